# Optimizing an MI355X kernel written in HIP

```python
import math
import jax, jax.numpy as jnp
from jax import lax
import numpy as np

D_MODEL = 1024
BATCH = 32
SEQ = 2048
DEPTH = 1
DEC_BATCH = 128
DEC_SEQ = 4
PAST_LEN = 8192
PAGE_SIZE = 128

HEAD_DIM = 64
GROUP_HEADS = 4
ATT_GROUPS = ((128, 1), (512, 4), (2048, 16))
N_GROUPS = len(ATT_GROUPS)
N_ATT_HEADS = N_GROUPS * GROUP_HEADS
ATT_W = N_ATT_HEADS * HEAD_DIM
ATT_OUT_W = GROUP_HEADS * HEAD_DIM
BLK = 128
N_BUCKETS = 32
MAX_DISTANCE = 2048
SGU_CHUNK = 128
SGU_GROUPS = 4
SGU_GROUP_W = 128
SGU_W = SGU_GROUPS * SGU_GROUP_W
D_FF = 2816
LN_EPS = 1e-5
ALPHA = (2 * DEPTH) ** 0.25
BETA = (8 * DEPTH) ** -0.25
IN_W = 3 * ATT_W + 2 * SGU_W + 2 * D_MODEL
NEG = -1e30
SCALE = HEAD_DIM ** -0.5

kernel_name = 'dilated_attn_gmlp_gated_macaron_step'


def _t5_bucket(dist):
    dist = np.asarray(dist, np.int64)
    max_exact = N_BUCKETS // 2
    large = max_exact + (np.log(np.maximum(dist, max_exact) / max_exact)
                         / np.log(MAX_DISTANCE / max_exact) * (N_BUCKETS - max_exact)).astype(np.int64)
    large = np.minimum(large, N_BUCKETS - 1)
    return np.where(dist < max_exact, dist, large).astype(np.int32)


def layer_norm(x, g, b):
    xf = x.astype(jnp.float32)
    mu = jnp.mean(xf, axis=-1, keepdims=True)
    var = jnp.mean(jnp.square(xf - mu), axis=-1, keepdims=True)
    return ((xf - mu) * lax.rsqrt(var + LN_EPS) * g.astype(jnp.float32) + b.astype(jnp.float32)).astype(x.dtype)


def swiglu(x, w1, w3, w2):
    return (jax.nn.silu(x @ w1) * (x @ w3)) @ w2


def dilated_attn_prompt(q, k, v, table, window, dil):
    B, S, H, E = q.shape
    L = S // dil
    band = window // dil
    assert band <= BLK
    nb = -(-L // BLK)
    Lp = nb * BLK

    def sub(a):
        return a.reshape(B, L, dil, H, E).transpose(0, 2, 3, 1, 4)

    qs = jnp.pad(sub(q), ((0, 0), (0, 0), (0, 0), (0, Lp - L), (0, 0))).reshape(B, dil, H, nb, BLK, E)

    def kblocks(a):
        ap = jnp.pad(sub(a), ((0, 0), (0, 0), (0, 0), (BLK, Lp - L), (0, 0)))
        prev = ap[:, :, :, :Lp].reshape(B, dil, H, nb, BLK, E)
        cur = ap[:, :, :, BLK:].reshape(B, dil, H, nb, BLK, E)
        return jnp.concatenate([prev, cur], axis=-2)

    kb, vb = kblocks(k), kblocks(v)
    rel = np.arange(BLK)[:, None] - np.arange(2 * BLK)[None, :] + BLK
    valid = (rel >= 0) & (rel <= band)
    bias = table.astype(jnp.float32)[_t5_bucket(np.clip(rel, 0, band) * dil)].transpose(2, 0, 1)
    kvalid = ~((np.arange(nb)[:, None] == 0) & (np.arange(2 * BLK)[None, :] < BLK))
    mask = valid[None] & kvalid[:, None, :]
    s = jnp.einsum('bdhnqe,bdhnke->bdhnqk', qs.astype(jnp.float32), kb.astype(jnp.float32)) * SCALE + bias[:, None]
    s = jnp.where(mask, s, NEG)
    m = jnp.max(s, axis=-1, keepdims=True)
    p = jnp.exp(s - m)
    l = jnp.sum(p, axis=-1, keepdims=True)
    o = jnp.einsum('bdhnqk,bdhnke->bdhnqe', p, vb.astype(jnp.float32)) / l
    lse = (m + jnp.log(l))[..., 0]
    o = o.reshape(B, dil, H, Lp, E)[:, :, :, :L].transpose(0, 3, 1, 2, 4).reshape(B, S, H, E)
    lse = lse.reshape(B, dil, H, Lp)[..., :L].transpose(0, 3, 1, 2).reshape(B, S, H)
    return o, lse


def dilated_attn_sample(q, k, v, kv_buf, table, window, dil):
    Bd, T, H, E = q.shape
    Lg = kv_buf.shape[1]
    band = window // dil
    full = jnp.concatenate([kv_buf, jnp.stack([k, v], axis=2).astype(kv_buf.dtype)], axis=1)
    steps = np.arange(band + 1)
    idx = Lg + np.arange(T)[:, None] - steps[None, :] * dil
    valid = idx >= 0
    kvg = full[:, np.maximum(idx, 0)]
    bias = table.astype(jnp.float32)[_t5_bucket(steps * dil)]
    s = jnp.einsum('bthe,btkhe->bthk', q.astype(jnp.float32), kvg[:, :, :, 0].astype(jnp.float32)) * SCALE + bias.T
    s = jnp.where(valid[:, None, :], s, NEG)
    m = jnp.max(s, axis=-1, keepdims=True)
    p = jnp.exp(s - m)
    l = jnp.sum(p, axis=-1, keepdims=True)
    o = jnp.einsum('bthk,btkhe->bthe', p, kvg[:, :, :, 1].astype(jnp.float32)) / l
    lse = (m + jnp.log(l))[..., 0]
    keep = min(window, full.shape[1])
    return o, lse, full[:, full.shape[1] - keep:]


def combine_groups(outs, lses):
    w = jax.nn.softmax(jnp.stack(lses, axis=-1), axis=-1)
    o = jnp.sum(jnp.stack(outs, axis=-2) * w[..., None], axis=-2)
    return o.reshape(*o.shape[:-2], ATT_OUT_W)


def sgu_branch(uv, ln_g, ln_b, ws, sb):
    Bn, L, _ = uv.shape
    z = jax.nn.gelu(uv, approximate=False)
    u, vr = z[..., :SGU_W], z[..., SGU_W:]
    vn = layer_norm(vr, ln_g, ln_b)
    cl = min(SGU_CHUNK, L)
    vc = vn.reshape(Bn, L // cl, cl, SGU_GROUPS, SGU_GROUP_W)
    wm = jnp.tril(ws)[:, :cl, :cl]
    mixed = jnp.einsum('gpq,bnqgc->bnpgc', wm, vc) + sb[:, :cl].T[:, :, None]
    return u * mixed.reshape(Bn, L, SGU_W), vn


def trunk_layer(x, rel_bias, kv_bufs, ln1_g, ln1_b, f1_w1, f1_w3, f1_w2, w_in, b_in,
                sgu_ln_g, sgu_ln_b, sgu_ws, sgu_b, w_oa, w_ob, w_out,
                ln2_g, ln2_b, f2_w1, f2_w3, f2_w2, ln3_g, ln3_b):
    h = layer_norm(ALPHA * x + 0.5 * swiglu(x, f1_w1, f1_w3, f1_w2), ln1_g, ln1_b)
    z = h @ w_in + b_in
    lead = z.shape[:-1]
    q = z[..., :ATT_W].reshape(*lead, N_GROUPS, GROUP_HEADS, HEAD_DIM)
    k = z[..., ATT_W:2 * ATT_W].reshape(*lead, N_GROUPS, GROUP_HEADS, HEAD_DIM)
    v = z[..., 2 * ATT_W:3 * ATT_W].reshape(*lead, N_GROUPS, GROUP_HEADS, HEAD_DIM)
    o_uv = 3 * ATT_W
    uv = z[..., o_uv:o_uv + 2 * SGU_W]
    ga = z[..., o_uv + 2 * SGU_W:o_uv + 2 * SGU_W + D_MODEL]
    gb = z[..., o_uv + 2 * SGU_W + D_MODEL:]
    outs, lses, new_bufs = [], [], []
    for g, (window, dil) in enumerate(ATT_GROUPS):
        tab = rel_bias[:, g * GROUP_HEADS:(g + 1) * GROUP_HEADS]
        qg, kg, vg = q[..., g, :, :], k[..., g, :, :], v[..., g, :, :]
        if kv_bufs is None:
            o, lse = dilated_attn_prompt(qg, kg, vg, tab, window, dil)
            S = x.shape[1]
            keep = min(window, S)
            nbuf = jnp.stack([kg, vg], axis=2)[:, S - keep:]
        else:
            o, lse, nbuf = dilated_attn_sample(qg, kg, vg, kv_bufs[g], tab, window, dil)
        outs.append(o)
        lses.append(lse)
        new_bufs.append(nbuf)
    att = combine_groups(outs, lses).astype(h.dtype)
    yb, vrows = sgu_branch(uv, sgu_ln_g, sgu_ln_b, sgu_ws, sgu_b)
    mix = (jax.nn.sigmoid(ga) * (att @ w_oa) + jax.nn.sigmoid(gb) * (yb @ w_ob)) @ w_out
    h = layer_norm(ALPHA * h + mix, ln2_g, ln2_b)
    h = layer_norm(ALPHA * h + 0.5 * swiglu(h, f2_w1, f2_w3, f2_w2), ln3_g, ln3_b)
    return h, new_bufs, vrows


def setup_inputs(seed: int = 0) -> dict:
    key = jax.random.key(seed)
    ks = iter(jax.random.split(key, 40))

    def nrm(shape, scale):
        return jax.random.normal(next(ks), shape, jnp.float32) * scale

    def gain(shape):
        return 1.0 + nrm(shape, 0.05)

    inp = {}
    inp['x_prompt'] = nrm((BATCH, SEQ, D_MODEL), 1.0)
    inp['x_sample'] = nrm((DEC_BATCH, DEC_SEQ, D_MODEL), 1.0)
    for g, (window, dil) in enumerate(ATT_GROUPS):
        inp['state_win%d' % g] = nrm((DEPTH, DEC_BATCH, min(window, PAST_LEN), 2, GROUP_HEADS, HEAD_DIM), 1.0)
    inp['rel_bias'] = nrm((N_BUCKETS, N_ATT_HEADS), 0.3)
    inp['ln1_g'] = gain((DEPTH, D_MODEL))
    inp['ln1_b'] = nrm((DEPTH, D_MODEL), 0.05)
    inp['f1_w1'] = nrm((DEPTH, D_MODEL, D_FF), D_MODEL ** -0.5)
    inp['f1_w3'] = nrm((DEPTH, D_MODEL, D_FF), D_MODEL ** -0.5)
    inp['f1_w2'] = nrm((DEPTH, D_FF, D_MODEL), BETA * D_FF ** -0.5)
    inp['w_in'] = nrm((DEPTH, D_MODEL, IN_W), D_MODEL ** -0.5)
    inp['b_in'] = nrm((DEPTH, IN_W), 0.02)
    inp['sgu_ln_g'] = gain((DEPTH, SGU_W))
    inp['sgu_ln_b'] = nrm((DEPTH, SGU_W), 0.05)
    inp['sgu_ws'] = nrm((DEPTH, SGU_GROUPS, SGU_CHUNK, SGU_CHUNK), 0.5 * SGU_CHUNK ** -0.5)
    inp['sgu_b'] = gain((DEPTH, SGU_GROUPS, SGU_CHUNK))
    inp['w_oa'] = nrm((DEPTH, ATT_OUT_W, D_MODEL), BETA * ATT_OUT_W ** -0.5)
    inp['w_ob'] = nrm((DEPTH, SGU_W, D_MODEL), BETA * SGU_W ** -0.5)
    inp['w_out'] = nrm((DEPTH, D_MODEL, D_MODEL), BETA * D_MODEL ** -0.5)
    inp['ln2_g'] = gain((DEPTH, D_MODEL))
    inp['ln2_b'] = nrm((DEPTH, D_MODEL), 0.05)
    inp['f2_w1'] = nrm((DEPTH, D_MODEL, D_FF), D_MODEL ** -0.5)
    inp['f2_w3'] = nrm((DEPTH, D_MODEL, D_FF), D_MODEL ** -0.5)
    inp['f2_w2'] = nrm((DEPTH, D_FF, D_MODEL), BETA * D_FF ** -0.5)
    inp['ln3_g'] = gain((DEPTH, D_MODEL))
    inp['ln3_b'] = nrm((DEPTH, D_MODEL), 0.05)
    return inp


def reference(x_prompt, x_sample, state_win0, state_win1, state_win2, rel_bias,
              ln1_g, ln1_b, f1_w1, f1_w3, f1_w2, w_in, b_in,
              sgu_ln_g, sgu_ln_b, sgu_ws, sgu_b, w_oa, w_ob, w_out,
              ln2_g, ln2_b, f2_w1, f2_w3, f2_w2, ln3_g, ln3_b):
    yp, ys = x_prompt, x_sample
    pw0, pw1, pw2, sw0, sw1, sw2, sv = [], [], [], [], [], [], []
    for l in range(DEPTH):
        lw = (ln1_g[l], ln1_b[l], f1_w1[l], f1_w3[l], f1_w2[l], w_in[l], b_in[l],
              sgu_ln_g[l], sgu_ln_b[l], sgu_ws[l], sgu_b[l], w_oa[l], w_ob[l], w_out[l],
              ln2_g[l], ln2_b[l], f2_w1[l], f2_w3[l], f2_w2[l], ln3_g[l], ln3_b[l])
        yp, nbp, _ = trunk_layer(yp, rel_bias, None, *lw)
        ys, nbs, vrows = trunk_layer(ys, rel_bias, (state_win0[l], state_win1[l], state_win2[l]), *lw)
        pw0.append(nbp[0]); pw1.append(nbp[1]); pw2.append(nbp[2])
        sw0.append(nbs[0]); sw1.append(nbs[1]); sw2.append(nbs[2])
        sv.append(vrows)
    return (yp, ys, jnp.stack(pw0), jnp.stack(pw1), jnp.stack(pw2),
            jnp.stack(sw0), jnp.stack(sw1), jnp.stack(sw2), jnp.stack(sv))
```

```cpp
#include <hip/hip_runtime.h>
#include <cstdio>
#include <cstdint>
#define MK_PROBE_TOL 0.02f
#define MK_PROBE_WS (2025ull << 20)

#ifndef MK_N_LAUNCHES
#define MK_N_LAUNCHES 1
#endif
#ifndef MK_PH_MAX
#define MK_PH_MAX 11
#endif

#define GAS __attribute__((address_space(1)))
#define LAS __attribute__((address_space(3)))
typedef unsigned short bf16;
typedef unsigned long long u64;
typedef float f32x2 __attribute__((ext_vector_type(2)));
typedef float f32x4 __attribute__((ext_vector_type(4)));
typedef float f32x16 __attribute__((ext_vector_type(16)));
typedef short bf16x8 __attribute__((ext_vector_type(8)));
typedef short s16x4 __attribute__((ext_vector_type(4)));
typedef unsigned u32x2 __attribute__((ext_vector_type(2)));
typedef unsigned u32x4 __attribute__((ext_vector_type(4)));

constexpr int DM = 1024, SEQ = 2048, NB = 32, MP = NB * SEQ, DEC_B = 128, DEC_T = 4, MS = DEC_B * DEC_T, M = MP + MS;
constexpr int DFF = 2816, NFF2 = 2 * DFF, INW = 5376, QKVW = 768, SGUW = 512;
constexpr float LN_EPS = 1e-5f;
constexpr float ALPHA = 1.189207115002721f;
constexpr float LOG2E = 1.4426950408889634f, LN2F = 0.6931471805599453f;
constexpr float QSCALE = 0.125f * LOG2E;
constexpr float NEGBIG = -1e30f;

constexpr size_t O_Y = 0, O_W0P = 67633152ull, O_W1P = 69730304ull, O_W2P = 78118912ull, O_W0S = 111673344ull, O_W1S = 120061952ull, O_W2S = 153616384ull, O_SV = 287834112ull, O_END = 288096256ull;

constexpr size_t MiB = 1u << 20;
constexpr size_t WS_CTL = 0, CTL_ZERO_BYTES = 1 * MiB;
constexpr size_t WS_SMALL = 1 * MiB;
constexpr size_t WS_WF1 = 2 * MiB, WS_WF1D = 13 * MiB, WS_WIN = 19 * MiB, WS_WOAB = 30 * MiB, WS_WOUT = 32 * MiB, WS_WF2 = 34 * MiB, WS_WF2D = 45 * MiB, WS_WSB = 51 * MiB;
constexpr size_t WS_S1 = 52 * MiB, WS_S2 = 61 * MiB, WS_S3 = 70 * MiB, WS_SGV = 79 * MiB, WS_LSE = 84 * MiB;
constexpr size_t WS_XB = 88 * MiB;
constexpr size_t WS_V1 = 217 * MiB, WS_V2 = 346 * MiB, WS_U = 475 * MiB, WS_GV = 540 * MiB, WS_SA = 605 * MiB, WS_SB = 734 * MiB, WS_OG = 863 * MiB, WS_AY = 960 * MiB;
constexpr size_t WS_ACT = 1057 * MiB;
constexpr size_t WS_Q = WS_ACT, WS_K = WS_ACT + 97 * MiB, WS_V = WS_ACT + 194 * MiB;
constexpr size_t WS_END = 1412 * MiB;
static_assert((size_t)M * DFF * 2 <= 355 * MiB && (size_t)M * QKVW * 2 <= 97 * MiB && (size_t)M * DM * 2 <= 129 * MiB, "ws map");
constexpr int SM_CS1 = 0, SM_B1 = 8192, SM_CS2 = 16384, SM_B2 = 24576, SM_BT = 32768;

constexpr int CW_BAR = 4096;

constexpr int RING_BYTES = 131072, STAB_OFF = RING_BYTES  , MISC_OFF = STAB_OFF + 4096, LDS_BYTES = 147456;

__device__ const unsigned char T5BUCKET[3][129] = {
{0,1,2,3,4,5,6,7,8,9,10,11,12,13,14,15,16,16,16,16,16,16,17,17,17,17,17,17,17,17,18,18,18,18,18,18,18,18,18,18,19,19,19,19,19,19,19,19,19,19,19,19,19,19,20,20,20,20,20,20,20,20,20,20,20,20,20,20,20,20,20,20,20,21,21,21,21,21,21,21,21,21,21,21,21,21,21,21,21,21,21,21,21,21,21,21,21,21,21,22,22,22,22,22,22,22,22,22,22,22,22,22,22,22,22,22,22,22,22,22,22,22,22,22,22,22,22,22,22},
{0,4,8,12,16,16,17,17,18,18,19,19,19,19,20,20,20,20,20,21,21,21,21,21,21,22,22,22,22,22,22,22,22,22,23,23,23,23,23,23,23,23,23,23,23,23,24,24,24,24,24,24,24,24,24,24,24,24,24,24,24,24,25,25,25,25,25,25,25,25,25,25,25,25,25,25,25,25,25,25,25,25,25,26,26,26,26,26,26,26,26,26,26,26,26,26,26,26,26,26,26,26,26,26,26,26,26,26,26,26,26,26,26,27,27,27,27,27,27,27,27,27,27,27,27,27,27,27,27},
{0,16,18,19,20,21,21,22,22,23,23,23,24,24,24,24,25,25,25,25,25,26,26,26,26,26,26,26,26,27,27,27,27,27,27,27,27,27,27,28,28,28,28,28,28,28,28,28,28,28,28,28,29,29,29,29,29,29,29,29,29,29,29,29,29,29,29,29,29,29,30,30,30,30,30,30,30,30,30,30,30,30,30,30,30,30,30,30,30,30,30,30,30,30,30,31,31,31,31,31,31,31,31,31,31,31,31,31,31,31,31,31,31,31,31,31,31,31,31,31,31,31,31,31,31,31,31,31,31}};

__device__ __forceinline__ unsigned f2bf(float f) { unsigned u = __builtin_bit_cast(unsigned, f); return (u + 0x7fffu + ((u >> 16) & 1u)) >> 16; }
__device__ __forceinline__ unsigned pk2(float lo, float hi) { return f2bf(lo) | (f2bf(hi) << 16); }
__device__ __forceinline__ float bfround(float f) { return __uint_as_float(f2bf(f) << 16); }
typedef __bf16 bf16x2_t __attribute__((ext_vector_type(2)));
__device__ __forceinline__ unsigned cvt_pk_bf16(float lo, float hi) { const f32x2 v = {lo, hi}; const bf16x2_t b = __builtin_convertvector(v, bf16x2_t); return __builtin_bit_cast(unsigned, b); }
__device__ __forceinline__ float bflo(unsigned u) { return __uint_as_float(u << 16); }
__device__ __forceinline__ float bfhi(unsigned u) { return __uint_as_float(u & 0xffff0000u); }
__device__ __forceinline__ u32x4 pack8(f32x4 a, f32x4 b) { u32x4 w; w.x = cvt_pk_bf16(a[0], a[1]); w.y = cvt_pk_bf16(a[2], a[3]); w.z = cvt_pk_bf16(b[0], b[1]); w.w = cvt_pk_bf16(b[2], b[3]); return w; }
__device__ __forceinline__ void unpack8(u32x4 w, f32x4& a, f32x4& b) { a = (f32x4){bflo(w.x), bfhi(w.x), bflo(w.y), bfhi(w.y)}; b = (f32x4){bflo(w.z), bfhi(w.z), bflo(w.w), bfhi(w.w)}; }
__device__ __forceinline__ float fast_exp2(float x) { return __builtin_amdgcn_exp2f(x); }
__device__ __forceinline__ float fast_rcp(float x) { return __builtin_amdgcn_rcpf(x); }
__device__ __forceinline__ float sigmoidf_(float x) { return fast_rcp(1.0f + fast_exp2(-x * LOG2E)); }
__device__ __forceinline__ f32x4 sigmoid4(f32x4 v) { return (f32x4){sigmoidf_(v[0]), sigmoidf_(v[1]), sigmoidf_(v[2]), sigmoidf_(v[3])}; }
__device__ __forceinline__ float gelu1(float v) {
    const float av = __builtin_fabsf(v), t = fast_rcp(av * 0.2316418882f + 1.0f);
    float q = t * 0.5307027145f + (-0.7265760135f); q = q * t + 0.7107068705f; q = q * t + (-0.142248368f); q = q * t + 0.127414796f; q = q * t;
    const float e = fast_exp2((v * v) * (-0.72134752044f));
    const float m = v * (q * e);
    return v < 0.f ? m : v - m;
}
__device__ __forceinline__ f32x4 gelu4(f32x4 v) { return (f32x4){gelu1(v[0]), gelu1(v[1]), gelu1(v[2]), gelu1(v[3])}; }
__device__ __forceinline__ float wave_sum(float v) {
#pragma unroll
    for (int o = 1; o < 64; o <<= 1) v += __shfl_xor(v, o);
    return v;
}
__device__ __forceinline__ float wave_max(float v) {
#pragma unroll
    for (int o = 1; o < 64; o <<= 1) v = fmaxf(v, __shfl_xor(v, o));
    return v;
}

namespace pg8 {
constexpr int BM = 256, BK = 64, HALF = 128, HTB = HALF * BK * 2, STAGE_BYTES = 8 * HTB, NXCD = 8, WGM = 8;
__host__ __device__ __forceinline__ int lds_byte(int r, int c) { const int st = (r >> 4) * 2 + (c >> 5), rr = r & 15, cc = c & 31, ob = rr * 64 + cc * 2; return st * 1024 + (ob ^ (((ob >> 9) & 1) << 5)); }
__host__ __device__ __forceinline__ void stage_rc(int b, int& R, int& C) { const int st = b / 1024, sb = b % 1024, swz = sb ^ (((sb >> 9) & 1) << 5); R = (st >> 1) * 16 + swz / 64; C = (st & 1) * 32 + (swz % 64) / 2; }
__host__ __device__ __forceinline__ int perm32(int rho) { const int n = rho >> 4, i = rho & 15; return 8 * (i >> 2) + 4 * n + (i & 3); }

struct Unit { int pm, pn; };
struct Gemm { const bf16* A; const bf16* Bt; int M, N, K; };

struct StaticOrder {
    int nM, nN, nwg, G, c;
    __device__ void init(int M_, int N_, int G_, int c_) { nM = M_ / BM; nN = N_ / BM; nwg = nM * nN; G = G_; c = c_; }
    __device__ bool next(int i, Unit& u) const {
        const long L = (long)i * G + c; if (L >= nwg) return false;
        int wgid = (int)L; { const int q = nwg / NXCD, r = nwg % NXCD, xcd = wgid % NXCD, off = wgid / NXCD; wgid = (xcd < r ? xcd * (q + 1) : r * (q + 1) + (xcd - r) * q) + off; }
        const int nig = WGM * nN, gid = wgid / nig, fm = gid * WGM, gsz = (nM - fm) < WGM ? (nM - fm) : WGM;
        u.pm = fm + ((wgid % nig) % gsz); u.pn = (wgid % nig) / gsz; return true;
    }
};

template <class Epi>
__device__ __forceinline__ void gemm_phase(LAS unsigned char* lds, const Gemm g, const StaticOrder& S, const Epi& E) {
    const int tid = threadIdx.x, wid = __builtin_amdgcn_readfirstlane(tid >> 6), lane = tid & 63, wr = wid >> 2, wc = wid & 3, fr = lane & 15, fq = lane >> 4;
    const int K = g.K, nt = K / BK;
    unsigned voffA[2], voffB[2];
#pragma unroll
    for (int i = 0; i < 2; ++i) { int R, C; stage_rc(tid * 16 + i * 8192, R, C); const int Rb = (R & ~31) + perm32(R & 31);
        voffA[i] = (unsigned)(R * K + C) * 2u; voffB[i] = (unsigned)(Rb * K + C) * 2u; }
    const size_t kstep = (size_t)(BK * 2);
    const size_t hstep = (size_t)HALF * K * 2;
    const size_t tstep = 2 * hstep;
    const unsigned ldsw = (unsigned)wid * 1024u;
    const int aoff = lds_byte(wr * 64 + fr, fq * 8), boff = lds_byte(wc * 32 + fr, fq * 8);
#define PG8_SA(b, h) (((b) * 2 + (h)) * HTB)
#define PG8_SB(b, h) ((4 + (b) * 2 + (h)) * HTB)
#define PG8_STAGE(bufoff, gbase, voff) do { _Pragma("unroll") for (int _i = 0; _i < 2; ++_i) \
        __builtin_amdgcn_global_load_lds((const unsigned*)((const char*)(gbase) + (voff)[_i]), (LAS unsigned*)(lds + (bufoff) + ldsw + _i * 8192), 16, 0, 0); } while (0)
#define PG8_LDA(dst, b, h) do { _Pragma("unroll") for (int m = 0; m < 4; ++m) _Pragma("unroll") for (int k = 0; k < 2; ++k) dst[m][k] = *(const LAS bf16x8*)(lds + PG8_SA(b, h) + aoff + m * 2048 + k * 1024); } while (0)
#define PG8_LDB(dst, b, h) do { _Pragma("unroll") for (int n = 0; n < 2; ++n) _Pragma("unroll") for (int k = 0; k < 2; ++k) dst[n][k] = *(const LAS bf16x8*)(lds + PG8_SB(b, h) + boff + n * 2048 + k * 1024); } while (0)
#define PG8_MMA(ai, bj, At, Bt) do { __builtin_amdgcn_s_setprio(1); _Pragma("unroll") for (int m = 0; m < 4; ++m) _Pragma("unroll") for (int n = 0; n < 2; ++n) _Pragma("unroll") for (int k = 0; k < 2; ++k) \
        acc[ai][bj][m][n] = __builtin_amdgcn_mfma_f32_16x16x32_bf16(Bt[n][k], At[m][k], acc[ai][bj][m][n], 0, 0, 0); __builtin_amdgcn_s_setprio(0); } while (0)
#define PG8_WAIT_V(n) asm volatile("s_waitcnt vmcnt(" #n ")" ::: "memory")
#define PG8_WAIT_L(n) asm volatile("s_waitcnt lgkmcnt(" #n ")" ::: "memory")
#define PG8_BAR __builtin_amdgcn_s_barrier()
#define PG8_SCHED __builtin_amdgcn_sched_barrier(0)
    Unit cur, nxt; int ui = 0;
    if (!S.next(0, cur)) return;
    f32x4 acc[2][2][4][2];
#pragma unroll
    for (int a = 0; a < 2; ++a)
#pragma unroll
        for (int b = 0; b < 2; ++b)
#pragma unroll
            for (int m = 0; m < 4; ++m)
#pragma unroll
                for (int n = 0; n < 2; ++n) acc[a][b][m][n] = (f32x4){0.f, 0.f, 0.f, 0.f};
    bf16x8 At[4][2], B0[2][2], B1[2][2];
    const char* cA = (const char*)g.A + (size_t)cur.pm * tstep; const char* cB = (const char*)g.Bt + (size_t)cur.pn * tstep;
    if constexpr (Epi::HAS_PREP) E.prep(cur, 0, tid);
    PG8_STAGE(PG8_SB(0, 0), cB, voffB); PG8_STAGE(PG8_SB(0, 1), cB + hstep, voffB); PG8_STAGE(PG8_SA(0, 0), cA, voffA); PG8_STAGE(PG8_SA(0, 1), cA + hstep, voffA);
    if (wr == 1) PG8_BAR;
    PG8_WAIT_V(2); PG8_BAR;
    PG8_STAGE(PG8_SB(1, 0), cB + kstep, voffB); PG8_STAGE(PG8_SA(1, 0), cA + kstep, voffA); PG8_STAGE(PG8_SB(1, 1), cB + hstep + kstep, voffB);
    PG8_WAIT_V(6); PG8_BAR;
    for (;;) {
        const bool has_next = S.next(ui + 1, nxt);
        const char* nA = has_next ? (const char*)g.A + (size_t)nxt.pm * tstep : cA; const char* nB = has_next ? (const char*)g.Bt + (size_t)nxt.pn * tstep : cB;
        for (int t = 0; t < nt; t += 2) {
            const bool last = (t == nt - 2);
            const char* a1 = cA + (size_t)(t + 1) * kstep;
            const char* a2 = last ? nA : cA + (size_t)(t + 2) * kstep; const char* b2 = last ? nB : cB + (size_t)(t + 2) * kstep;
            const char* a3 = a2 + kstep; const char* b3 = b2 + kstep;
            if constexpr (Epi::MID_T >= 0) { if (t == Epi::MID_T) E.mid(acc, cur, wr, wc, fr, fq); }
            PG8_LDB(B0, 0, 0); PG8_LDB(B1, 0, 1); PG8_SCHED; PG8_LDA(At, 0, 0); PG8_STAGE(PG8_SA(1, 1), a1 + hstep, voffA);
            PG8_WAIT_V(8); PG8_WAIT_L(0); PG8_BAR; PG8_MMA(0, 0, At, B0); PG8_MMA(0, 1, At, B1); PG8_BAR; PG8_SCHED;
            PG8_LDA(At, 0, 1); PG8_STAGE(PG8_SB(0, 0), b2, voffB); PG8_STAGE(PG8_SB(0, 1), b2 + hstep, voffB); PG8_STAGE(PG8_SA(0, 0), a2, voffA);
            PG8_WAIT_V(8); PG8_WAIT_L(0); PG8_BAR; PG8_MMA(1, 0, At, B0); PG8_MMA(1, 1, At, B1); PG8_BAR; PG8_SCHED;
            PG8_LDB(B0, 1, 0); PG8_LDB(B1, 1, 1); PG8_SCHED; PG8_LDA(At, 1, 0); PG8_STAGE(PG8_SA(0, 1), a2 + hstep, voffA);
            PG8_WAIT_V(8); PG8_WAIT_L(0); PG8_BAR; PG8_MMA(0, 0, At, B0); PG8_MMA(0, 1, At, B1); PG8_BAR; PG8_SCHED;
            PG8_LDA(At, 1, 1); PG8_STAGE(PG8_SB(1, 0), b3, voffB); PG8_STAGE(PG8_SB(1, 1), b3 + hstep, voffB); PG8_STAGE(PG8_SA(1, 0), a3, voffA);
            PG8_WAIT_V(8); PG8_WAIT_L(0); PG8_BAR; PG8_MMA(1, 0, At, B0); PG8_MMA(1, 1, At, B1); PG8_BAR; PG8_SCHED;
        }
        if (wr == 0) PG8_BAR;
        E(acc, cur, wr, wc, fr, fq, ui & 1);
        if (!has_next) break;
#pragma unroll
        for (int a = 0; a < 2; ++a)
#pragma unroll
            for (int b = 0; b < 2; ++b)
#pragma unroll
                for (int m = 0; m < 4; ++m)
#pragma unroll
                    for (int n = 0; n < 2; ++n) acc[a][b][m][n] = (f32x4){0.f, 0.f, 0.f, 0.f};
        if constexpr (Epi::HAS_PREP) E.prep(nxt, (ui + 1) & 1, tid);
        cur = nxt; cA = nA; cB = nB; ++ui;
        if (wr == 1) PG8_BAR;
    }
    PG8_WAIT_V(0);
    PG8_BAR;
#undef PG8_SA
#undef PG8_SB
#undef PG8_STAGE
#undef PG8_LDA
#undef PG8_LDB
#undef PG8_MMA
#undef PG8_WAIT_V
#undef PG8_WAIT_L
#undef PG8_BAR
#undef PG8_SCHED
}

__device__ __forceinline__ void wave_row_stats(const f32x4 (&v)[2][2][4][2], u64* slots, int ns, int sidx, int row0, int fq) {
#pragma unroll
    for (int ai = 0; ai < 2; ++ai)
#pragma unroll
        for (int m = 0; m < 4; ++m) {
            float s = 0.f;
#pragma unroll
            for (int bj = 0; bj < 2; ++bj)
#pragma unroll
                for (int n = 0; n < 2; ++n) { const f32x4 x = v[ai][bj][m][n]; s += (x[0] + x[1]) + (x[2] + x[3]); }
            s += __shfl_xor(s, 16); s += __shfl_xor(s, 32);
            const float mw = s * (1.0f / 64.0f); float q = 0.f;
#pragma unroll
            for (int bj = 0; bj < 2; ++bj)
#pragma unroll
                for (int n = 0; n < 2; ++n) { const f32x4 d = v[ai][bj][m][n] - mw; q += (d[0] * d[0] + d[1] * d[1]) + (d[2] * d[2] + d[3] * d[3]); }
            q += __shfl_xor(q, 16); q += __shfl_xor(q, 32);
            if (fq == 0) slots[(size_t)(row0 + ai * HALF + m * 16) * ns + sidx] = ((u64)__float_as_uint(q) << 32) | (u64)__float_as_uint(mw);
        }
}
__device__ __forceinline__ void stats_table16(const u64* slots, int pm, LAS f32x2* tab, int tid) {
    const int row = tid >> 1, half = tid & 1;
    const u32x4* p = (const u32x4*)(slots + (size_t)(pm * 256 + row) * 16 + half * 8);
    const u32x4 a = p[0], b = p[1], c = p[2], d = p[3];
    const float mn[8] = {__uint_as_float(a.x), __uint_as_float(a.z), __uint_as_float(b.x), __uint_as_float(b.z), __uint_as_float(c.x), __uint_as_float(c.z), __uint_as_float(d.x), __uint_as_float(d.z)};
    const float m2[8] = {__uint_as_float(a.y), __uint_as_float(a.w), __uint_as_float(b.y), __uint_as_float(b.w), __uint_as_float(c.y), __uint_as_float(c.w), __uint_as_float(d.y), __uint_as_float(d.w)};
    float sm = 0.f;
#pragma unroll
    for (int i = 0; i < 8; ++i) sm += mn[i];
    sm += __shfl_xor(sm, 1);
    const float mt = sm * (1.0f / 16.0f);
    float q = 0.f;
#pragma unroll
    for (int i = 0; i < 8; ++i) { const float dd = mn[i] - mt; q += m2[i] + 64.0f * dd * dd; }
    q += __shfl_xor(q, 1);
    if (half == 0) tab[row] = (f32x2){mt, 1.0f / sqrtf(q * (1.0f / 1024.0f) + LN_EPS)};
}

template <bool LN> struct EpiSwiglu {
    static constexpr bool HAS_PREP = LN; static constexpr int MID_T = -1;
    bf16* O; const float* cs; const float* bias; const u64* slots; LAS f32x2* stab;
    __device__ __forceinline__ void prep(const Unit& u, int par, int tid) const { stats_table16(slots, u.pm, stab + par * 256, tid); }
    __device__ __forceinline__ void mid(f32x4 (&)[2][2][4][2], const Unit&, int, int, int, int) const {}
    __device__ __forceinline__ void operator()(f32x4 (&acc)[2][2][4][2], const Unit& u, int wr, int wc, int fr, int fq, int par) const {
        asm volatile("" : "+v"(fr), "+v"(fq));
        const int ocol = u.pn * 128 + wc * 32 + 8 * fq, brow = u.pn * 256 + wc * 32 + 8 * fq;
        f32x4 csA[2], csB[2], biA[2], biB[2];
        if constexpr (LN) {
#pragma unroll
            for (int n = 0; n < 2; ++n) { csA[n] = *(const f32x4*)(cs + brow + 4 * n); csB[n] = *(const f32x4*)(cs + brow + 128 + 4 * n); biA[n] = *(const f32x4*)(bias + brow + 4 * n); biB[n] = *(const f32x4*)(bias + brow + 128 + 4 * n); }
        }
#pragma unroll
        for (int ai = 0; ai < 2; ++ai)
#pragma unroll
            for (int m = 0; m < 4; ++m) {
                const int r = ai * HALF + wr * 64 + m * 16 + fr;
                f32x4 o[2];
                f32x2 st; if constexpr (LN) st = stab[par * 256 + r];
#pragma unroll
                for (int n = 0; n < 2; ++n) {
                    f32x4 a = acc[ai][0][m][n], b = acc[ai][1][m][n];
                    if constexpr (LN) { a = (a - st.x * csA[n]) * st.y + biA[n]; b = (b - st.x * csB[n]) * st.y + biB[n]; }
                    o[n] = a * b * sigmoid4(a);
                }
                *(u32x4*)(O + (size_t)(u.pm * BM + r) * DFF + ocol) = pack8(o[0], o[1]);
            }
    }
};

template <int MODE> struct EpiDown {
    static constexpr bool HAS_PREP = (MODE != 0); static constexpr int MID_T = -1;
    const float* xp; const float* xs; const bf16* Vp; const float* g; const float* b; const u64* slots_in; LAS f32x2* stab;
    bf16* Ob; float* Of; u64* slots_out; float cacc;
    __device__ __forceinline__ void prep(const Unit& u, int par, int tid) const { stats_table16(slots_in, u.pm, stab + par * 256, tid); }
    __device__ __forceinline__ void mid(f32x4 (&)[2][2][4][2], const Unit&, int, int, int, int) const {}
    __device__ __forceinline__ void operator()(f32x4 (&acc)[2][2][4][2], const Unit& u, int wr, int wc, int fr, int fq, int par) const {
        asm volatile("" : "+v"(fr), "+v"(fq));
        const float* xbase = (u.pm < MP / BM) ? xp + (size_t)u.pm * BM * DM : xs + (size_t)(u.pm - MP / BM) * BM * DM;
#pragma unroll
        for (int bj = 0; bj < 2; ++bj) {
            const int col = u.pn * BM + bj * HALF + wc * 32 + 8 * fq;
            f32x4 g0, g1, b0, b1;
            if constexpr (MODE != 0) { g0 = *(const f32x4*)(g + col); g1 = *(const f32x4*)(g + col + 4); b0 = *(const f32x4*)(b + col); b1 = *(const f32x4*)(b + col + 4); }
#pragma unroll
            for (int ai = 0; ai < 2; ++ai)
#pragma unroll
                for (int m = 0; m < 4; ++m) {
                    const int r = ai * HALF + wr * 64 + m * 16 + fr;
                    f32x4 r0, r1;
                    if constexpr (MODE == 0) { const float* xr = xbase + (size_t)r * DM + col; r0 = *(const f32x4*)xr; r1 = *(const f32x4*)(xr + 4); }
                    else { const u32x4 w = *(const u32x4*)(Vp + (size_t)(u.pm * BM + r) * DM + col); unpack8(w, r0, r1); const f32x2 st = stab[par * 256 + r];
                           r0 = (r0 - st.x) * st.y * g0 + b0; r1 = (r1 - st.x) * st.y * g1 + b1; }
                    acc[ai][bj][m][0] = ALPHA * r0 + cacc * acc[ai][bj][m][0]; acc[ai][bj][m][1] = ALPHA * r1 + cacc * acc[ai][bj][m][1];
                    asm volatile("" : "+v"(acc[ai][bj][m][0]), "+v"(acc[ai][bj][m][1])); if (m & 1) asm volatile("" ::: "memory");
                }
        }
        wave_row_stats(acc, slots_out, 16, u.pn * 4 + wc, u.pm * BM + wr * 64 + fr, fq);
#pragma unroll
        for (int ai = 0; ai < 2; ++ai)
#pragma unroll
            for (int m = 0; m < 4; ++m) {
                const size_t row = (size_t)(u.pm * BM + ai * HALF + wr * 64 + m * 16 + fr);
#pragma unroll
                for (int bj = 0; bj < 2; ++bj) {
                    const int col = u.pn * BM + bj * HALF + wc * 32 + 8 * fq;
                    if constexpr (MODE == 2) { *(f32x4*)(Of + row * DM + col) = acc[ai][bj][m][0]; *(f32x4*)(Of + row * DM + col + 4) = acc[ai][bj][m][1]; }
                    else *(u32x4*)(Ob + row * DM + col) = pack8(acc[ai][bj][m][0], acc[ai][bj][m][1]);
                }
                asm volatile("" ::: "memory");
            }
    }
};

struct EpiWin {
    static constexpr bool HAS_PREP = true; static constexpr int MID_T = -1;
    const float* cs; const float* bias; const u64* slots; LAS f32x2* stab;
    bf16 *Q, *K, *V, *U, *GV, *SA, *SB; u64* sgv; float* out;
    __device__ __forceinline__ void prep(const Unit& u, int par, int tid) const { stats_table16(slots, u.pm, stab + par * 256, tid); }
    __device__ __forceinline__ void mid(f32x4 (&)[2][2][4][2], const Unit&, int, int, int, int) const {}
    template <int ACT>
    __device__ __forceinline__ void store_tile(f32x4 (&acc)[2][2][4][2], bf16* dst, int ld, int c0, const Unit& u, int wr, int wc, int fr, int fq) const {
#pragma unroll
        for (int ai = 0; ai < 2; ++ai)
#pragma unroll
            for (int m = 0; m < 4; ++m) {
                bf16* rowp = dst + (size_t)(u.pm * BM + ai * HALF + wr * 64 + m * 16 + fr) * ld + c0 + wc * 32 + 8 * fq;
#pragma unroll
                for (int bj = 0; bj < 2; ++bj) {
                    f32x4 v0 = acc[ai][bj][m][0], v1 = acc[ai][bj][m][1];
                    if (ACT == 1) { v0 = v0 * QSCALE; v1 = v1 * QSCALE; }
                    if (ACT == 2) { v0 = gelu4(v0); v1 = gelu4(v1); }
                    if (ACT == 3) { v0 = sigmoid4(v0); v1 = sigmoid4(v1); }
                    *(u32x4*)(rowp + bj * HALF) = pack8(v0, v1);
                }
                asm volatile("" ::: "memory");
            }
    }
    __device__ __forceinline__ void operator()(f32x4 (&acc)[2][2][4][2], const Unit& u, int wr, int wc, int fr, int fq, int par) const {
        asm volatile("" : "+v"(fr), "+v"(fq));
#pragma unroll
        for (int bj = 0; bj < 2; ++bj) {
            const int col = u.pn * BM + bj * HALF + wc * 32 + 8 * fq;
            const f32x4 c0 = *(const f32x4*)(cs + col), c1 = *(const f32x4*)(cs + col + 4), b0 = *(const f32x4*)(bias + col), b1 = *(const f32x4*)(bias + col + 4);
#pragma unroll
            for (int ai = 0; ai < 2; ++ai)
#pragma unroll
                for (int m = 0; m < 4; ++m) {
                    const f32x2 st = stab[par * 256 + ai * HALF + wr * 64 + m * 16 + fr];
                    acc[ai][bj][m][0] = (acc[ai][bj][m][0] - st.x * c0) * st.y + b0; acc[ai][bj][m][1] = (acc[ai][bj][m][1] - st.x * c1) * st.y + b1;
                    asm volatile("" : "+v"(acc[ai][bj][m][0]), "+v"(acc[ai][bj][m][1]));
                }
            asm volatile("" ::: "memory");
        }
        const int pn = u.pn;
        if (pn < 3) { store_tile<1>(acc, Q, QKVW, pn * 256, u, wr, wc, fr, fq); }
        else if (pn < 9) {
            const int kv = pn >= 6 ? 1 : 0, g = pn - 3 - 3 * kv, W = 128 << (2 * g);
            store_tile<0>(acc, kv ? V : K, QKVW, g * 256, u, wr, wc, fr, fq);
            const size_t obase_p = (g == 0) ? O_W0P : (g == 1) ? O_W1P : O_W2P, obase_s = (g == 0) ? O_W0S : (g == 1) ? O_W1S : O_W2S;
#pragma unroll
            for (int ai = 0; ai < 2; ++ai)
#pragma unroll
                for (int m = 0; m < 4; ++m) {
                    const int r = ai * HALF + wr * 64 + m * 16 + fr;
                    float* dst = nullptr;
                    if (u.pm < MP / BM) { const int b = u.pm >> 3, t = (u.pm & 7) * 256 + r, p = t - (SEQ - W); if (p >= 0) dst = out + obase_p + ((size_t)(b * W + p) * 2 + kv) * 256; }
                    else { const int ms = (u.pm - MP / BM) * 256 + r, bd = ms >> 2, tt = ms & 3; dst = out + obase_s + ((size_t)(bd * W + W - 4 + tt) * 2 + kv) * 256; }
                    if (dst) {
#pragma unroll
                        for (int bj = 0; bj < 2; ++bj) { float* d2 = dst + bj * HALF + wc * 32 + 8 * fq; *(f32x4*)d2 = acc[ai][bj][m][0]; *(f32x4*)(d2 + 4) = acc[ai][bj][m][1]; }
                    }
                    asm volatile("" ::: "memory");
                }
        }
        else if (pn < 11) { store_tile<2>(acc, U, SGUW, (pn - 9) * 256, u, wr, wc, fr, fq); }
        else if (pn < 13) {
            bf16* dstb = GV + (pn - 11) * 256 + wc * 32 + 8 * fq; const int sidx = (pn - 11) * 4 + wc;
#pragma unroll
            for (int ai = 0; ai < 2; ++ai)
#pragma unroll
                for (int m = 0; m < 4; ++m) {
                    const size_t row = (size_t)(u.pm * BM + ai * HALF + wr * 64 + m * 16 + fr);
                    f32x4 t[2][2]; float s = 0.f;
#pragma unroll
                    for (int bj = 0; bj < 2; ++bj)
#pragma unroll
                        for (int n = 0; n < 2; ++n) { t[bj][n] = gelu4(acc[ai][bj][m][n]); s += (t[bj][n][0] + t[bj][n][1]) + (t[bj][n][2] + t[bj][n][3]); }
                    s += __shfl_xor(s, 16); s += __shfl_xor(s, 32);
                    const float mw = s * (1.0f / 64.0f); float q = 0.f;
#pragma unroll
                    for (int bj = 0; bj < 2; ++bj)
#pragma unroll
                        for (int n = 0; n < 2; ++n) { const f32x4 d = t[bj][n] - mw; q += (d[0] * d[0] + d[1] * d[1]) + (d[2] * d[2] + d[3] * d[3]); }
                    q += __shfl_xor(q, 16); q += __shfl_xor(q, 32);
                    if (fq == 0) sgv[row * 8 + sidx] = ((u64)__float_as_uint(q) << 32) | (u64)__float_as_uint(mw);
#pragma unroll
                    for (int bj = 0; bj < 2; ++bj) *(u32x4*)(dstb + row * SGUW + bj * HALF) = pack8(t[bj][0], t[bj][1]);
                    asm volatile("" ::: "memory");
                }
        }
        else if (pn < 17) { store_tile<3>(acc, SA, DM, (pn - 13) * 256, u, wr, wc, fr, fq); }
        else { store_tile<3>(acc, SB, DM, (pn - 17) * 256, u, wr, wc, fr, fq); }
    }
};

struct EpiGate {
    static constexpr bool HAS_PREP = false; static constexpr int MID_T = 4;
    const bf16* SA; const bf16* SB; bf16* T;
    __device__ __forceinline__ void prep(const Unit&, int, int) const {}
    __device__ __forceinline__ void mid(f32x4 (&acc)[2][2][4][2], const Unit& u, int wr, int wc, int fr, int fq) const {
        asm volatile("" : "+v"(fr), "+v"(fq));
#pragma unroll
        for (int ai = 0; ai < 2; ++ai)
#pragma unroll
            for (int m = 0; m < 4; ++m) {
                const size_t off = (size_t)(u.pm * BM + ai * HALF + wr * 64 + m * 16 + fr) * DM + u.pn * BM + wc * 32 + 8 * fq;
#pragma unroll
                for (int bj = 0; bj < 2; ++bj) {
                    f32x4 a0, a1, b0, b1; unpack8(*(const u32x4*)(SA + off + bj * HALF), a0, a1); unpack8(*(const u32x4*)(SB + off + bj * HALF), b0, b1);
#pragma unroll
                    for (int e = 0; e < 4; ++e) { acc[ai][bj][m][0][e] *= a0[e] * fast_rcp(b0[e]); acc[ai][bj][m][1][e] *= a1[e] * fast_rcp(b1[e]); }
                    asm volatile("" : "+v"(acc[ai][bj][m][0]), "+v"(acc[ai][bj][m][1]));
                }
                asm volatile("" ::: "memory");
            }
    }
    __device__ __forceinline__ void operator()(f32x4 (&acc)[2][2][4][2], const Unit& u, int wr, int wc, int fr, int fq, int) const {
        asm volatile("" : "+v"(fr), "+v"(fq));
#pragma unroll
        for (int ai = 0; ai < 2; ++ai)
#pragma unroll
            for (int m = 0; m < 4; ++m) {
                const size_t off = (size_t)(u.pm * BM + ai * HALF + wr * 64 + m * 16 + fr) * DM + u.pn * BM + wc * 32 + 8 * fq;
#pragma unroll
                for (int bj = 0; bj < 2; ++bj) { f32x4 b0, b1; unpack8(*(const u32x4*)(SB + off + bj * HALF), b0, b1); *(u32x4*)(T + off + bj * HALF) = pack8(acc[ai][bj][m][0] * b0, acc[ai][bj][m][1] * b1); }
            }
    }
};
}

#define XB_TMO      128
#define XB_XCNT(j)  (256  + 64 * (j))
#define XB_XSUB(j)  (1280 + 64 * (j))
#define XB_XGEN(j)  (2304 + 64 * (j))
#define XB_TOP      3328
#define XB_TOPGEN   3392
#define XCD_BAR_WORDS 3456
#define XB_SPIN_CAP (1u << 18)
__device__ __forceinline__ unsigned xb_ld(unsigned* p)              { return __hip_atomic_load(p, __ATOMIC_RELAXED, __HIP_MEMORY_SCOPE_AGENT); }
__device__ __forceinline__ unsigned xb_add(unsigned* p, unsigned v) { return __hip_atomic_fetch_add(p, v, __ATOMIC_RELAXED, __HIP_MEMORY_SCOPE_AGENT); }
__device__ __forceinline__ unsigned xb_xcc_id() { return (unsigned)__builtin_amdgcn_s_getreg((3 << 11) | 20) & 0xFu; }
#define XB_SPIN(cond, bar) do { unsigned _sp = 0; while (cond) { __builtin_amdgcn_s_sleep(1); \
    if ((++_sp & 255u) == 0u) { if (xb_ld(&(bar)[XB_TMO])) break; if (_sp > XB_SPIN_CAP) { atomicAdd(&(bar)[XB_TMO], 1u); break; } } } } while (0)
struct XcdBarrier { unsigned* bar; unsigned x; volatile LAS unsigned* st; };
__device__ __forceinline__ XcdBarrier xcd_barrier_post(unsigned* bar, volatile LAS unsigned* st) {
    XcdBarrier b; b.bar = bar; b.x = xb_xcc_id(); b.st = st;
    if (threadIdx.x == 0) (void)xb_add(&bar[XB_XCNT(b.x)], 1u);
    return b;
}
__device__ __forceinline__ void xcd_barrier_complete(unsigned* bar, unsigned x, unsigned& nloc, unsigned& nx) {
    const unsigned G = gridDim.x * gridDim.y * gridDim.z;
    unsigned sum, cnt, mine, sp = 0u;
    for (;;) {
        sum = 0u; cnt = 0u; mine = 0u;
#pragma unroll
        for (unsigned j = 0; j < 16; ++j) { const unsigned c = xb_ld(&bar[XB_XCNT(j)]); sum += c; cnt += (c > 0u) ? 1u : 0u; mine = (j == x) ? c : mine; }
        if (sum == G) break;
        __builtin_amdgcn_s_sleep(1);
        if ((++sp & 255u) == 0u) { if (xb_ld(&bar[XB_TMO])) break; if (sp > XB_SPIN_CAP) { atomicAdd(&bar[XB_TMO], 1u); break; } }
    }
    nloc = mine > 0u ? mine : 1u; nx = cnt > 0u ? cnt : 1u;
}
__device__ __forceinline__ void xcd_barrier(const XcdBarrier& b) {
    asm volatile("s_waitcnt vmcnt(0)" ::: "memory");
    __syncthreads();
    if (threadIdx.x == 0) {
        unsigned* bar = b.bar;
        __builtin_amdgcn_s_waitcnt(0);
        unsigned nloc = b.st[0], nx = b.st[1];
        if (nloc == 0u) { xcd_barrier_complete(bar, b.x, nloc, nx); b.st[0] = nloc; b.st[1] = nx; }
        const unsigned old = xb_add(&bar[XB_XSUB(b.x)], 1u);
        const unsigned gen = old / nloc;
        if (old + 1u == (gen + 1u) * nloc) {
            __builtin_amdgcn_fence(__ATOMIC_RELEASE, "agent");
            asm volatile("s_waitcnt vmcnt(0)" ::: "memory");
            const unsigned og = xb_add(&bar[XB_TOP], 1u);
            const unsigned tg = og / nx;
            if (og + 1u == (tg + 1u) * nx) xb_add(&bar[XB_TOPGEN], 1u);
            else XB_SPIN(xb_ld(&bar[XB_TOPGEN]) == tg, bar);
            __builtin_amdgcn_fence(__ATOMIC_ACQUIRE, "agent");
            xb_add(&bar[XB_XGEN(b.x)], 1u);
            asm volatile("s_waitcnt vmcnt(0)" ::: "memory");
        } else {
            XB_SPIN(xb_ld(&bar[XB_XGEN(b.x)]) == gen, bar);
            __builtin_amdgcn_fence(__ATOMIC_ACQUIRE, "agent");
            asm volatile("s_waitcnt vmcnt(0)" ::: "memory");
        }
    }
    __syncthreads();
}

struct Args { const float* in[27]; float* out; unsigned char* ws; int ph_lo, ph_hi, li, pad; };
struct Frame {
    LAS unsigned char* lds; int tid, lane, wave, vcu, G;
    const float* const* in; float* out; unsigned char* ws;
};
#define WSP(T, off) ((T*)(F.ws + (off)))

__device__ __forceinline__ void p0_tr_item(const float* W, int N, bf16* WT, int ldk, int koff, int dst_row0, const float* g, LAS float* scr, int k0, int n0, int lane) {
#pragma unroll 8
    for (int i = 0; i < 32; ++i) { const int kk = 2 * i + (lane >> 5); float w = W[(size_t)(k0 + kk) * N + n0 + (lane & 31)]; if (g) w *= g[k0 + kk]; scr[kk * 33 + (lane & 31)] = w; }
    asm volatile("s_waitcnt lgkmcnt(0)" ::: "memory");
    const int c = lane & 7;
#pragma unroll
    for (int j = 0; j < 4; ++j) { const int n = (lane >> 3) + 8 * j; const LAS float* s = scr + (8 * c) * 33 + n;
        u32x4 o; o.x = pk2(s[0 * 33], s[1 * 33]); o.y = pk2(s[2 * 33], s[3 * 33]); o.z = pk2(s[4 * 33], s[5 * 33]); o.w = pk2(s[6 * 33], s[7 * 33]);
        *(u32x4*)(WT + (size_t)(dst_row0 + n) * ldk + koff + k0 + 8 * c) = o; }
    asm volatile("s_waitcnt lgkmcnt(0)" ::: "memory");
}
__device__ __forceinline__ int swiglu_row(int n, int sel) { return 256 * (n >> 7) + (n & 127) + sel * 128; }

__device__ __forceinline__ void p0_prologue(Frame& F) {
    const int gw = F.vcu * 8 + F.wave, NGW = F.G * 8, lane = F.lane;
    const int gt = F.vcu * 512 + F.tid, NGT = F.G * 512;
    float* sm = WSP(float, WS_SMALL);
    for (int ct = gw; ct < 172; ct += NGW) {
        const float *W, *gg, *bb; int N, n, di; float* csd; float* bid; float b0 = 0.f;
        if (ct < 84) { W = F.in[11]; gg = F.in[6]; bb = F.in[7]; N = INW; n = ct * 64 + lane; di = n; csd = sm + SM_CS1; bid = sm + SM_B1; b0 = F.in[12][n]; }
        else { const int c2 = ct - 84, sel = c2 / 44, nb = c2 % 44; W = sel ? F.in[23] : F.in[22]; gg = F.in[20]; bb = F.in[21]; N = DFF; n = nb * 64 + lane; di = swiglu_row(n, sel); csd = sm + SM_CS2; bid = sm + SM_B2; }
        float cs = 0.f, bi = 0.f;
#pragma unroll 8
        for (int k = 0; k < DM; ++k) { const float w = W[(size_t)k * N + n]; cs += bfround(gg[k] * w); bi += bb[k] * w; }
        csd[di] = cs; bid[di] = bi + b0;
    }
    LAS float* scr = (LAS float*)(F.lds + F.wave * 16384);
    for (int it = gw; it < 12032; it += NGW) {
        int r = it;
        if (r < 2816) { const int sel = r / 1408, q = r % 1408, kb = q / 88, nb = q % 88; p0_tr_item(sel ? F.in[9] : F.in[8], DFF, WSP(bf16, WS_WF1), DM, 0, swiglu_row(nb * 32, sel), nullptr, scr, kb * 64, nb * 32, lane); continue; } r -= 2816;
        if (r < 1408) { const int kb = r / 32, nb = r % 32; p0_tr_item(F.in[10], DM, WSP(bf16, WS_WF1D), DFF, 0, nb * 32, nullptr, scr, kb * 64, nb * 32, lane); continue; } r -= 1408;
        if (r < 2688) { const int kb = r / 168, nb = r % 168; p0_tr_item(F.in[11], INW, WSP(bf16, WS_WIN), DM, 0, nb * 32, F.in[6], scr, kb * 64, nb * 32, lane); continue; } r -= 2688;
        if (r < 128) { const int kb = r / 32, nb = r % 32; p0_tr_item(F.in[17], DM, WSP(bf16, WS_WOAB), 768, 0, nb * 32, nullptr, scr, kb * 64, nb * 32, lane); continue; } r -= 128;
        if (r < 256) { const int kb = r / 32, nb = r % 32; p0_tr_item(F.in[18], DM, WSP(bf16, WS_WOAB), 768, 256, nb * 32, nullptr, scr, kb * 64, nb * 32, lane); continue; } r -= 256;
        if (r < 512) { const int kb = r / 32, nb = r % 32; p0_tr_item(F.in[19], DM, WSP(bf16, WS_WOUT), DM, 0, nb * 32, nullptr, scr, kb * 64, nb * 32, lane); continue; } r -= 512;
        if (r < 2816) { const int sel = r / 1408, q = r % 1408, kb = q / 88, nb = q % 88; p0_tr_item(sel ? F.in[23] : F.in[22], DFF, WSP(bf16, WS_WF2), DM, 0, swiglu_row(nb * 32, sel), F.in[20], scr, kb * 64, nb * 32, lane); continue; } r -= 2816;
        { const int kb = r / 32, nb = r % 32; p0_tr_item(F.in[24], DM, WSP(bf16, WS_WF2D), DFF, 0, nb * 32, nullptr, scr, kb * 64, nb * 32, lane); }
    }
    for (int i = gt; i < 12 * 192; i += NGT) { const int hj = i / 192, x = i % 192, rel = x - 32, g = hj >> 2;
        sm[SM_BT + i] = (rel >= 0 && rel <= 128) ? F.in[5][(int)T5BUCKET[g][rel] * 12 + hj] * LOG2E : NEGBIG; }
    for (int i = gt; i < 4 * 128 * 128; i += NGT) { const int p = (i >> 7) & 127, q = i & 127; WSP(bf16, WS_WSB)[i] = (bf16)(q <= p ? f2bf(F.in[15][i]) : 0u); }
    for (int i = gt; i < M * 128; i += NGT) { const int row = i >> 7, c8 = i & 127;
        const float* src = (row < MP ? F.in[0] + (size_t)row * DM : F.in[1] + (size_t)(row - MP) * DM) + c8 * 8;
        const f32x4 a = *(const f32x4*)src, b = *(const f32x4*)(src + 4);
        *(u32x4*)(WSP(bf16, WS_XB) + (size_t)row * DM + c8 * 8) = pack8(a, b); }
#pragma unroll
    for (int g = 0; g < 3; ++g) {
        const int W = 128 << (2 * g), per = (W - 4) * 128, tot = DEC_B * per;
        const f32x4* src = (const f32x4*)F.in[2 + g]; f32x4* dst = (f32x4*)(F.out + (g == 0 ? O_W0S : g == 1 ? O_W1S : O_W2S));
        for (int i = gt; i < tot; i += NGT) { const int bd = i / per, off = i - bd * per; dst[(size_t)bd * W * 128 + off] = src[(size_t)bd * W * 128 + 512 + off]; }
    }
}

__device__ __forceinline__ f32x16 mfma32(bf16x8 a, bf16x8 b, f32x16 c) { return __builtin_amdgcn_mfma_f32_32x32x16_bf16(a, b, c, 0, 0, 0); }
__device__ __forceinline__ s16x4 trld(const LAS unsigned char* p) { return __builtin_bit_cast(s16x4, __builtin_amdgcn_ds_read_tr16_b64_v4i16((LAS s16x4*)p)); }

__device__ __forceinline__ void attn_unit(Frame& F, int au, LAS unsigned char* wl, int& cur_gj) {
    const int lane = F.lane, r32 = lane & 31, hi = lane >> 5;
    const int blk = au & 63, bg = au >> 6, gj = bg % 12, b = bg / 12, g = gj >> 2, j = gj & 3;
    const int dsh = 2 * g, d = 1 << dsh, bpr = 64 >> dsh, r = blk >> (6 - dsh), m0 = (blk & (bpr - 1)) * 32;
    const size_t rowbase = (size_t)b * SEQ; const int hc = g * 256 + j * 64;
    const bf16* Qb = WSP(bf16, WS_Q); const bf16* Kb = WSP(bf16, WS_K); const bf16* Vb = WSP(bf16, WS_V);
    LAS float* tab = (LAS float*)(wl + 8192);
    if (gj != cur_gj) { const float* bt = WSP(float, WS_SMALL) + SM_BT + gj * 192;
#pragma unroll
        for (int i = 0; i < 3; ++i) tab[lane + 64 * i] = bt[lane + 64 * i];
        cur_gj = gj; }
    const int tq = (m0 + r32) * d + r;
    const bf16* qp = Qb + (rowbase + tq) * QKVW + hc + 8 * hi;
    bf16x8 qf[4];
#pragma unroll
    for (int s = 0; s < 4; ++s) qf[s] = *(const bf16x8*)(qp + 16 * s);
    const int i0 = m0 >= 128 ? 0 : (128 - m0) >> 5;
    f32x16 sc[5];
#pragma unroll
    for (int i = 0; i < 5; ++i) {
        if (i >= i0) {
            const bf16* kp = Kb + (rowbase + (size_t)((m0 - 128 + 32 * i + r32) * d + r)) * QKVW + hc + 8 * hi;
            bf16x8 kf[4];
#pragma unroll
            for (int s = 0; s < 4; ++s) kf[s] = *(const bf16x8*)(kp + 16 * s);
            f32x16 a = {};
#pragma unroll
            for (int s = 0; s < 4; ++s) a = mfma32(kf[s], qf[s], a);
            const LAS float* tb = tab + (r32 - 4 * hi + 4) + (156 - 32 * i);
#pragma unroll
            for (int R = 0; R < 16; ++R) a[R] += tb[-((R & 3) + 8 * (R >> 2))];
            sc[i] = a;
        } else {
#pragma unroll
            for (int R = 0; R < 16; ++R) sc[i][R] = NEGBIG;
        }
    }
    float mx = NEGBIG;
#pragma unroll
    for (int i = 0; i < 5; ++i)
#pragma unroll
        for (int R = 0; R < 16; ++R) mx = fmaxf(mx, sc[i][R]);
    mx = fmaxf(mx, __shfl_xor(mx, 32));
    float l = 0.f;
#pragma unroll
    for (int i = 0; i < 5; ++i)
#pragma unroll
        for (int R = 0; R < 16; ++R) { const float p = fast_exp2(sc[i][R] - mx); sc[i][R] = p; l += p; }
    l += __shfl_xor(l, 32);
    f32x16 o0 = {}, o1 = {};
    const int vaoff = (4 * hi + ((lane & 15) >> 2)) * 64 + ((lane >> 4) & 1) * 32 + (lane & 3) * 8;
#pragma unroll
    for (int i = 0; i < 5; ++i) {
        if (i >= i0) {
            LAS unsigned char* vb = wl + (i & 1) * 4096;
#pragma unroll
            for (int ii = 0; ii < 4; ++ii) { const int key = 8 * ii + (lane >> 3), ch = lane & 7;
                const u32x4 w = *(const u32x4*)(Vb + (rowbase + (size_t)((m0 - 128 + 32 * i + key) * d + r)) * QKVW + hc + ch * 8);
                *(LAS u32x4*)(vb + (ch >> 2) * 2048 + key * 64 + (ch & 3) * 16) = w; }
            const LAS unsigned char* va = vb + vaoff;
#pragma unroll
            for (int s = 0; s < 2; ++s) {
                u32x4 pw; pw.x = cvt_pk_bf16(sc[i][8 * s + 0], sc[i][8 * s + 1]); pw.y = cvt_pk_bf16(sc[i][8 * s + 2], sc[i][8 * s + 3]); pw.z = cvt_pk_bf16(sc[i][8 * s + 4], sc[i][8 * s + 5]); pw.w = cvt_pk_bf16(sc[i][8 * s + 6], sc[i][8 * s + 7]);
                const bf16x8 pb = __builtin_bit_cast(bf16x8, pw);
                { const s16x4 lo = trld(va + s * 1024), h2 = trld(va + s * 1024 + 512); const bf16x8 A = {lo[0], lo[1], lo[2], lo[3], h2[0], h2[1], h2[2], h2[3]}; o0 = mfma32(A, pb, o0); }
                { const s16x4 lo = trld(va + 2048 + s * 1024), h2 = trld(va + 2048 + s * 1024 + 512); const bf16x8 A = {lo[0], lo[1], lo[2], lo[3], h2[0], h2[1], h2[2], h2[3]}; o1 = mfma32(A, pb, o1); }
            }
        }
    }
    const float inv = 1.0f / l;
    bf16* op = WSP(bf16, WS_OG) + (rowbase + tq) * QKVW + hc + 4 * hi;
#pragma unroll
    for (int G4 = 0; G4 < 4; ++G4) {
        u32x2 w0; w0.x = cvt_pk_bf16(o0[4 * G4] * inv, o0[4 * G4 + 1] * inv); w0.y = cvt_pk_bf16(o0[4 * G4 + 2] * inv, o0[4 * G4 + 3] * inv); *(u32x2*)(op + 8 * G4) = w0;
        u32x2 w1; w1.x = cvt_pk_bf16(o1[4 * G4] * inv, o1[4 * G4 + 1] * inv); w1.y = cvt_pk_bf16(o1[4 * G4 + 2] * inv, o1[4 * G4 + 3] * inv); *(u32x2*)(op + 32 + 8 * G4) = w1;
    }
    if (hi == 0) WSP(float, WS_LSE)[(rowbase + tq) * 12 + gj] = (mx + __builtin_amdgcn_logf(l)) * LN2F;
}

__device__ __forceinline__ void attn_sample_task(Frame& F, int task, LAS unsigned char* wl) {
    const int lane = F.lane, t = task & 3, gj = (task >> 2) % 12, bd = task / 48, g = gj >> 2, j = gj & 3;
    const int W = 128 << (2 * g), d = 1 << (2 * g), hc = g * 256 + j * 64;
    const size_t row = (size_t)MP + bd * 4 + t;
    const float* st = (g == 0 ? F.in[2] : g == 1 ? F.in[3] : F.in[4]) + (size_t)bd * W * 512 + j * 64;
    const float* nw = F.out + (g == 0 ? O_W0S : g == 1 ? O_W1S : O_W2S) + (size_t)bd * W * 512 + j * 64;
    const float* bt = WSP(float, WS_SMALL) + SM_BT + gj * 192 + 32;
    LAS float* scb = (LAS float*)(wl + 10240);
    const u32x2 qw = *(const u32x2*)(WSP(bf16, WS_Q) + row * QKVW + hc + 4 * (lane & 15));
    const f32x4 qv = {bflo(qw.x), bfhi(qw.x), bflo(qw.y), bfhi(qw.y)};
    for (int it = 0; it < 33; ++it) {
        const int i = it * 4 + (lane >> 4), ii = i < 128 ? i : 128, idx = W + t - ii * d;
        const float* kp = (idx < W ? st + (size_t)idx * 512 : nw + (size_t)(idx - 4) * 512) + 4 * (lane & 15);
        const f32x4 kv = *(const f32x4*)kp;
        float s = (qv[0] * kv[0] + qv[1] * kv[1]) + (qv[2] * kv[2] + qv[3] * kv[3]);
        s += __shfl_xor(s, 1); s += __shfl_xor(s, 2); s += __shfl_xor(s, 4); s += __shfl_xor(s, 8);
        if ((lane & 15) == 0 && i <= 128) scb[i] = s + bt[ii];
    }
    asm volatile("s_waitcnt lgkmcnt(0)" ::: "memory");
    const float v0 = scb[lane], v1 = scb[lane + 64], v2 = lane == 0 ? scb[128] : NEGBIG;
    const float mx = wave_max(fmaxf(fmaxf(v0, v1), v2));
    const float p0 = fast_exp2(v0 - mx), p1 = fast_exp2(v1 - mx), p2 = lane == 0 ? fast_exp2(v2 - mx) : 0.f;
    const float l = wave_sum(p0 + p1 + p2);
    scb[lane] = p0; scb[lane + 64] = p1; if (lane == 0) scb[128] = p2;
    asm volatile("s_waitcnt lgkmcnt(0)" ::: "memory");
    float o = 0.f;
#pragma unroll 4
    for (int i = 0; i <= 128; ++i) { const int idx = W + t - i * d; const float* vp = (idx < W ? st + (size_t)idx * 512 : nw + (size_t)(idx - 4) * 512) + 256; o += scb[i] * vp[lane]; }
    WSP(bf16, WS_OG)[row * QKVW + hc + lane] = (bf16)f2bf(o / l);
    if (lane == 0) WSP(float, WS_LSE)[row * 12 + gj] = (mx + __builtin_amdgcn_logf(l)) * LN2F;
    asm volatile("s_waitcnt lgkmcnt(0)" ::: "memory");
}

__device__ __forceinline__ void sgu_unit(Frame& F, int su, LAS unsigned char* wl) {
    const int lane = F.lane, r32 = lane & 31, hi = lane >> 5;
    const int cb = su & 3, gg = (su >> 2) & 3, chunk = su >> 4, c0 = gg * 128 + cb * 32; const size_t row0 = (size_t)chunk * 128;
    LAS f32x2* st = (LAS f32x2*)(wl + 9216);
    const u64* sgv = WSP(u64, WS_SGV);
#pragma unroll
    for (int h = 0; h < 2; ++h) { const int rr = lane + 64 * h; const u32x4* p = (const u32x4*)(sgv + (row0 + rr) * 8);
        const u32x4 a = p[0], b = p[1], c = p[2], dd = p[3];
        const float mn[8] = {__uint_as_float(a.x), __uint_as_float(a.z), __uint_as_float(b.x), __uint_as_float(b.z), __uint_as_float(c.x), __uint_as_float(c.z), __uint_as_float(dd.x), __uint_as_float(dd.z)};
        const float m2[8] = {__uint_as_float(a.y), __uint_as_float(a.w), __uint_as_float(b.y), __uint_as_float(b.w), __uint_as_float(c.y), __uint_as_float(c.w), __uint_as_float(dd.y), __uint_as_float(dd.w)};
        float smn = 0.f;
#pragma unroll
        for (int i = 0; i < 8; ++i) smn += mn[i];
        const float mt = smn * 0.125f; float q = 0.f;
#pragma unroll
        for (int i = 0; i < 8; ++i) { const float e = mn[i] - mt; q += m2[i] + 64.0f * e * e; }
        st[rr] = (f32x2){mt, 1.0f / sqrtf(q * (1.0f / 512.0f) + LN_EPS)}; }
    const int ch = lane & 3;
    const float* lg = F.in[13] + c0 + ch * 8; const float* lb = F.in[14] + c0 + ch * 8;
    const f32x4 g0 = *(const f32x4*)lg, g1 = *(const f32x4*)(lg + 4), b0 = *(const f32x4*)lb, b1 = *(const f32x4*)(lb + 4);
    const bf16* GVb = WSP(bf16, WS_GV);
#pragma unroll
    for (int it = 0; it < 8; ++it) { const int rw = 16 * it + (lane >> 2);
        const u32x4 w = *(const u32x4*)(GVb + (row0 + rw) * SGUW + c0 + ch * 8); f32x4 x0, x1; unpack8(w, x0, x1); const f32x2 s = st[rw];
        x0 = (x0 - s.x) * s.y * g0 + b0; x1 = (x1 - s.x) * s.y * g1 + b1;
        *(LAS u32x4*)(wl + rw * 64 + ch * 16) = pack8(x0, x1); }
    const LAS unsigned char* va = wl + (8 * hi + ((lane & 15) >> 2)) * 64 + ((lane >> 4) & 1) * 32 + (lane & 3) * 8;
    bf16x8 Af[8];
#pragma unroll
    for (int ks = 0; ks < 8; ++ks) { const s16x4 lo = trld(va + ks * 1024), h2 = trld(va + ks * 1024 + 256); Af[ks] = (bf16x8){lo[0], lo[1], lo[2], lo[3], h2[0], h2[1], h2[2], h2[3]}; }
    const bf16* Wsb = WSP(bf16, WS_WSB) + (size_t)gg * 128 * 128;
    const bf16* Ub = WSP(bf16, WS_U); bf16* AY = WSP(bf16, WS_AY);
#pragma unroll
    for (int pt = 0; pt < 4; ++pt) {
        f32x16 acc = {};
#pragma unroll
        for (int ks = 0; ks < 2 * pt + 2; ++ks) { const bf16x8 B = *(const bf16x8*)(Wsb + (size_t)(32 * pt + r32) * 128 + 16 * ks + 8 * hi); acc = mfma32(Af[ks], B, acc); }
        const float sbv = F.in[16][gg * 128 + 32 * pt + r32];
        const size_t prow = row0 + 32 * pt + r32;
#pragma unroll
        for (int G4 = 0; G4 < 4; ++G4) { const int c4 = 8 * G4 + 4 * hi;
            const u32x2 uw = *(const u32x2*)(Ub + prow * SGUW + c0 + c4);
            u32x2 y; y.x = cvt_pk_bf16(bflo(uw.x) * (acc[4 * G4] + sbv), bfhi(uw.x) * (acc[4 * G4 + 1] + sbv)); y.y = cvt_pk_bf16(bflo(uw.y) * (acc[4 * G4 + 2] + sbv), bfhi(uw.y) * (acc[4 * G4 + 3] + sbv));
            *(u32x2*)(AY + prow * 768 + 256 + c0 + c4) = y; }
    }
    asm volatile("s_waitcnt lgkmcnt(0)" ::: "memory");
}
__device__ __forceinline__ void sgu_sample_task(Frame& F, int bd) {
    const int lane = F.lane, c = lane * 8, gg = lane >> 4;
    const size_t row0 = (size_t)MP + bd * 4;
    const u64* sgv = WSP(u64, WS_SGV); const bf16* GVb = WSP(bf16, WS_GV); const bf16* Ub = WSP(bf16, WS_U); bf16* AY = WSP(bf16, WS_AY);
    const f32x4 g0 = *(const f32x4*)(F.in[13] + c), g1 = *(const f32x4*)(F.in[13] + c + 4), b0 = *(const f32x4*)(F.in[14] + c), b1 = *(const f32x4*)(F.in[14] + c + 4);
    f32x4 vn[4][2];
#pragma unroll
    for (int t = 0; t < 4; ++t) {
        const u32x4* p = (const u32x4*)(sgv + (row0 + t) * 8);
        const u32x4 a = p[0], b = p[1], cc = p[2], dd = p[3];
        const float mn[8] = {__uint_as_float(a.x), __uint_as_float(a.z), __uint_as_float(b.x), __uint_as_float(b.z), __uint_as_float(cc.x), __uint_as_float(cc.z), __uint_as_float(dd.x), __uint_as_float(dd.z)};
        const float m2[8] = {__uint_as_float(a.y), __uint_as_float(a.w), __uint_as_float(b.y), __uint_as_float(b.w), __uint_as_float(cc.y), __uint_as_float(cc.w), __uint_as_float(dd.y), __uint_as_float(dd.w)};
        float smn = 0.f;
#pragma unroll
        for (int i = 0; i < 8; ++i) smn += mn[i];
        const float mt = smn * 0.125f; float q = 0.f;
#pragma unroll
        for (int i = 0; i < 8; ++i) { const float e = mn[i] - mt; q += m2[i] + 64.0f * e * e; }
        const float rs = 1.0f / sqrtf(q * (1.0f / 512.0f) + LN_EPS);
        f32x4 x0, x1; unpack8(*(const u32x4*)(GVb + (row0 + t) * SGUW + c), x0, x1);
        vn[t][0] = (x0 - mt) * rs * g0 + b0; vn[t][1] = (x1 - mt) * rs * g1 + b1;
        float* sv = F.out + O_SV + (size_t)(bd * 4 + t) * SGUW + c; *(f32x4*)sv = vn[t][0]; *(f32x4*)(sv + 4) = vn[t][1];
    }
#pragma unroll
    for (int p = 0; p < 4; ++p) {
        const float sbv = F.in[16][gg * 128 + p];
        f32x4 m0 = {sbv, sbv, sbv, sbv}, m1 = m0;
#pragma unroll
        for (int q = 0; q <= p; ++q) { const float w = F.in[15][(size_t)(gg * 128 + p) * 128 + q]; m0 += w * vn[q][0]; m1 += w * vn[q][1]; }
        f32x4 u0, u1; unpack8(*(const u32x4*)(Ub + (row0 + p) * SGUW + c), u0, u1);
        *(u32x4*)(AY + (row0 + p) * 768 + 256 + c) = pack8(u0 * m0, u1 * m1);
    }
}


#ifdef MK_PROBE
__device__ __constant__ int PRB_B[8] = {0, 0, 3, 5, 7, 12, 20, 31};
__device__ __constant__ int PRB_T[8] = {0, 37, 130, 1000, 2047, 255, 1290, 64};
__device__ __forceinline__ size_t probe_row(int w) { return (size_t)PRB_B[w] * SEQ + PRB_T[w]; }
__device__ __forceinline__ void probe_put(unsigned* ctl, int stage, float ref, float got) {
    float d = fabsf(ref - got) / (fabsf(ref) + 0.3f); if (!(d == d)) d = 1e30f; d = wave_max(d);
    if ((threadIdx.x & 63) == 0) atomicMax(ctl + 64 + stage, __float_as_uint(d));
}
__device__ __forceinline__ float probe_dot(const LAS float* vec, const float* W, int K, int ldw, int col) {
    float a = 0.f;
#pragma unroll 8
    for (int k = 0; k < K; ++k) a += vec[k] * W[(size_t)k * ldw + col];
    return a;
}
__device__ __forceinline__ void probe_ln_row(LAS float* vec, const bf16* rowp, const float* g, const float* b, int lane) {
    float x[16], s = 0.f;
    for (int i = 0; i < 16; ++i) { x[i] = bflo((unsigned)rowp[i * 64 + lane]); s += x[i]; }
    const float mean = wave_sum(s) * (1.0f / 1024.0f); float q = 0.f;
    for (int i = 0; i < 16; ++i) q += (x[i] - mean) * (x[i] - mean);
    const float rs = 1.0f / sqrtf(wave_sum(q) * (1.0f / 1024.0f) + LN_EPS);
    for (int i = 0; i < 16; ++i) { const int c = i * 64 + lane; vec[c] = (x[i] - mean) * rs * g[c] + b[c]; }
    asm volatile("s_waitcnt lgkmcnt(0)" ::: "memory");
}
__device__ __forceinline__ void probe_stage(Frame& F, unsigned* ctl, int stage) {
    const int lane = F.lane, w = F.wave; const size_t row = probe_row(w);
    LAS float* vec = (LAS float*)(F.lds + w * 16384);
    if (stage == 0) {
        const float* x = F.in[0] + row * DM;
        for (int i = 0; i < 16; ++i) vec[i * 64 + lane] = x[i * 64 + lane];
        asm volatile("s_waitcnt lgkmcnt(0)" ::: "memory");
        const int hc = lane * 44 + (lane * 5 + w) % 44; const float a = probe_dot(vec, F.in[8], DM, DFF, hc), b = probe_dot(vec, F.in[9], DM, DFF, hc);
        probe_put(ctl, 0, a * b / (1.0f + expf(-a)), bflo((unsigned)WSP(bf16, WS_ACT)[row * DFF + hc]));
        for (int i = 0; i < 44; ++i) vec[i * 64 + lane] = bflo((unsigned)WSP(bf16, WS_ACT)[row * DFF + i * 64 + lane]);
        asm volatile("s_waitcnt lgkmcnt(0)" ::: "memory");
        const int c = lane * 16 + (lane * 7 + w * 3) % 16; probe_put(ctl, 1, ALPHA * x[c] + 0.5f * probe_dot(vec, F.in[10], DFF, DM, c), bflo((unsigned)WSP(bf16, WS_V1)[row * DM + c]));
    } else if (stage == 1) {
        probe_ln_row(vec, WSP(bf16, WS_V1) + row * DM, F.in[6], F.in[7], lane);
        const int c = lane * 84 + (lane * 11 + w * 7) % 84; const float z = probe_dot(vec, F.in[11], DM, INW, c) + F.in[12][c];
        float ref, got;
        if (c < 768) { ref = z * QSCALE; got = bflo((unsigned)WSP(bf16, WS_Q)[row * QKVW + c]); }
        else if (c < 1536) { ref = z; got = bflo((unsigned)WSP(bf16, WS_K)[row * QKVW + c - 768]); }
        else if (c < 2304) { ref = z; got = bflo((unsigned)WSP(bf16, WS_V)[row * QKVW + c - 1536]); }
        else if (c < 2816) { ref = 0.5f * z * (1.0f + erff(z * 0.70710678f)); got = bflo((unsigned)WSP(bf16, WS_U)[row * SGUW + c - 2304]); }
        else if (c < 3328) { ref = 0.5f * z * (1.0f + erff(z * 0.70710678f)); got = bflo((unsigned)WSP(bf16, WS_GV)[row * SGUW + c - 2816]); }
        else if (c < 4352) { ref = 1.0f / (1.0f + expf(-z)); got = bflo((unsigned)WSP(bf16, WS_SA)[row * DM + c - 3328]); }
        else { ref = 1.0f / (1.0f + expf(-z)); got = bflo((unsigned)WSP(bf16, WS_SB)[row * DM + c - 4352]); }
        if (c >= 4352) {
            float csr = 0.f, bir = 0.f; unsigned wbad = 0u;
            for (int k = 0; k < DM; ++k) { const float wv = F.in[11][(size_t)k * INW + c]; csr += bfround(F.in[6][k] * wv); bir += F.in[7][k] * wv;
                if (f2bf(F.in[6][k] * wv) != (unsigned)WSP(bf16, WS_WIN)[(size_t)c * DM + k]) wbad = 1u; }
            bir += F.in[12][c];
            const float* smm = WSP(float, WS_SMALL);
            if (fabsf(csr - smm[SM_CS1 + c]) > 1e-3f) atomicOr(ctl + 98, 1u);
            if (fabsf(bir - smm[SM_B1 + c]) > 1e-3f) atomicOr(ctl + 98, 2u);
            if (wbad) atomicOr(ctl + 98, 4u);
        }
        if (c >= 4352) { float d = fabsf(ref - got) / (fabsf(ref) + 0.3f); if (d > 0.1f) { atomicOr(ctl + 96, 1u << (c & 7)); atomicOr(ctl + 97, 1u << ((c - 4352) >> 7)); } }
        { const int cls = c < 768 ? 0 : c < 1536 ? 1 : c < 2304 ? 2 : c < 2816 ? 3 : c < 3328 ? 4 : c < 4352 ? 5 : 6;
          for (int k = 0; k < 7; ++k) probe_put(ctl, 8 + k, cls == k ? ref : 0.f, cls == k ? got : 0.f); }
        probe_put(ctl, 2, ref, got);
    } else if (stage == 2) {
        const bf16* OG = WSP(bf16, WS_OG) + row * QKVW; const float* LSE = WSP(float, WS_LSE) + row * 12;
        for (int q = 0; q < 4; ++q) { const int c = lane * 4 + q, j = c >> 6;
            const float l0 = LSE[j], l1 = LSE[4 + j], l2 = LSE[8 + j], mx = fmaxf(fmaxf(l0, l1), l2), e0 = expf(l0 - mx), e1 = expf(l1 - mx), e2 = expf(l2 - mx);
            const float ref = (bflo((unsigned)OG[c]) * e0 + bflo((unsigned)OG[256 + c]) * e1 + bflo((unsigned)OG[512 + c]) * e2) / (e0 + e1 + e2);
            probe_put(ctl, 3, ref, bflo((unsigned)WSP(bf16, WS_AY)[row * 768 + c])); }
    } else if (stage == 3) {
        for (int i = 0; i < 12; ++i) vec[i * 64 + lane] = bflo((unsigned)WSP(bf16, WS_AY)[row * 768 + i * 64 + lane]);
        asm volatile("s_waitcnt lgkmcnt(0)" ::: "memory");
        const int c = lane * 16 + (lane * 7 + w * 3) % 16; const float a = probe_dot(vec, F.in[17], 256, DM, c), b = probe_dot(vec + 256, F.in[18], 512, DM, c);
        probe_put(ctl, 4, bflo((unsigned)WSP(bf16, WS_SA)[row * DM + c]) * a + bflo((unsigned)WSP(bf16, WS_SB)[row * DM + c]) * b, bflo((unsigned)WSP(bf16, WS_XB)[row * DM + c]));
    } else if (stage == 4) {
        probe_ln_row(vec, WSP(bf16, WS_V1) + row * DM, F.in[6], F.in[7], lane);
        const int c = lane * 16 + (lane * 7 + w * 3) % 16; const float h1 = vec[c];
        for (int i = 0; i < 16; ++i) vec[i * 64 + lane] = bflo((unsigned)WSP(bf16, WS_XB)[row * DM + i * 64 + lane]);
        asm volatile("s_waitcnt lgkmcnt(0)" ::: "memory");
        probe_put(ctl, 5, ALPHA * h1 + probe_dot(vec, F.in[19], DM, DM, c), bflo((unsigned)WSP(bf16, WS_V2)[row * DM + c]));
    } else if (stage == 5) {
        probe_ln_row(vec, WSP(bf16, WS_V2) + row * DM, F.in[20], F.in[21], lane);
        const int hc = lane * 44 + (lane * 5 + w) % 44; const float a = probe_dot(vec, F.in[22], DM, DFF, hc), b = probe_dot(vec, F.in[23], DM, DFF, hc);
        probe_put(ctl, 6, a * b / (1.0f + expf(-a)), bflo((unsigned)WSP(bf16, WS_ACT)[row * DFF + hc]));
    } else {
        probe_ln_row(vec, WSP(bf16, WS_V2) + row * DM, F.in[20], F.in[21], lane);
        const int c = lane * 16 + (lane * 7 + w * 3) % 16; const float h2 = vec[c];
        for (int i = 0; i < 44; ++i) vec[i * 64 + lane] = bflo((unsigned)WSP(bf16, WS_ACT)[row * DFF + i * 64 + lane]);
        asm volatile("s_waitcnt lgkmcnt(0)" ::: "memory");
        probe_put(ctl, 7, ALPHA * h2 + 0.5f * probe_dot(vec, F.in[24], DFF, DM, c), F.out[O_Y + row * DM + c]);
    }
    asm volatile("s_waitcnt lgkmcnt(0)" ::: "memory");
}
#define PROBE(stage) do { if (F.vcu == 0) probe_stage(F, ctl, stage); __syncthreads(); } while (0)
#else
#define PROBE(stage) do {} while (0)
#endif
constexpr int N_PHASES = 11;
__global__ void __launch_bounds__(512, 2) mk_fwd(Args args) {
    extern __shared__ __attribute__((aligned(16))) unsigned char lds_raw[];
    Frame F;
    F.lds = (LAS unsigned char*)lds_raw;
    F.tid = threadIdx.x; F.lane = F.tid & 63; F.wave = __builtin_amdgcn_readfirstlane(F.tid >> 6);
    F.G = gridDim.x; { const int bx = blockIdx.x; F.vcu = (F.G % 8 == 0) ? (bx % 8) * (F.G / 8) + bx / 8 : bx; }
    F.in = args.in; F.out = args.out; F.ws = args.ws;
    volatile LAS unsigned* MISC = (volatile LAS unsigned*)(F.lds + MISC_OFF);
    for (int u = F.tid; u < (LDS_BYTES - MISC_OFF) / 4; u += 512) ((LAS unsigned*)(F.lds + MISC_OFF))[u] = 0u;
    __syncthreads();
    unsigned* ctl = (unsigned*)(F.ws + WS_CTL);
    XcdBarrier bar; bar.bar = ctl + CW_BAR; bar.x = 0; bar.st = nullptr;
    if (MK_N_LAUNCHES == 1) bar = xcd_barrier_post(ctl + CW_BAR, MISC + 8);
    const int lo = args.ph_lo, hi = args.ph_hi;
#ifdef MK_PROBE
    if (lo >= 100) { if (F.vcu == 0) probe_stage(F, (unsigned*)(F.ws + WS_CTL), lo - 100); return; }
#endif
#ifdef MK_ONLY
#define IN(k) ((k) == MK_ONLY)
#else
#define IN(k) (lo <= (k) && (k) < hi)
#endif
#define SEAM(k) do { if (IN(k) && IN((k) + 1)) xcd_barrier(bar); } while (0)
    LAS f32x2* stab = (LAS f32x2*)(F.lds + STAB_OFF);
#ifdef MK_PROBE
    const bool alt = (args.li == 99);
    if (args.li >= 200) {
        const int k = args.li - 200; const unsigned* A = (const unsigned*)(F.ws + (k == 0 ? WS_ACT : k == 1 ? WS_V1 : WS_V2)); const unsigned* B = (const unsigned*)(F.ws + (k == 0 ? 1412 * MiB : k == 1 ? 1767 * MiB : 1896 * MiB));
        const size_t n = (size_t)M * (k == 0 ? DFF : DM) / 2; unsigned cnt = 0;
        for (size_t i = (size_t)F.vcu * 512 + F.tid; i < n; i += (size_t)F.G * 512) cnt += (A[i] != B[i]) ? 1u : 0u;
        if (cnt) atomicAdd((unsigned*)(F.ws + WS_CTL) + 80 + k, cnt);
        return;
    }
#else
    const bool alt = false;
#endif
    const int gw = F.vcu * 8 + F.wave, NGW = F.G * 8;
    const int gt = F.vcu * 512 + F.tid, NGT = F.G * 512;
    float* sm = WSP(float, WS_SMALL);

    if (IN(0)) { p0_prologue(F); }
    SEAM(0);
    if (IN(1)) {
        pg8::Gemm g{WSP(bf16, WS_XB), WSP(bf16, WS_WF1), M, NFF2, DM}; pg8::StaticOrder S; S.init(M, NFF2, F.G, (int)blockIdx.x);
        pg8::EpiSwiglu<false> E{alt ? WSP(bf16, 1412 * MiB) : WSP(bf16, WS_ACT), nullptr, nullptr, nullptr, stab};
        pg8::gemm_phase(F.lds, g, S, E);
    }
    SEAM(1);
    if (IN(2)) {
        pg8::Gemm g{WSP(bf16, WS_ACT), WSP(bf16, WS_WF1D), M, DM, DFF}; pg8::StaticOrder S; S.init(M, DM, F.G, (int)blockIdx.x);
        pg8::EpiDown<0> E{F.in[0], F.in[1], nullptr, nullptr, nullptr, nullptr, stab, alt ? WSP(bf16, 1767 * MiB) : WSP(bf16, WS_V1), nullptr, alt ? WSP(u64, WS_S3) : WSP(u64, WS_S1), 0.5f};
        pg8::gemm_phase(F.lds, g, S, E);
    }
    SEAM(2);
    if (IN(3)) {
        pg8::Gemm g{WSP(bf16, WS_V1), WSP(bf16, WS_WIN), M, INW, DM}; pg8::StaticOrder S; S.init(M, INW, F.G, (int)blockIdx.x);
        pg8::EpiWin E{sm + SM_CS1, sm + SM_B1, WSP(u64, WS_S1), stab, WSP(bf16, WS_Q), WSP(bf16, WS_K), WSP(bf16, WS_V), WSP(bf16, WS_U), WSP(bf16, WS_GV), WSP(bf16, WS_SA), WSP(bf16, WS_SB), WSP(u64, WS_SGV), F.out};
        pg8::gemm_phase(F.lds, g, S, E);
    }
    SEAM(3);
    if (IN(4)) {
        LAS unsigned char* wl = F.lds + F.wave * 16384;
        int cur_gj = -1;
        for (int au = gw; au < NB * 12 * 64; au += NGW) attn_unit(F, au, wl, cur_gj);
        for (int su = gw; su < (MP / 128) * 16; su += NGW) sgu_unit(F, su, wl);
        for (int task = gw; task < DEC_B * 48; task += NGW) attn_sample_task(F, task, wl);
        for (int bd = gw; bd < DEC_B; bd += NGW) sgu_sample_task(F, bd);
    }
    SEAM(4);
    if (IN(5)) {
        const bf16* OG = WSP(bf16, WS_OG); const float* LSE = WSP(float, WS_LSE); bf16* AY = WSP(bf16, WS_AY);
        for (int i = gt; i < M * 32; i += NGT) { const size_t row = (size_t)(i >> 5); const int c8 = i & 31, j = c8 >> 3;
            const float l0 = LSE[row * 12 + j], l1 = LSE[row * 12 + 4 + j], l2 = LSE[row * 12 + 8 + j], mx = fmaxf(fmaxf(l0, l1), l2);
            const float e0 = __expf(l0 - mx), e1 = __expf(l1 - mx), e2 = __expf(l2 - mx), inv = 1.0f / (e0 + e1 + e2);
            f32x4 a0, a1, b0, b1, c0, c1; unpack8(*(const u32x4*)(OG + row * QKVW + c8 * 8), a0, a1); unpack8(*(const u32x4*)(OG + row * QKVW + 256 + c8 * 8), b0, b1); unpack8(*(const u32x4*)(OG + row * QKVW + 512 + c8 * 8), c0, c1);
            *(u32x4*)(AY + row * 768 + c8 * 8) = pack8((a0 * e0 + b0 * e1 + c0 * e2) * inv, (a1 * e0 + b1 * e1 + c1 * e2) * inv); }
    }
    SEAM(5);
    if (IN(6)) {
        pg8::Gemm g{WSP(bf16, WS_AY), WSP(bf16, WS_WOAB), M, DM, 768}; pg8::StaticOrder S; S.init(M, DM, F.G, (int)blockIdx.x);
        pg8::EpiGate E{WSP(bf16, WS_SA), WSP(bf16, WS_SB), WSP(bf16, WS_XB)};
        pg8::gemm_phase(F.lds, g, S, E);
    }
    SEAM(6);
    if (IN(7)) {
        pg8::Gemm g{WSP(bf16, WS_XB), WSP(bf16, WS_WOUT), M, DM, DM}; pg8::StaticOrder S; S.init(M, DM, F.G, (int)blockIdx.x);
        pg8::EpiDown<1> E{nullptr, nullptr, WSP(bf16, WS_V1), F.in[6], F.in[7], WSP(u64, WS_S1), stab, alt ? WSP(bf16, 1896 * MiB) : WSP(bf16, WS_V2), nullptr, alt ? WSP(u64, WS_S3) : WSP(u64, WS_S2), 1.0f};
        pg8::gemm_phase(F.lds, g, S, E);
    }
    SEAM(7);
    if (IN(8)) {
        pg8::Gemm g{WSP(bf16, WS_V2), WSP(bf16, WS_WF2), M, NFF2, DM}; pg8::StaticOrder S; S.init(M, NFF2, F.G, (int)blockIdx.x);
        pg8::EpiSwiglu<true> E{WSP(bf16, WS_ACT), sm + SM_CS2, sm + SM_B2, WSP(u64, WS_S2), stab};
        pg8::gemm_phase(F.lds, g, S, E);
    }
    SEAM(8);
    if (IN(9)) {
        pg8::Gemm g{WSP(bf16, WS_ACT), WSP(bf16, WS_WF2D), M, DM, DFF}; pg8::StaticOrder S; S.init(M, DM, F.G, (int)blockIdx.x);
        pg8::EpiDown<2> E{nullptr, nullptr, WSP(bf16, WS_V2), F.in[20], F.in[21], WSP(u64, WS_S2), stab, nullptr, F.out + O_Y, WSP(u64, WS_S3), 0.5f};
        pg8::gemm_phase(F.lds, g, S, E);
    }
    SEAM(9);
    if (IN(10)) {
        const u64* s3 = WSP(u64, WS_S3); const float* g3 = F.in[25]; const float* b3 = F.in[26];
        for (int row = gw; row < M; row += NGW) {
#ifdef MK_PROBE
            { bool skip = false; for (int w8 = 0; w8 < 8; ++w8) skip |= ((size_t)row == probe_row(w8)); if (skip) continue; }
#endif
            const u64 w = s3[(size_t)row * 16 + (F.lane & 15)];
            const float mn = __uint_as_float((unsigned)w), m2 = __uint_as_float((unsigned)(w >> 32));
            float smn = mn; smn += __shfl_xor(smn, 1); smn += __shfl_xor(smn, 2); smn += __shfl_xor(smn, 4); smn += __shfl_xor(smn, 8);
            const float mt = smn * (1.0f / 16.0f); const float e = mn - mt; float q = m2 + 64.0f * e * e;
            q += __shfl_xor(q, 1); q += __shfl_xor(q, 2); q += __shfl_xor(q, 4); q += __shfl_xor(q, 8);
            const float rs = 1.0f / sqrtf(q * (1.0f / 1024.0f) + LN_EPS);
            float* y = F.out + O_Y + (size_t)row * DM;
#pragma unroll
            for (int jj = 0; jj < 4; ++jj) { const int c = 4 * F.lane + 256 * jj; const f32x4 v = *(const f32x4*)(y + c); *(f32x4*)(y + c) = (v - mt) * rs * *(const f32x4*)(g3 + c) + *(const f32x4*)(b3 + c); }
        }
    }
#ifdef MK_PROBE
    if (IN(10) && MK_PROBE == 1 && F.vcu == 0) {
        __builtin_amdgcn_fence(__ATOMIC_ACQUIRE, "agent");
        float dmax = 0.f; for (int st = 0; st < 8; ++st) dmax = fmaxf(dmax, __uint_as_float(__hip_atomic_load(ctl + 64 + st, __ATOMIC_RELAXED, __HIP_MEMORY_SCOPE_AGENT)));
        for (int i = F.tid; i < DEC_B * DEC_T * SGUW; i += 512) F.out[O_SV + i] += 100.0f * dmax;
    }
    if (IN(10) && gt == 0) {
        __builtin_amdgcn_fence(__ATOMIC_ACQUIRE, "agent");
        float val = 0.f; float scale = 100.f;
        for (int st = 8; st < 15; ++st) { const float d = __uint_as_float(__hip_atomic_load(ctl + 64 + st, __ATOMIC_RELAXED, __HIP_MEMORY_SCOPE_AGENT));
            if (val == 0.f && d > MK_PROBE_TOL) { int ex; (void)frexpf(d, &ex); val = scale * (float)(ex + 40); } scale *= 10.f; }
        if (MK_PROBE == 2) { val = 0.f; scale = 100.f;
            for (int k = 0; k < 3; ++k) { const unsigned c = __hip_atomic_load(ctl + 80 + k, __ATOMIC_RELAXED, __HIP_MEMORY_SCOPE_AGENT);
                if (val == 0.f && c > 0u) { int ex; (void)frexpf((float)c, &ex); val = scale * (float)(ex + 40); } scale *= 10.f; } }
        if (MK_PROBE == 1) { val = 1.0e4f * (float)(100u + __hip_atomic_load(ctl + 96, __ATOMIC_RELAXED, __HIP_MEMORY_SCOPE_AGENT)); }
        if (MK_PROBE == 11) { val = 1000.0f * (float)__hip_atomic_load(ctl + 96, __ATOMIC_RELAXED, __HIP_MEMORY_SCOPE_AGENT) + 1.0e6f * (float)__hip_atomic_load(ctl + 97, __ATOMIC_RELAXED, __HIP_MEMORY_SCOPE_AGENT); }
        if (MK_PROBE == 3) { F.out[O_SV] += 1.0e6f; val = 0.f; }
        if (MK_PROBE == 4) { F.out[O_Y] += 1.0e6f; val = 0.f; }
        if (MK_PROBE == 5) { F.out[O_Y + (size_t)MP * DM] += 1.0e6f; val = 0.f; }
        F.out[O_W0P] += val;
    }
#endif
#undef IN
#undef SEAM
}

extern "C" void kernel_launch(void* const* d_in, const int* in_sizes, int n_in, void* d_out, int out_size, void* d_ws, size_t ws_size, hipStream_t stream) {
    static int grid = 0;
    if (grid == 0) {
        if (n_in != 27 || (size_t)out_size != O_END || ws_size < WS_END) { fprintf(stderr, "kernel_launch: unexpected shapes: n_in %d out %d ws %zu (need %zu)\n", n_in, out_size, ws_size, (size_t)WS_END); grid = -1; return; }
        int dev = 0, cus = 0, per_cu = 0;
        if (hipGetDevice(&dev) != hipSuccess || hipDeviceGetAttribute(&cus, hipDeviceAttributeMultiprocessorCount, dev) != hipSuccess) { grid = -1; return; }
        if (hipFuncSetAttribute((const void*)mk_fwd, hipFuncAttributeMaxDynamicSharedMemorySize, LDS_BYTES) != hipSuccess) { fprintf(stderr, "kernel_launch: hipFuncSetAttribute failed\n"); grid = -1; return; }
        if (hipOccupancyMaxActiveBlocksPerMultiprocessor(&per_cu, (const void*)mk_fwd, 512, LDS_BYTES) != hipSuccess || per_cu < 1) { fprintf(stderr, "kernel_launch: occupancy query says %d\n", per_cu); }
        (void)hipGetLastError();
        grid = cus;
    }
    if (grid < 0) return;
    (void)hipMemsetAsync((char*)d_ws + WS_CTL, 0, CTL_ZERO_BYTES, stream);
    Args a{};
    for (int i = 0; i < 27; ++i) a.in[i] = (const float*)d_in[i];
    a.out = (float*)d_out; a.ws = (unsigned char*)d_ws;
    const int nph = MK_PH_MAX < N_PHASES ? MK_PH_MAX : N_PHASES;
    if (MK_N_LAUNCHES == 1) {
        a.ph_lo = 0; a.ph_hi = nph; a.li = 0;
        hipLaunchKernelGGL(mk_fwd, dim3(grid), dim3(512), LDS_BYTES, stream, a);
    } else {
        for (int p = 0; p < nph; ++p) { a.ph_lo = p; a.ph_hi = p + 1; a.li = p; hipLaunchKernelGGL(mk_fwd, dim3(grid), dim3(512), LDS_BYTES, stream, a);
#ifdef MK_PROBE
            const int stage_after[11] = {-1, -1, 0, 1, -1, 2, 3, 4, 5, 6, -1};
            if (MK_PROBE == 1 && stage_after[p] >= 0) { a.ph_lo = 100 + stage_after[p]; a.ph_hi = a.ph_lo + 1; hipLaunchKernelGGL(mk_fwd, dim3(grid), dim3(512), LDS_BYTES, stream, a); }
            if (MK_PROBE == 2 && (p == 1 || p == 2 || p == 7)) { const int k = p == 1 ? 0 : p == 2 ? 1 : 2;
                a.ph_lo = p; a.ph_hi = p + 1; a.li = 99; hipLaunchKernelGGL(mk_fwd, dim3(grid), dim3(512), LDS_BYTES, stream, a);
                a.li = 200 + k; hipLaunchKernelGGL(mk_fwd, dim3(grid), dim3(512), LDS_BYTES, stream, a); }
#endif
        }
    }
}
```

```cpp
#include <hip/hip_runtime.h>
#include <cstdio>
#include <cstdint>
#define MK_PROBE_TOL 0.02f
#define MK_PROBE_WS (2025ull << 20)

#ifndef MK_N_LAUNCHES
#define MK_N_LAUNCHES 1
#endif
#ifndef MK_DUP
#define MK_DUP -1
#endif
#ifndef MK_PH_MAX
#define MK_PH_MAX 11
#endif

#define GAS __attribute__((address_space(1)))
#define LAS __attribute__((address_space(3)))
typedef unsigned short bf16;
typedef unsigned long long u64;
typedef float f32x2 __attribute__((ext_vector_type(2)));
typedef float f32x4 __attribute__((ext_vector_type(4)));
typedef float f32x16 __attribute__((ext_vector_type(16)));
typedef short bf16x8 __attribute__((ext_vector_type(8)));
typedef short s16x4 __attribute__((ext_vector_type(4)));
typedef unsigned u32x2 __attribute__((ext_vector_type(2)));
typedef unsigned u32x4 __attribute__((ext_vector_type(4)));

constexpr int DM = 1024, SEQ = 2048, NB = 32, MP = NB * SEQ, DEC_B = 128, DEC_T = 4, MS = DEC_B * DEC_T, M = MP + MS;
constexpr size_t PLQ = (size_t)(MP + MS) * 64, PLU = (size_t)(MP + MS) * 32 + 2176;
constexpr int DFF = 2816, NFF2 = 2 * DFF, INW = 5376, QKVW = 768, SGUW = 512;
constexpr float LN_EPS = 1e-5f;
constexpr float ALPHA = 1.189207115002721f;
constexpr float LOG2E = 1.4426950408889634f, LN2F = 0.6931471805599453f;
constexpr float QSCALE = 0.125f * LOG2E;
constexpr float NEGBIG = -1e30f;

constexpr size_t O_Y = 0, O_W0P = 67633152ull, O_W1P = 69730304ull, O_W2P = 78118912ull, O_W0S = 111673344ull, O_W1S = 120061952ull, O_W2S = 153616384ull, O_SV = 287834112ull, O_END = 288096256ull;

constexpr size_t MiB = 1u << 20;
constexpr size_t WS_CTL = 0, CTL_ZERO_BYTES = 1 * MiB;
constexpr size_t WS_SMALL = 1 * MiB;
constexpr size_t WS_WF1 = 2 * MiB, WS_WF1D = 13 * MiB, WS_WIN = 19 * MiB, WS_WOAB = 30 * MiB, WS_WOUT = 32 * MiB, WS_WF2 = 34 * MiB, WS_WF2D = 45 * MiB, WS_WSB = 51 * MiB;
constexpr size_t WS_S1 = 52 * MiB, WS_S2 = 61 * MiB, WS_S3 = 70 * MiB, WS_SGV = 79 * MiB, WS_LSE = 84 * MiB;
constexpr size_t WS_XB = 88 * MiB;
constexpr size_t WS_V1 = 217 * MiB, WS_V2 = 346 * MiB, WS_U = 475 * MiB, WS_GV = 540 * MiB, WS_SA = 605 * MiB, WS_SB = 734 * MiB, WS_OG = 863 * MiB, WS_AY = 960 * MiB;
constexpr size_t WS_ACT = 1057 * MiB;
constexpr size_t WS_Q = WS_ACT, WS_K = WS_ACT + 97 * MiB, WS_V = WS_ACT + 194 * MiB;
constexpr size_t WS_END = 1412 * MiB;
static_assert(12 * PLQ * 2 <= 97 * MiB && 16 * PLU * 2 <= 65 * MiB, "plane map");
static_assert((size_t)M * DFF * 2 <= 355 * MiB && (size_t)M * QKVW * 2 <= 97 * MiB && (size_t)M * DM * 2 <= 129 * MiB, "ws map");
constexpr int SM_CS1 = 0, SM_B1 = 8192, SM_CS2 = 16384, SM_B2 = 24576, SM_BT = 32768, SM_PART = 65536;

constexpr int CW_BAR = 4096;

constexpr int RING_BYTES = 131072, STAB_OFF = RING_BYTES  , MISC_OFF = STAB_OFF + 4096, LDS_BYTES = 147456;

__device__ const unsigned char T5BUCKET[3][129] = {
{0,1,2,3,4,5,6,7,8,9,10,11,12,13,14,15,16,16,16,16,16,16,17,17,17,17,17,17,17,17,18,18,18,18,18,18,18,18,18,18,19,19,19,19,19,19,19,19,19,19,19,19,19,19,20,20,20,20,20,20,20,20,20,20,20,20,20,20,20,20,20,20,20,21,21,21,21,21,21,21,21,21,21,21,21,21,21,21,21,21,21,21,21,21,21,21,21,21,21,22,22,22,22,22,22,22,22,22,22,22,22,22,22,22,22,22,22,22,22,22,22,22,22,22,22,22,22,22,22},
{0,4,8,12,16,16,17,17,18,18,19,19,19,19,20,20,20,20,20,21,21,21,21,21,21,22,22,22,22,22,22,22,22,22,23,23,23,23,23,23,23,23,23,23,23,23,24,24,24,24,24,24,24,24,24,24,24,24,24,24,24,24,25,25,25,25,25,25,25,25,25,25,25,25,25,25,25,25,25,25,25,25,25,26,26,26,26,26,26,26,26,26,26,26,26,26,26,26,26,26,26,26,26,26,26,26,26,26,26,26,26,26,26,27,27,27,27,27,27,27,27,27,27,27,27,27,27,27,27},
{0,16,18,19,20,21,21,22,22,23,23,23,24,24,24,24,25,25,25,25,25,26,26,26,26,26,26,26,26,27,27,27,27,27,27,27,27,27,27,28,28,28,28,28,28,28,28,28,28,28,28,28,29,29,29,29,29,29,29,29,29,29,29,29,29,29,29,29,29,29,30,30,30,30,30,30,30,30,30,30,30,30,30,30,30,30,30,30,30,30,30,30,30,30,30,31,31,31,31,31,31,31,31,31,31,31,31,31,31,31,31,31,31,31,31,31,31,31,31,31,31,31,31,31,31,31,31,31,31}};

__device__ __forceinline__ unsigned f2bf(float f) { unsigned u = __builtin_bit_cast(unsigned, f); return (u + 0x7fffu + ((u >> 16) & 1u)) >> 16; }
__device__ __forceinline__ unsigned pk2(float lo, float hi) { return f2bf(lo) | (f2bf(hi) << 16); }
__device__ __forceinline__ float bfround(float f) { return __uint_as_float(f2bf(f) << 16); }
typedef __bf16 bf16x2_t __attribute__((ext_vector_type(2)));
__device__ __forceinline__ unsigned cvt_pk_bf16(float lo, float hi) { const f32x2 v = {lo, hi}; const bf16x2_t b = __builtin_convertvector(v, bf16x2_t); return __builtin_bit_cast(unsigned, b); }
__device__ __forceinline__ float bflo(unsigned u) { return __uint_as_float(u << 16); }
__device__ __forceinline__ float bfhi(unsigned u) { return __uint_as_float(u & 0xffff0000u); }
__device__ __forceinline__ u32x4 pack8(f32x4 a, f32x4 b) { u32x4 w; w.x = cvt_pk_bf16(a[0], a[1]); w.y = cvt_pk_bf16(a[2], a[3]); w.z = cvt_pk_bf16(b[0], b[1]); w.w = cvt_pk_bf16(b[2], b[3]); return w; }
__device__ __forceinline__ int lane_now() { int l; asm volatile("v_mbcnt_lo_u32_b32 %0, -1, 0\n\tv_mbcnt_hi_u32_b32 %0, -1, %0" : "=v"(l)); return l & 63; }
__device__ __forceinline__ void unpack8(u32x4 w, f32x4& a, f32x4& b) { a = (f32x4){bflo(w.x), bfhi(w.x), bflo(w.y), bfhi(w.y)}; b = (f32x4){bflo(w.z), bfhi(w.z), bflo(w.w), bfhi(w.w)}; }
__device__ __forceinline__ float fast_exp2(float x) { return __builtin_amdgcn_exp2f(x); }
__device__ __forceinline__ float fast_rcp(float x) { return __builtin_amdgcn_rcpf(x); }
__device__ __forceinline__ float sigmoidf_(float x) { return fast_rcp(1.0f + fast_exp2(-x * LOG2E)); }
__device__ __forceinline__ f32x4 sigmoid4(f32x4 v) { return (f32x4){sigmoidf_(v[0]), sigmoidf_(v[1]), sigmoidf_(v[2]), sigmoidf_(v[3])}; }
__device__ __forceinline__ float gelu1(float v) {
    const float av = __builtin_fabsf(v), t = fast_rcp(av * 0.2316418882f + 1.0f);
    float q = t * 0.5307027145f + (-0.7265760135f); q = q * t + 0.7107068705f; q = q * t + (-0.142248368f); q = q * t + 0.127414796f; q = q * t;
    const float e = fast_exp2((v * v) * (-0.72134752044f));
    const float m = v * (q * e);
    return v < 0.f ? m : v - m;
}
__device__ __forceinline__ f32x4 gelu4(f32x4 v) {
    const f32x4 av = __builtin_elementwise_abs(v), dd = av * 0.2316418882f + 1.0f;
    const f32x4 t = {fast_rcp(dd[0]), fast_rcp(dd[1]), fast_rcp(dd[2]), fast_rcp(dd[3])};
    f32x4 q = t * 0.5307027145f + (-0.7265760135f); q = q * t + 0.7107068705f; q = q * t + (-0.142248368f); q = q * t + 0.127414796f; q = q * t;
    const f32x4 s2 = (v * v) * (-0.72134752044f);
    const f32x4 e = {fast_exp2(s2[0]), fast_exp2(s2[1]), fast_exp2(s2[2]), fast_exp2(s2[3])};
    const f32x4 m = v * (q * e), r = v - m;
    return (f32x4){v[0] < 0.f ? m[0] : r[0], v[1] < 0.f ? m[1] : r[1], v[2] < 0.f ? m[2] : r[2], v[3] < 0.f ? m[3] : r[3]};
}
__device__ __forceinline__ float wave_sum(float v) {
#pragma unroll
    for (int o = 1; o < 64; o <<= 1) v += __shfl_xor(v, o);
    return v;
}
__device__ __forceinline__ float wave_max(float v) {
#pragma unroll
    for (int o = 1; o < 64; o <<= 1) v = fmaxf(v, __shfl_xor(v, o));
    return v;
}

namespace pg8 {
constexpr int BM = 256, BK = 64, HALF = 128, HTB = HALF * BK * 2, STAGE_BYTES = 8 * HTB, NXCD = 8, WGM = 8;
__host__ __device__ __forceinline__ int lds_byte(int r, int c) { const int st = (r >> 4) * 2 + (c >> 5), rr = r & 15, cc = c & 31, ob = rr * 64 + cc * 2; return st * 1024 + (ob ^ (((ob >> 9) & 1) << 5)); }
__host__ __device__ __forceinline__ void stage_rc(int b, int& R, int& C) { const int st = b / 1024, sb = b % 1024, swz = sb ^ (((sb >> 9) & 1) << 5); R = (st >> 1) * 16 + swz / 64; C = (st & 1) * 32 + (swz % 64) / 2; }
__host__ __device__ __forceinline__ int perm32(int rho) { const int n = rho >> 4, i = rho & 15; return 8 * (i >> 2) + 4 * n + (i & 3); }

struct Unit { int pm, pn; };
struct Gemm { const bf16* A; const bf16* Bt; int M, N, K; };

struct StaticOrder {
    int nM, nN, nwg, G, c;
    __device__ void init(int M_, int N_, int G_, int c_) { nM = M_ / BM; nN = N_ / BM; nwg = nM * nN; G = G_; c = c_; }
    __device__ bool next(int i, Unit& u) const {
        const long L = (long)i * G + c; if (L >= nwg) return false;
        int wgid = (int)L; { const int q = nwg / NXCD, r = nwg % NXCD, xcd = wgid % NXCD, off = wgid / NXCD; wgid = (xcd < r ? xcd * (q + 1) : r * (q + 1) + (xcd - r) * q) + off; }
        const int nig = WGM * nN, gid = wgid / nig, fm = gid * WGM, gsz = (nM - fm) < WGM ? (nM - fm) : WGM;
        u.pm = fm + ((wgid % nig) % gsz); u.pn = (wgid % nig) / gsz; return true;
    }
};

struct PanelOrder {
    int nM, G, slot, tile;
    __device__ void init(int M_, int G_, int c_) { nM = M_ / BM; G = G_;
        if (G % 32 == 0) { const int R = G / 8, x = c_ & 7, k = c_ >> 3; slot = x * (R / 4) + (k >> 2); tile = k & 3; } else { slot = c_ >> 2; tile = c_ & 3; if (c_ >= (G / 4) * 4) slot = 1 << 20; } }
    __device__ bool next(int i, Unit& u) const { const int pm = i * (G / 4) + slot; if (pm >= nM) return false; u.pm = pm; u.pn = tile; return true; }
};

template <class Order, class Epi>
__device__ __forceinline__ void gemm_phase(LAS unsigned char* lds, const Gemm g, const Order& S, const Epi& E, const int wid) {
    const int lane = lane_now(), tid = wid * 64 + lane, wr = wid >> 2, wc = wid & 3, fr = lane & 15, fq = lane >> 4;
    const int K = g.K, nt = K / BK;
    unsigned voffA[2], voffB[2];
#pragma unroll
    for (int i = 0; i < 2; ++i) { int R, C; stage_rc(tid * 16 + i * 8192, R, C); const int Rb = (R & ~31) + perm32(R & 31);
        voffA[i] = (unsigned)(R * K + C) * 2u; voffB[i] = (unsigned)(Rb * K + C) * 2u; }
    const size_t kstep = (size_t)(BK * 2);
    const size_t hstep = (size_t)HALF * K * 2;
    const size_t tstep = 2 * hstep;
    const unsigned ldsw = (unsigned)wid * 1024u;
    const int aoff = lds_byte(wr * 64 + fr, fq * 8), boff = lds_byte(wc * 32 + fr, fq * 8);
#define PG8_SA(b, h) (((b) * 2 + (h)) * HTB)
#define PG8_SB(b, h) ((4 + (b) * 2 + (h)) * HTB)
#define PG8_STAGE(bufoff, gbase, voff) do { _Pragma("unroll") for (int _i = 0; _i < 2; ++_i) \
        __builtin_amdgcn_global_load_lds((const unsigned*)((const char*)(gbase) + (voff)[_i]), (LAS unsigned*)(lds + (bufoff) + ldsw + _i * 8192), 16, 0, 0); } while (0)
#define PG8_LDA(dst, b, h) do { _Pragma("unroll") for (int m = 0; m < 4; ++m) _Pragma("unroll") for (int k = 0; k < 2; ++k) dst[m][k] = *(const LAS bf16x8*)(lds + PG8_SA(b, h) + aoff + m * 2048 + k * 1024); } while (0)
#define PG8_LDB(dst, b, h) do { _Pragma("unroll") for (int n = 0; n < 2; ++n) _Pragma("unroll") for (int k = 0; k < 2; ++k) dst[n][k] = *(const LAS bf16x8*)(lds + PG8_SB(b, h) + boff + n * 2048 + k * 1024); } while (0)
#define PG8_MMA(ai, bj, At, Bt) do { __builtin_amdgcn_s_setprio(1); _Pragma("unroll") for (int m = 0; m < 4; ++m) _Pragma("unroll") for (int n = 0; n < 2; ++n) _Pragma("unroll") for (int k = 0; k < 2; ++k) \
        acc[ai][bj][m][n] = __builtin_amdgcn_mfma_f32_16x16x32_bf16(Bt[n][k], At[m][k], acc[ai][bj][m][n], 0, 0, 0); __builtin_amdgcn_s_setprio(0); } while (0)
#define PG8_WAIT_V(n) asm volatile("s_waitcnt vmcnt(" #n ")" ::: "memory")
#define PG8_WAIT_L(n) asm volatile("s_waitcnt lgkmcnt(" #n ")" ::: "memory")
#define PG8_BAR __builtin_amdgcn_s_barrier()
#define PG8_SCHED __builtin_amdgcn_sched_barrier(0)
    Unit cur, nxt; int ui = 0;
    if (!S.next(0, cur)) return;
    f32x4 acc[2][2][4][2];
#pragma unroll
    for (int a = 0; a < 2; ++a)
#pragma unroll
        for (int b = 0; b < 2; ++b)
#pragma unroll
            for (int m = 0; m < 4; ++m)
#pragma unroll
                for (int n = 0; n < 2; ++n) acc[a][b][m][n] = (f32x4){0.f, 0.f, 0.f, 0.f};
    bf16x8 At[4][2], B0[2][2], B1[2][2];
    const char* cA = (const char*)g.A + (size_t)cur.pm * tstep; const char* cB = (const char*)g.Bt + (size_t)cur.pn * tstep;
    int tpar = 0, tpm = cur.pm;
    if constexpr (Epi::HAS_PREP) E.prep(cur, 0, tid);
    PG8_STAGE(PG8_SB(0, 0), cB, voffB); PG8_STAGE(PG8_SB(0, 1), cB + hstep, voffB); PG8_STAGE(PG8_SA(0, 0), cA, voffA); PG8_STAGE(PG8_SA(0, 1), cA + hstep, voffA);
    if (wr == 1) PG8_BAR;
    PG8_WAIT_V(2); PG8_BAR;
    PG8_STAGE(PG8_SB(1, 0), cB + kstep, voffB); PG8_STAGE(PG8_SA(1, 0), cA + kstep, voffA); PG8_STAGE(PG8_SB(1, 1), cB + hstep + kstep, voffB);
    PG8_WAIT_V(6); PG8_BAR;
    for (;;) {
        const bool has_next = S.next(ui + 1, nxt);
        const char* nA = has_next ? (const char*)g.A + (size_t)nxt.pm * tstep : cA; const char* nB = has_next ? (const char*)g.Bt + (size_t)nxt.pn * tstep : cB;
        for (int t = 0; t < nt; t += 2) {
            const bool last = (t == nt - 2);
            const char* a1 = cA + (size_t)(t + 1) * kstep;
            const char* a2 = last ? nA : cA + (size_t)(t + 2) * kstep; const char* b2 = last ? nB : cB + (size_t)(t + 2) * kstep;
            const char* a3 = a2 + kstep; const char* b3 = b2 + kstep;
            if constexpr (Epi::MID_T >= 0) { if (t == Epi::MID_T) E.mid(acc, cur, wr, wc, fr, fq); }
            PG8_LDB(B0, 0, 0); PG8_LDB(B1, 0, 1); PG8_SCHED; PG8_LDA(At, 0, 0); PG8_STAGE(PG8_SA(1, 1), a1 + hstep, voffA);
            PG8_WAIT_V(8); PG8_WAIT_L(0); PG8_BAR; PG8_MMA(0, 0, At, B0); PG8_MMA(0, 1, At, B1); PG8_BAR; PG8_SCHED;
            PG8_LDA(At, 0, 1); PG8_STAGE(PG8_SB(0, 0), b2, voffB); PG8_STAGE(PG8_SB(0, 1), b2 + hstep, voffB); PG8_STAGE(PG8_SA(0, 0), a2, voffA);
            PG8_WAIT_V(8); PG8_WAIT_L(0); PG8_BAR; PG8_MMA(1, 0, At, B0); PG8_MMA(1, 1, At, B1); PG8_BAR; PG8_SCHED;
            PG8_LDB(B0, 1, 0); PG8_LDB(B1, 1, 1); PG8_SCHED; PG8_LDA(At, 1, 0); PG8_STAGE(PG8_SA(0, 1), a2 + hstep, voffA);
            PG8_WAIT_V(8); PG8_WAIT_L(0); PG8_BAR; PG8_MMA(0, 0, At, B0); PG8_MMA(0, 1, At, B1); PG8_BAR; PG8_SCHED;
            PG8_LDA(At, 1, 1); PG8_STAGE(PG8_SB(1, 0), b3, voffB); PG8_STAGE(PG8_SB(1, 1), b3 + hstep, voffB); PG8_STAGE(PG8_SA(1, 0), a3, voffA);
            PG8_WAIT_V(8); PG8_WAIT_L(0); PG8_BAR; PG8_MMA(1, 0, At, B0); PG8_MMA(1, 1, At, B1); PG8_BAR; PG8_SCHED;
        }
        if (wr == 0) PG8_BAR;
        E(acc, cur, wr, wc, fr, fq, tpar);
        if (!has_next) break;
#pragma unroll
        for (int a = 0; a < 2; ++a)
#pragma unroll
            for (int b = 0; b < 2; ++b)
#pragma unroll
                for (int m = 0; m < 4; ++m)
#pragma unroll
                    for (int n = 0; n < 2; ++n) acc[a][b][m][n] = (f32x4){0.f, 0.f, 0.f, 0.f};
        if constexpr (Epi::HAS_PREP) { if (nxt.pm != tpm) { tpar ^= 1; tpm = nxt.pm; E.prep(nxt, tpar, tid); } }
        cur = nxt; cA = nA; cB = nB; ++ui;
        if (wr == 1) PG8_BAR;
    }
    PG8_WAIT_V(0);
    PG8_BAR;
#undef PG8_SA
#undef PG8_SB
#undef PG8_STAGE
#undef PG8_LDA
#undef PG8_LDB
#undef PG8_MMA
#undef PG8_WAIT_V
#undef PG8_WAIT_L
#undef PG8_BAR
#undef PG8_SCHED
}

template <bool WT = false>
__device__ __forceinline__ void wave_row_stats(const f32x4 (&v)[2][2][4][2], u64* slots, int ns, int sidx, int row0, int fq) {
#pragma unroll
    for (int ai = 0; ai < 2; ++ai)
#pragma unroll
        for (int m = 0; m < 4; ++m) {
            float s = 0.f;
#pragma unroll
            for (int bj = 0; bj < 2; ++bj)
#pragma unroll
                for (int n = 0; n < 2; ++n) { const f32x4 x = v[ai][bj][m][n]; s += (x[0] + x[1]) + (x[2] + x[3]); }
            s += __shfl_xor(s, 16); s += __shfl_xor(s, 32);
            const float mw = s * (1.0f / 64.0f); float q = 0.f;
#pragma unroll
            for (int bj = 0; bj < 2; ++bj)
#pragma unroll
                for (int n = 0; n < 2; ++n) { const f32x4 d = v[ai][bj][m][n] - mw; q += (d[0] * d[0] + d[1] * d[1]) + (d[2] * d[2] + d[3] * d[3]); }
            q += __shfl_xor(q, 16); q += __shfl_xor(q, 32);
            if (fq == 0) { u64* sp = slots + (size_t)(row0 + ai * HALF + m * 16) * ns + sidx; const u64 val = ((u64)__float_as_uint(q) << 32) | (u64)__float_as_uint(mw);
                if constexpr (WT) __hip_atomic_store(sp, val, __ATOMIC_RELAXED, __HIP_MEMORY_SCOPE_AGENT); else *sp = val; }
        }
}
__device__ __forceinline__ void stats_table16(const u64* slots, int pm, LAS f32x2* tab, int tid) {
    asm volatile("" : "+v"(tid));
    const int row = tid >> 1, half = tid & 1;
    const u32x4* p = (const u32x4*)(slots + (size_t)(pm * 256 + row) * 16 + half * 8);
    const u32x4 a = p[0], b = p[1], c = p[2], d = p[3];
    const float mn[8] = {__uint_as_float(a.x), __uint_as_float(a.z), __uint_as_float(b.x), __uint_as_float(b.z), __uint_as_float(c.x), __uint_as_float(c.z), __uint_as_float(d.x), __uint_as_float(d.z)};
    const float m2[8] = {__uint_as_float(a.y), __uint_as_float(a.w), __uint_as_float(b.y), __uint_as_float(b.w), __uint_as_float(c.y), __uint_as_float(c.w), __uint_as_float(d.y), __uint_as_float(d.w)};
    float sm = 0.f;
#pragma unroll
    for (int i = 0; i < 8; ++i) sm += mn[i];
    sm += __shfl_xor(sm, 1);
    const float mt = sm * (1.0f / 16.0f);
    float q = 0.f;
#pragma unroll
    for (int i = 0; i < 8; ++i) { const float dd = mn[i] - mt; q += m2[i] + 64.0f * dd * dd; }
    q += __shfl_xor(q, 1);
    if (half == 0) tab[row] = (f32x2){mt, 1.0f / sqrtf(q * (1.0f / 1024.0f) + LN_EPS)};
}

__device__ __forceinline__ void stats_table16_coh(u64* slots, int pm, LAS f32x2* tab, int tid) {
    asm volatile("" : "+v"(tid));
    const int row = tid >> 1, half = tid & 1;
    u64* p = slots + (size_t)(pm * 256 + row) * 16 + half * 8;
    u64 w[8];
#pragma unroll
    for (int i = 0; i < 8; ++i) w[i] = __hip_atomic_load(p + i, __ATOMIC_RELAXED, __HIP_MEMORY_SCOPE_AGENT);
    float sm = 0.f;
#pragma unroll
    for (int i = 0; i < 8; ++i) sm += __uint_as_float((unsigned)w[i]);
    sm += __shfl_xor(sm, 1);
    const float mt = sm * (1.0f / 16.0f);
    float q = 0.f;
#pragma unroll
    for (int i = 0; i < 8; ++i) { const float dd = __uint_as_float((unsigned)w[i]) - mt; q += __uint_as_float((unsigned)(w[i] >> 32)) + 64.0f * dd * dd; }
    q += __shfl_xor(q, 1);
    if (half == 0) tab[row] = (f32x2){mt, 1.0f / sqrtf(q * (1.0f / 1024.0f) + LN_EPS)};
}

template <bool LN> struct EpiSwiglu {
    static constexpr bool HAS_PREP = LN; static constexpr int MID_T = -1;
    bf16* O; const float* cs; const float* bias; const u64* slots; LAS f32x2* stab;
    __device__ __forceinline__ void prep(const Unit& u, int par, int tid) const { stats_table16(slots, u.pm, stab + par * 256, tid); }
    __device__ __forceinline__ void mid(f32x4 (&)[2][2][4][2], const Unit&, int, int, int, int) const {}
    __device__ __forceinline__ void operator()(f32x4 (&acc)[2][2][4][2], const Unit& u, int wr, int wc, int fr, int fq, int par) const {
        asm volatile("" : "+v"(fr), "+v"(fq));
        const int ocol = u.pn * 128 + wc * 32 + 8 * fq, brow = u.pn * 256 + wc * 32 + 8 * fq;
        f32x4 csA[2], csB[2], biA[2], biB[2];
        if constexpr (LN) {
#pragma unroll
            for (int n = 0; n < 2; ++n) { csA[n] = *(const f32x4*)(cs + brow + 4 * n); csB[n] = *(const f32x4*)(cs + brow + 128 + 4 * n); biA[n] = *(const f32x4*)(bias + brow + 4 * n); biB[n] = *(const f32x4*)(bias + brow + 128 + 4 * n); }
        }
#pragma unroll
        for (int ai = 0; ai < 2; ++ai)
#pragma unroll
            for (int m = 0; m < 4; ++m) {
                const int r = ai * HALF + wr * 64 + m * 16 + fr;
                f32x4 o[2];
                f32x2 st; if constexpr (LN) st = stab[par * 256 + r];
#pragma unroll
                for (int n = 0; n < 2; ++n) {
                    f32x4 a = acc[ai][0][m][n], b = acc[ai][1][m][n];
                    if constexpr (LN) { a = (a - st.x * csA[n]) * st.y + biA[n]; b = (b - st.x * csB[n]) * st.y + biB[n]; }
                    o[n] = a * b * sigmoid4(a);
                }
                __builtin_nontemporal_store(pack8(o[0], o[1]), (u32x4*)(O + (size_t)(u.pm * BM + r) * DFF + ocol));
            }
    }
};

template <int MODE> struct EpiDown {
    static constexpr bool HAS_PREP = (MODE != 0); static constexpr int MID_T = -1;
    const float* xp; const float* xs; const bf16* Vp; const float* g; const float* b; const u64* slots_in; LAS f32x2* stab;
    bf16* Ob; float* Of; u64* slots_out; float cacc;
    const float* g3; const float* b3; unsigned* pcnt; LAS f32x2* tab3;
    __device__ __forceinline__ void prep(const Unit& u, int par, int tid) const { stats_table16(slots_in, u.pm, stab + par * 256, tid); }
    __device__ __forceinline__ void mid(f32x4 (&)[2][2][4][2], const Unit&, int, int, int, int) const {}
    __device__ __forceinline__ void operator()(f32x4 (&acc)[2][2][4][2], const Unit& u, int wr, int wc, int fr, int fq, int par) const {
        asm volatile("" : "+v"(fr), "+v"(fq));
        u32x4 w[2][2][4];
        if constexpr (MODE == 99) {
#pragma unroll
            for (int bj = 0; bj < 2; ++bj)
#pragma unroll
                for (int ai = 0; ai < 2; ++ai)
#pragma unroll
                    for (int m = 0; m < 4; ++m) w[bj][ai][m] = *(const u32x4*)(Vp + (size_t)(u.pm * BM + ai * HALF + wr * 64 + m * 16 + fr) * DM + u.pn * BM + bj * HALF + wc * 32 + 8 * fq);
        }
#pragma unroll
        for (int bj = 0; bj < 2; ++bj) {
            const int col = u.pn * BM + bj * HALF + wc * 32 + 8 * fq;
            f32x4 g0, g1, b0, b1;
            if constexpr (MODE != 0) { g0 = *(const f32x4*)(g + col); g1 = *(const f32x4*)(g + col + 4); b0 = *(const f32x4*)(b + col); b1 = *(const f32x4*)(b + col + 4); }
#pragma unroll
            for (int ai = 0; ai < 2; ++ai)
#pragma unroll
                for (int m = 0; m < 4; ++m) w[bj][ai][m] = *(const u32x4*)(Vp + (size_t)(u.pm * BM + ai * HALF + wr * 64 + m * 16 + fr) * DM + col);
#pragma unroll
            for (int ai = 0; ai < 2; ++ai)
#pragma unroll
                for (int m = 0; m < 4; ++m) {
                    const int r = ai * HALF + wr * 64 + m * 16 + fr;
                    f32x4 r0, r1; unpack8(w[bj][ai][m], r0, r1);
                    if constexpr (MODE != 0) { const f32x2 st = stab[par * 256 + r]; r0 = (r0 - st.x) * st.y * g0 + b0; r1 = (r1 - st.x) * st.y * g1 + b1; }
                    acc[ai][bj][m][0] = ALPHA * r0 + cacc * acc[ai][bj][m][0]; acc[ai][bj][m][1] = ALPHA * r1 + cacc * acc[ai][bj][m][1];
                    asm volatile("" : "+v"(acc[ai][bj][m][0]), "+v"(acc[ai][bj][m][1]));
                }
            asm volatile("" ::: "memory");
        }
        if constexpr (MODE == 3) {
            wave_row_stats<true>(acc, slots_out, 16, u.pn * 4 + wc, u.pm * BM + wr * 64 + fr, fq);
            asm volatile("s_waitcnt vmcnt(0)" ::: "memory");
            __builtin_amdgcn_s_barrier();
            const int tid = (wr * 4 + wc) * 64 + fq * 16 + fr;
            if (tid == 0) {
                (void)__hip_atomic_fetch_add(pcnt + u.pm, 1u, __ATOMIC_RELAXED, __HIP_MEMORY_SCOPE_AGENT);
                unsigned sp = 0;
                while (__hip_atomic_load(pcnt + u.pm, __ATOMIC_RELAXED, __HIP_MEMORY_SCOPE_AGENT) < 4u) { __builtin_amdgcn_s_sleep(1); if (++sp > (1u << 20)) break; }
                __builtin_amdgcn_fence(__ATOMIC_ACQUIRE, "agent");
            }
            __builtin_amdgcn_s_barrier();
            stats_table16_coh(slots_out, u.pm, tab3, tid);
            asm volatile("s_waitcnt lgkmcnt(0)" ::: "memory");
            __builtin_amdgcn_s_barrier();
#pragma unroll
            for (int bj = 0; bj < 2; ++bj) {
                const int col = u.pn * BM + bj * HALF + wc * 32 + 8 * fq;
                const f32x4 h0 = *(const f32x4*)(g3 + col), h1 = *(const f32x4*)(g3 + col + 4), c0 = *(const f32x4*)(b3 + col), c1 = *(const f32x4*)(b3 + col + 4);
#pragma unroll
                for (int ai = 0; ai < 2; ++ai)
#pragma unroll
                    for (int m = 0; m < 4; ++m) {
                        const int r = ai * HALF + wr * 64 + m * 16 + fr; const f32x2 st = tab3[r];
                        float* y = Of + (size_t)(u.pm * BM + r) * DM + col;
                        __builtin_nontemporal_store((acc[ai][bj][m][0] - st.x) * st.y * h0 + c0, (f32x4*)y); __builtin_nontemporal_store((acc[ai][bj][m][1] - st.x) * st.y * h1 + c1, (f32x4*)(y + 4));
                    }
                asm volatile("" ::: "memory");
            }
            return;
        }
        wave_row_stats(acc, slots_out, 16, u.pn * 4 + wc, u.pm * BM + wr * 64 + fr, fq);
#pragma unroll
        for (int ai = 0; ai < 2; ++ai)
#pragma unroll
            for (int m = 0; m < 4; ++m) {
                const size_t row = (size_t)(u.pm * BM + ai * HALF + wr * 64 + m * 16 + fr);
#pragma unroll
                for (int bj = 0; bj < 2; ++bj) {
                    const int col = u.pn * BM + bj * HALF + wc * 32 + 8 * fq;
                    if constexpr (MODE == 2) { *(f32x4*)(Of + row * DM + col) = acc[ai][bj][m][0]; *(f32x4*)(Of + row * DM + col + 4) = acc[ai][bj][m][1]; }
                    else __builtin_nontemporal_store(pack8(acc[ai][bj][m][0], acc[ai][bj][m][1]), (u32x4*)(Ob + row * DM + col));
                }
                asm volatile("" ::: "memory");
            }
    }
};

struct EpiWin {
    static constexpr bool HAS_PREP = true; static constexpr int MID_T = -1;
    const float* cs; const float* bias; const u64* slots; LAS f32x2* stab;
    bf16 *Q, *K, *V, *U, *GV, *SA, *SB; u64* sgv; float* out;
    __device__ __forceinline__ void prep(const Unit& u, int par, int tid) const { stats_table16(slots, u.pm, stab + par * 256, tid); }
    __device__ __forceinline__ void mid(f32x4 (&)[2][2][4][2], const Unit&, int, int, int, int) const {}
    template <int ACT>
    __device__ __forceinline__ void store_tile(f32x4 (&acc)[2][2][4][2], bf16* dst, int ld, int c0, const Unit& u, int wr, int wc, int fr, int fq) const {
#pragma unroll
        for (int ai = 0; ai < 2; ++ai)
#pragma unroll
            for (int m = 0; m < 4; ++m) {
                bf16* rowp = dst + (size_t)(u.pm * BM + ai * HALF + wr * 64 + m * 16 + fr) * ld + c0 + wc * 32 + 8 * fq;
#pragma unroll
                for (int bj = 0; bj < 2; ++bj) {
                    f32x4 v0 = acc[ai][bj][m][0], v1 = acc[ai][bj][m][1];
                    if (ACT == 1) { v0 = v0 * QSCALE; v1 = v1 * QSCALE; }
                    if (ACT == 2) { v0 = gelu4(v0); v1 = gelu4(v1); }
                    if (ACT == 3) { v0 = sigmoid4(v0); v1 = sigmoid4(v1); }
                    __builtin_nontemporal_store(pack8(v0, v1), (u32x4*)(rowp + bj * HALF));
                }
                asm volatile("" ::: "memory");
            }
    }
    template <int ACT>
    __device__ __forceinline__ void store_planes(f32x4 (&acc)[2][2][4][2], bf16* dst, int g, const Unit& u, int wr, int wc, int fr, int fq) const {
#pragma unroll
        for (int ai = 0; ai < 2; ++ai)
#pragma unroll
            for (int m = 0; m < 4; ++m) {
                bf16* rowp = dst + (size_t)(g * 4 + (wc >> 1)) * PLQ + (size_t)(u.pm * BM + ai * HALF + wr * 64 + m * 16 + fr) * 64 + (wc & 1) * 32 + 8 * fq;
#pragma unroll
                for (int bj = 0; bj < 2; ++bj) {
                    f32x4 v0 = acc[ai][bj][m][0], v1 = acc[ai][bj][m][1];
                    if (ACT == 1) { v0 = v0 * QSCALE; v1 = v1 * QSCALE; }
                    __builtin_nontemporal_store(pack8(v0, v1), (u32x4*)(rowp + (size_t)bj * 2 * PLQ));
                }
                asm volatile("" ::: "memory");
            }
    }
    __device__ __forceinline__ void operator()(f32x4 (&acc)[2][2][4][2], const Unit& u, int wr, int wc, int fr, int fq, int par) const {
        asm volatile("" : "+v"(fr), "+v"(fq));
#pragma unroll
        for (int bj = 0; bj < 2; ++bj) {
            const int col = u.pn * BM + bj * HALF + wc * 32 + 8 * fq;
            const f32x4 c0 = *(const f32x4*)(cs + col), c1 = *(const f32x4*)(cs + col + 4), b0 = *(const f32x4*)(bias + col), b1 = *(const f32x4*)(bias + col + 4);
#pragma unroll
            for (int ai = 0; ai < 2; ++ai)
#pragma unroll
                for (int m = 0; m < 4; ++m) {
                    const f32x2 st = stab[par * 256 + ai * HALF + wr * 64 + m * 16 + fr];
                    const float k2 = -st.x * st.y;
                    acc[ai][bj][m][0] = acc[ai][bj][m][0] * st.y + (c0 * k2 + b0); acc[ai][bj][m][1] = acc[ai][bj][m][1] * st.y + (c1 * k2 + b1);
                    asm volatile("" : "+v"(acc[ai][bj][m][0]), "+v"(acc[ai][bj][m][1]));
                }
            asm volatile("" ::: "memory");
        }
        const int pn = u.pn;
        if (pn < 3) { store_planes<1>(acc, Q, pn, u, wr, wc, fr, fq); }
        else if (pn < 9) {
            const int kv = pn >= 6 ? 1 : 0, g = pn - 3 - 3 * kv, W = 128 << (2 * g);
            store_planes<0>(acc, kv ? V : K, g, u, wr, wc, fr, fq);
            const size_t obase_p = (g == 0) ? O_W0P : (g == 1) ? O_W1P : O_W2P, obase_s = (g == 0) ? O_W0S : (g == 1) ? O_W1S : O_W2S;
#pragma unroll
            for (int ai = 0; ai < 2; ++ai)
#pragma unroll
                for (int m = 0; m < 4; ++m) {
                    const int r = ai * HALF + wr * 64 + m * 16 + fr;
                    float* dst = nullptr;
                    if (u.pm < MP / BM) { const int b = u.pm >> 3, t = (u.pm & 7) * 256 + r, p = t - (SEQ - W); if (p >= 0) dst = out + obase_p + ((size_t)(b * W + p) * 2 + kv) * 256; }
                    else { const int ms = (u.pm - MP / BM) * 256 + r, bd = ms >> 2, tt = ms & 3; dst = out + obase_s + ((size_t)(bd * W + W - 4 + tt) * 2 + kv) * 256; }
                    if (dst) {
#pragma unroll
                        for (int bj = 0; bj < 2; ++bj) { float* d2 = dst + bj * HALF + wc * 32 + 8 * fq; __builtin_nontemporal_store(acc[ai][bj][m][0], (f32x4*)d2); __builtin_nontemporal_store(acc[ai][bj][m][1], (f32x4*)(d2 + 4)); }
                    }
                    asm volatile("" ::: "memory");
                }
        }
        else if (pn < 11) {
#pragma unroll
            for (int ai = 0; ai < 2; ++ai)
#pragma unroll
                for (int m = 0; m < 4; ++m) {
                    bf16* rowp = U + (size_t)((pn - 9) * 8 + wc) * PLU + (size_t)(u.pm * BM + ai * HALF + wr * 64 + m * 16 + fr) * 32 + 8 * fq;
#pragma unroll
                    for (int bj = 0; bj < 2; ++bj) __builtin_nontemporal_store(pack8(gelu4(acc[ai][bj][m][0]), gelu4(acc[ai][bj][m][1])), (u32x4*)(rowp + (size_t)bj * 4 * PLU));
                    asm volatile("" ::: "memory");
                }
        }
        else if (pn < 13) {
            bf16* dstb = GV + (size_t)((pn - 11) * 8 + wc) * PLU + 8 * fq; const int sidx = (pn - 11) * 4 + wc;
#pragma unroll
            for (int ai = 0; ai < 2; ++ai)
#pragma unroll
                for (int m = 0; m < 4; ++m) {
                    const size_t row = (size_t)(u.pm * BM + ai * HALF + wr * 64 + m * 16 + fr);
                    f32x4 t[2][2]; float s = 0.f;
#pragma unroll
                    for (int bj = 0; bj < 2; ++bj)
#pragma unroll
                        for (int n = 0; n < 2; ++n) { t[bj][n] = gelu4(acc[ai][bj][m][n]); s += (t[bj][n][0] + t[bj][n][1]) + (t[bj][n][2] + t[bj][n][3]); }
                    s += __shfl_xor(s, 16); s += __shfl_xor(s, 32);
                    const float mw = s * (1.0f / 64.0f); float q = 0.f;
#pragma unroll
                    for (int bj = 0; bj < 2; ++bj)
#pragma unroll
                        for (int n = 0; n < 2; ++n) { const f32x4 d = t[bj][n] - mw; q += (d[0] * d[0] + d[1] * d[1]) + (d[2] * d[2] + d[3] * d[3]); }
                    q += __shfl_xor(q, 16); q += __shfl_xor(q, 32);
                    if (fq == 0) sgv[row * 8 + sidx] = ((u64)__float_as_uint(q) << 32) | (u64)__float_as_uint(mw);
#pragma unroll
                    for (int bj = 0; bj < 2; ++bj) __builtin_nontemporal_store(pack8(t[bj][0], t[bj][1]), (u32x4*)(dstb + row * 32 + (size_t)bj * 4 * PLU));
                    asm volatile("" ::: "memory");
                }
        }
        else {
            const int p = pn - 13, wave = wr * 4 + wc, ln = fq * 16 + fr;
#pragma unroll
            for (int ai = 0; ai < 2; ++ai)
#pragma unroll
                for (int m = 0; m < 4; ++m) {
                    const size_t idx = ((((size_t)(u.pm * 8 + p) * 8 + wave) * 8 + (ai * 4 + m)) * 64 + ln) * 8;
                    f32x4 r[2], sb[2];
#pragma unroll
                    for (int n = 0; n < 2; ++n) {
                        const f32x4 xa = acc[ai][0][m][n] * (-LOG2E), xb = acc[ai][1][m][n] * (-LOG2E);
                        f32x4 ea = {fast_exp2(xa[0]), fast_exp2(xa[1]), fast_exp2(xa[2]), fast_exp2(xa[3])}, eb = {fast_exp2(xb[0]), fast_exp2(xb[1]), fast_exp2(xb[2]), fast_exp2(xb[3])};
                        ea = __builtin_elementwise_min(ea, (f32x4){1e30f, 1e30f, 1e30f, 1e30f}) + 1.0f; eb = __builtin_elementwise_min(eb, (f32x4){1e30f, 1e30f, 1e30f, 1e30f}) + 1.0f;
                        const f32x4 ia = {fast_rcp(ea[0]), fast_rcp(ea[1]), fast_rcp(ea[2]), fast_rcp(ea[3])};
                        sb[n] = (f32x4){fast_rcp(eb[0]), fast_rcp(eb[1]), fast_rcp(eb[2]), fast_rcp(eb[3])}; r[n] = eb * ia; }
                    __builtin_nontemporal_store(pack8(r[0], r[1]), (u32x4*)(SA + idx)); __builtin_nontemporal_store(pack8(sb[0], sb[1]), (u32x4*)(SB + idx));
                    asm volatile("" ::: "memory");
                }
        }
    }
};

struct EpiGate {
    static constexpr bool HAS_PREP = false; static constexpr int MID_T = 4;
    const bf16* SA; const bf16* SB; bf16* T;
    __device__ __forceinline__ void prep(const Unit&, int, int) const {}
    __device__ __forceinline__ void mid(f32x4 (&acc)[2][2][4][2], const Unit& u, int wr, int wc, int fr, int fq) const {
        asm volatile("" : "+v"(fr), "+v"(fq));
        const int wave = wr * 4 + wc, ln = fq * 16 + fr;
        u32x4 w[2][8];
#pragma unroll
        for (int bj = 0; bj < 2; ++bj)
#pragma unroll
            for (int j = 0; j < 8; ++j) w[bj][j] = *(const u32x4*)(SA + ((((size_t)(u.pm * 8 + 2 * u.pn + bj) * 8 + wave) * 8 + j) * 64 + ln) * 8);
#pragma unroll
        for (int bj = 0; bj < 2; ++bj)
#pragma unroll
            for (int j = 0; j < 8; ++j) { const int ai = j >> 2, m = j & 3; f32x4 r0, r1; unpack8(w[bj][j], r0, r1); acc[ai][bj][m][0] *= r0; acc[ai][bj][m][1] *= r1; asm volatile("" : "+v"(acc[ai][bj][m][0]), "+v"(acc[ai][bj][m][1])); }
        asm volatile("" ::: "memory");
    }
    __device__ __forceinline__ void operator()(f32x4 (&acc)[2][2][4][2], const Unit& u, int wr, int wc, int fr, int fq, int) const {
        asm volatile("" : "+v"(fr), "+v"(fq));
        const int wave = wr * 4 + wc, ln = fq * 16 + fr;
        u32x4 w[2][8];
#pragma unroll
        for (int bj = 0; bj < 2; ++bj)
#pragma unroll
            for (int j = 0; j < 8; ++j) w[bj][j] = *(const u32x4*)(SB + ((((size_t)(u.pm * 8 + 2 * u.pn + bj) * 8 + wave) * 8 + j) * 64 + ln) * 8);
#pragma unroll
        for (int bj = 0; bj < 2; ++bj)
#pragma unroll
            for (int j = 0; j < 8; ++j) { const int ai = j >> 2, m = j & 3; f32x4 b0, b1; unpack8(w[bj][j], b0, b1);
                __builtin_nontemporal_store(pack8(acc[ai][bj][m][0] * b0, acc[ai][bj][m][1] * b1), (u32x4*)(T + (size_t)(u.pm * BM + ai * HALF + wr * 64 + m * 16 + fr) * DM + u.pn * BM + bj * HALF + wc * 32 + 8 * fq)); }
        asm volatile("" ::: "memory");
    }
};
}

#define XB_TMO      128
#define XB_XCNT(j)  (256  + 64 * (j))
#define XB_XSUB(j)  (1280 + 64 * (j))
#define XB_XGEN(j)  (2304 + 64 * (j))
#define XB_TOP      3328
#define XB_TOPGEN   3392
#define XCD_BAR_WORDS 3456
#define XB_SPIN_CAP (1u << 18)
__device__ __forceinline__ unsigned xb_ld(unsigned* p)              { return __hip_atomic_load(p, __ATOMIC_RELAXED, __HIP_MEMORY_SCOPE_AGENT); }
__device__ __forceinline__ unsigned xb_add(unsigned* p, unsigned v) { return __hip_atomic_fetch_add(p, v, __ATOMIC_RELAXED, __HIP_MEMORY_SCOPE_AGENT); }
__device__ __forceinline__ unsigned xb_xcc_id() { return (unsigned)__builtin_amdgcn_s_getreg((3 << 11) | 20) & 0xFu; }
#define XB_SPIN(cond, bar) do { unsigned _sp = 0; while (cond) { __builtin_amdgcn_s_sleep(1); \
    if ((++_sp & 255u) == 0u) { if (xb_ld(&(bar)[XB_TMO])) break; if (_sp > XB_SPIN_CAP) { atomicAdd(&(bar)[XB_TMO], 1u); break; } } } } while (0)
struct XcdBarrier { unsigned* bar; unsigned x; volatile LAS unsigned* st; };
__device__ __forceinline__ XcdBarrier xcd_barrier_post(unsigned* bar, volatile LAS unsigned* st, const bool leader) {
    XcdBarrier b; b.bar = bar; b.x = xb_xcc_id(); b.st = st;
    if (leader) (void)xb_add(&bar[XB_XCNT(b.x)], 1u);
    return b;
}
__device__ __forceinline__ void xcd_barrier_complete(unsigned* bar, unsigned x, unsigned& nloc, unsigned& nx) {
    const unsigned G = gridDim.x * gridDim.y * gridDim.z;
    unsigned sum, cnt, mine, sp = 0u;
    for (;;) {
        sum = 0u; cnt = 0u; mine = 0u;
#pragma unroll
        for (unsigned j = 0; j < 16; ++j) { const unsigned c = xb_ld(&bar[XB_XCNT(j)]); sum += c; cnt += (c > 0u) ? 1u : 0u; mine = (j == x) ? c : mine; }
        if (sum == G) break;
        __builtin_amdgcn_s_sleep(1);
        if ((++sp & 255u) == 0u) { if (xb_ld(&bar[XB_TMO])) break; if (sp > XB_SPIN_CAP) { atomicAdd(&bar[XB_TMO], 1u); break; } }
    }
    nloc = mine > 0u ? mine : 1u; nx = cnt > 0u ? cnt : 1u;
}
__device__ __forceinline__ void xcd_barrier(const XcdBarrier& b, const bool leader) {
    asm volatile("s_waitcnt vmcnt(0)" ::: "memory");
    __syncthreads();
    if (leader) {
        unsigned* bar = b.bar;
        __builtin_amdgcn_s_waitcnt(0);
        unsigned nloc = b.st[0], nx = b.st[1];
        if (nloc == 0u) { xcd_barrier_complete(bar, b.x, nloc, nx); b.st[0] = nloc; b.st[1] = nx; }
        const unsigned old = xb_add(&bar[XB_XSUB(b.x)], 1u);
        const unsigned gen = old / nloc;
        if (old + 1u == (gen + 1u) * nloc) {
            __builtin_amdgcn_fence(__ATOMIC_RELEASE, "agent");
            asm volatile("s_waitcnt vmcnt(0)" ::: "memory");
            const unsigned og = xb_add(&bar[XB_TOP], 1u);
            const unsigned tg = og / nx;
            if (og + 1u == (tg + 1u) * nx) xb_add(&bar[XB_TOPGEN], 1u);
            else XB_SPIN(xb_ld(&bar[XB_TOPGEN]) == tg, bar);
            __builtin_amdgcn_fence(__ATOMIC_ACQUIRE, "agent");
            xb_add(&bar[XB_XGEN(b.x)], 1u);
            asm volatile("s_waitcnt vmcnt(0)" ::: "memory");
        } else {
            XB_SPIN(xb_ld(&bar[XB_XGEN(b.x)]) == gen, bar);
            __builtin_amdgcn_fence(__ATOMIC_ACQUIRE, "agent");
            asm volatile("s_waitcnt vmcnt(0)" ::: "memory");
        }
    }
    __syncthreads();
}

struct Args { const float* in[27]; float* out; unsigned char* ws; int ph_lo, ph_hi, li, pad; };
struct Frame {
    LAS unsigned char* lds; int tid, lane, wave, vcu, G;
    const float* const* in; float* out; unsigned char* ws;
};
#define WSP(T, off) ((T*)(F.ws + (off)))

__device__ __forceinline__ void p0_tr_item(const float* W, int N, bf16* WT, int ldk, int koff, int dst_row0, const float* g, LAS float* scr, int k0, int n0, int lane,
                                           float* part = nullptr, int bias_off = 0, const float* bvec = nullptr) {
    f32x4 w[8]; float gk[8], bk[8];
#pragma unroll
    for (int i = 0; i < 8; ++i) { const int kk = 8 * i + (lane >> 3); w[i] = *(const f32x4*)(W + (size_t)(k0 + kk) * N + n0 + 4 * (lane & 7)); gk[i] = g ? g[k0 + kk] : 1.0f; bk[i] = part ? bvec[k0 + kk] : 0.f; }
    f32x4 cs = {0.f, 0.f, 0.f, 0.f}, bi = cs;
#pragma unroll
    for (int i = 0; i < 8; ++i) { const int kk = 8 * i + (lane >> 3); LAS float* d = scr + kk * 33 + 4 * (lane & 7); f32x4 v = w[i]; if (g) v = v * gk[i]; d[0] = v[0]; d[1] = v[1]; d[2] = v[2]; d[3] = v[3];
        if (part) { cs += (f32x4){bfround(v[0]), bfround(v[1]), bfround(v[2]), bfround(v[3])}; bi += w[i] * bk[i]; } }
    if (part) {
#pragma unroll
        for (int c = 0; c < 4; ++c) { cs[c] += __shfl_xor(cs[c], 8); cs[c] += __shfl_xor(cs[c], 16); cs[c] += __shfl_xor(cs[c], 32); bi[c] += __shfl_xor(bi[c], 8); bi[c] += __shfl_xor(bi[c], 16); bi[c] += __shfl_xor(bi[c], 32); }
        if (lane < 8) { *(f32x4*)(part + 4 * lane) = cs; *(f32x4*)(part + bias_off + 4 * lane) = bi; }
    }
    asm volatile("s_waitcnt lgkmcnt(0)" ::: "memory");
    const int c = lane & 7;
#pragma unroll
    for (int j = 0; j < 4; ++j) { const int n = (lane >> 3) + 8 * j; const LAS float* s = scr + (8 * c) * 33 + n;
        u32x4 o; o.x = pk2(s[0 * 33], s[1 * 33]); o.y = pk2(s[2 * 33], s[3 * 33]); o.z = pk2(s[4 * 33], s[5 * 33]); o.w = pk2(s[6 * 33], s[7 * 33]);
        *(u32x4*)(WT + (size_t)(dst_row0 + n) * ldk + koff + k0 + 8 * c) = o; }
    asm volatile("s_waitcnt lgkmcnt(0)" ::: "memory");
}
__device__ __forceinline__ int swiglu_row(int n, int sel) { return 256 * (n >> 7) + (n & 127) + sel * 128; }
__device__ __forceinline__ int win_row(int n) { if (n < 3328) return n; const int q = n - 3328; return q < 1024 ? 3328 + 256 * (q >> 7) + (q & 127) : 3328 + 256 * ((q - 1024) >> 7) + 128 + (q & 127); }

__device__ __forceinline__ void p0_prologue(Frame& F) {
    const int gw = F.vcu * 8 + F.wave, NGW = F.G * 8, lane = F.lane;
    const int gt = F.vcu * 512 + F.tid, NGT = F.G * 512;
    float* sm = WSP(float, WS_SMALL);
    float* part16 = WSP(float, WS_LSE);
    LAS float* scr = (LAS float*)(F.lds + F.wave * 16384);
    for (int it = gw; it < 12032; it += NGW) {
        int r = it;
        if (r < 2816) { const int sel = r / 1408, q = r % 1408, kb = q / 88, nb = q % 88; p0_tr_item(sel ? F.in[9] : F.in[8], DFF, WSP(bf16, WS_WF1), DM, 0, swiglu_row(nb * 32, sel), nullptr, scr, kb * 64, nb * 32, lane); continue; } r -= 2816;
        if (r < 1408) { const int kb = r / 32, nb = r % 32; p0_tr_item(F.in[10], DM, WSP(bf16, WS_WF1D), DFF, 0, nb * 32, nullptr, scr, kb * 64, nb * 32, lane); continue; } r -= 1408;
        if (r < 2688) { const int kb = r / 168, nb = r % 168; p0_tr_item(F.in[11], INW, WSP(bf16, WS_WIN), DM, 0, win_row(nb * 32), F.in[6], scr, kb * 64, nb * 32, lane, part16 + kb * 22016 + win_row(nb * 32), 5376, F.in[7]); continue; } r -= 2688;
        if (r < 128) { const int kb = r / 32, nb = r % 32; p0_tr_item(F.in[17], DM, WSP(bf16, WS_WOAB), 768, 0, nb * 32, nullptr, scr, kb * 64, nb * 32, lane); continue; } r -= 128;
        if (r < 256) { const int kb = r / 32, nb = r % 32; p0_tr_item(F.in[18], DM, WSP(bf16, WS_WOAB), 768, 256, nb * 32, nullptr, scr, kb * 64, nb * 32, lane); continue; } r -= 256;
        if (r < 512) { const int kb = r / 32, nb = r % 32; p0_tr_item(F.in[19], DM, WSP(bf16, WS_WOUT), DM, 0, nb * 32, nullptr, scr, kb * 64, nb * 32, lane); continue; } r -= 512;
        if (r < 2816) { const int sel = r / 1408, q = r % 1408, kb = q / 88, nb = q % 88; p0_tr_item(sel ? F.in[23] : F.in[22], DFF, WSP(bf16, WS_WF2), DM, 0, swiglu_row(nb * 32, sel), F.in[20], scr, kb * 64, nb * 32, lane, part16 + kb * 22016 + 10752 + swiglu_row(nb * 32, sel), 5632, F.in[21]); continue; } r -= 2816;
        { const int kb = r / 32, nb = r % 32; p0_tr_item(F.in[24], DM, WSP(bf16, WS_WF2D), DFF, 0, nb * 32, nullptr, scr, kb * 64, nb * 32, lane); }
    }
    for (int i = gt; i < 12 * 192; i += NGT) { const int hj = i / 192, x = i % 192, rel = x - 32, g = hj >> 2;
        sm[SM_BT + i] = (rel >= 0 && rel <= 128) ? F.in[5][(int)T5BUCKET[g][rel] * 12 + hj] * LOG2E : NEGBIG; }
    for (int i = gt; i < 4 * 128 * 128; i += NGT) { const int p = (i >> 7) & 127, q = i & 127; WSP(bf16, WS_WSB)[i] = (bf16)(q <= p ? f2bf(F.in[15][i]) : 0u); }
    for (int i0 = gt; i0 < M * 128; i0 += 4 * NGT) {
        f32x4 a[4], b[4];
#pragma unroll
        for (int k = 0; k < 4; ++k) { const int i = i0 + k * NGT; if (i < M * 128) { const int row = i >> 7, c8 = i & 127;
            const float* src = (row < MP ? F.in[0] + (size_t)row * DM : F.in[1] + (size_t)(row - MP) * DM) + c8 * 8;
            a[k] = __builtin_nontemporal_load((const f32x4*)src); b[k] = __builtin_nontemporal_load((const f32x4*)(src + 4)); } }
#pragma unroll
        for (int k = 0; k < 4; ++k) { const int i = i0 + k * NGT; if (i < M * 128) { const int row = i >> 7, c8 = i & 127;
            *(u32x4*)(WSP(bf16, WS_XB) + (size_t)row * DM + c8 * 8) = pack8(a[k], b[k]); } }
    }
}

constexpr int CW_CQ_HEAD = 8192, CW_DONE = 9216, CW_PCNT = 10240, CQ_PER_X = 669;
template <int G_> __device__ __forceinline__ void copy_chunk_g(const f32x4* src, f32x4* dst, unsigned f0, int tid) {
    constexpr unsigned W = 128u << (2 * G_), per = (W - 4u) * 128u;
#pragma unroll
    for (int bt = 0; bt < 2; ++bt) { f32x4 v[8]; size_t o[8];
#pragma unroll
        for (int j = 0; j < 8; ++j) { const unsigned f = f0 + (unsigned)((bt * 8 + j) * 512 + tid), bd = f / per, off = f - bd * per; o[j] = (size_t)bd * (W * 128u) + off; v[j] = __builtin_nontemporal_load(src + o[j] + 512); }
#pragma unroll
        for (int j = 0; j < 8; ++j) __builtin_nontemporal_store(v[j], dst + o[j]);
    }
}
__device__ __forceinline__ void copy_chunk(Frame& F, int c) {
    if (c < 248) copy_chunk_g<0>((const f32x4*)F.in[2], (f32x4*)(F.out + O_W0S), (unsigned)c * 8192u, F.tid);
    else if (c < 1264) copy_chunk_g<1>((const f32x4*)F.in[3], (f32x4*)(F.out + O_W1S), (unsigned)(c - 248) * 8192u, F.tid);
    else copy_chunk_g<2>((const f32x4*)F.in[4], (f32x4*)(F.out + O_W2S), (unsigned)(c - 1264) * 8192u, F.tid);
}
__device__ __forceinline__ void copy_fill(Frame& F, unsigned* ctl, int phase, bool drain) {
    volatile LAS int* slot = (volatile LAS int*)(F.lds + MISC_OFF + 64);
    const unsigned x = xb_xcc_id() & 7u;
    __syncthreads();
    if (F.tid == 0 && !drain) (void)__hip_atomic_fetch_add(ctl + CW_DONE + 64 * phase, 1u, __ATOMIC_RELAXED, __HIP_MEMORY_SCOPE_AGENT);
    for (unsigned q = 0; q < (drain ? 8u : 1u); ++q) {
        const unsigned xq = (x + q) & 7u;
        for (;;) {
            if (F.tid == 0) { int c = -1;
                if (drain || __hip_atomic_load(ctl + CW_DONE + 64 * phase, __ATOMIC_RELAXED, __HIP_MEMORY_SCOPE_AGENT) < (unsigned)F.G) {
                    const unsigned h = __hip_atomic_fetch_add(ctl + CW_CQ_HEAD + 64 * xq, 1u, __ATOMIC_RELAXED, __HIP_MEMORY_SCOPE_AGENT); if (h < (unsigned)CQ_PER_X) c = (int)(xq * CQ_PER_X + h); }
                *slot = c; }
            __syncthreads();
            const int c = *slot;
            __syncthreads();
            if (c < 0) break;
            copy_chunk(F, c);
        }
    }
}

__device__ __forceinline__ f32x16 mfma32(bf16x8 a, bf16x8 b, f32x16 c) { return __builtin_amdgcn_mfma_f32_32x32x16_bf16(a, b, c, 0, 0, 0); }
__device__ __forceinline__ s16x4 trld(const LAS unsigned char* p) { return __builtin_bit_cast(s16x4, __builtin_amdgcn_ds_read_tr16_b64_v4i16((LAS s16x4*)p)); }

__device__ __forceinline__ void attn_unit(Frame& F, int au, LAS unsigned char* wl, int& cur_gj) {
    int lane = F.lane; asm volatile("" : "+v"(lane));
    const int r32 = lane & 31, hi = lane >> 5;
    const int blk = au & 63, bg = au >> 6, gj = bg % 12, b = bg / 12, g = gj >> 2, j = gj & 3;
    const int dsh = 2 * g, d = 1 << dsh, bpr = 64 >> dsh, r = blk >> (6 - dsh), m0 = (blk & (bpr - 1)) * 32;
    const size_t rowbase = (size_t)b * SEQ; const int hc = g * 256 + j * 64;
    const bf16* Qb = WSP(bf16, WS_Q); const bf16* Kb = WSP(bf16, WS_K); const bf16* Vb = WSP(bf16, WS_V);
    LAS float* tab = (LAS float*)(wl + 8192);
    if (gj != cur_gj) { const float* bt = WSP(float, WS_SMALL) + SM_BT + gj * 192;
#pragma unroll
        for (int i = 0; i < 3; ++i) tab[lane + 64 * i] = bt[lane + 64 * i];
        cur_gj = gj; }
    const int tq = (m0 + r32) * d + r;
    const unsigned voff = (unsigned)((lane >> 3) * d * 64 + (lane & 7) * 8);
    const long ub = (long)gj * (long)PLQ + (long)(rowbase + r) * 64;
#define AT_LD4(dst_, base_, sp_) do { _Pragma("unroll") for (int ii_ = 0; ii_ < 4; ++ii_) { const int sp__ = (sp_) + 8 * ii_; (dst_)[ii_] = *(const u32x4*)((base_) + ub + (long)((sp__ < 0 ? 0 : sp__) * d) * 64 + voff); } } while (0)
    const int i0 = m0 >= 128 ? 0 : (128 - m0) >> 5;
    LAS unsigned char* kb = wl + 12288;
    const int wro = (lane >> 3) * 128 + (((lane & 7) ^ ((lane >> 3) & 7)) << 4);
    u32x4 kr[5][4];
    bf16x8 qf[4];
    {
        u32x4 qr[4];
        AT_LD4(qr, Qb, m0);
        asm volatile("" ::: "memory");
#pragma unroll
        for (int i = 0; i < 5; ++i) AT_LD4(kr[i], Kb, m0 - 128 + 32 * i);
#pragma unroll
        for (int ii = 0; ii < 4; ++ii) *(LAS u32x4*)(kb + wro + 1024 * ii) = qr[ii];
#pragma unroll
        for (int s = 0; s < 4; ++s) qf[s] = *(const LAS bf16x8*)(kb + r32 * 128 + (((2 * s + hi) ^ (r32 & 7)) << 4));
    }
    f32x16 sc[5];
#pragma unroll
    for (int i = 0; i < 5; ++i) {
#pragma unroll
        for (int ii = 0; ii < 4; ++ii) *(LAS u32x4*)(kb + wro + 1024 * ii) = kr[i][ii];
        AT_LD4(kr[i], Vb, m0 - 128 + 32 * i);
        bf16x8 kf[4];
#pragma unroll
        for (int s = 0; s < 4; ++s) kf[s] = *(const LAS bf16x8*)(kb + r32 * 128 + (((2 * s + hi) ^ (r32 & 7)) << 4));
        f32x16 a = {};
#pragma unroll
        for (int s = 0; s < 4; ++s) a = mfma32(kf[s], qf[s], a);
        const LAS float* tb = tab + (r32 - 4 * hi + 4) + (i >= i0 ? 156 - 32 * i : 192 + 27);
#pragma unroll
        for (int R = 0; R < 16; ++R) a[R] += tb[-((R & 3) + 8 * (R >> 2))];
        sc[i] = a;
    }
    float mx = NEGBIG;
#pragma unroll
    for (int i = 0; i < 5; ++i)
#pragma unroll
        for (int R = 0; R < 16; ++R) mx = fmaxf(mx, sc[i][R]);
    mx = fmaxf(mx, __shfl_xor(mx, 32));
    float l = 0.f;
#pragma unroll
    for (int i = 0; i < 5; ++i)
#pragma unroll
        for (int R = 0; R < 16; ++R) { const float p = fast_exp2(sc[i][R] - mx); sc[i][R] = p; l += p; }
    l += __shfl_xor(l, 32);
    f32x16 o0 = {}, o1 = {};
    const int vaoff = (4 * hi + ((lane & 15) >> 2)) * 64 + ((lane >> 4) & 1) * 32 + (lane & 3) * 8;
    const int vwo = ((lane & 7) >> 2) * 2048 + (lane >> 3) * 64 + (lane & 3) * 16;
#pragma unroll
    for (int i = 0; i < 5; ++i) {
        LAS unsigned char* vb = wl + (i & 1) * 4096;
        {
#pragma unroll
            for (int ii = 0; ii < 4; ++ii) *(LAS u32x4*)(vb + vwo + 512 * ii) = kr[i][ii];
            const LAS unsigned char* va = vb + vaoff;
#pragma unroll
            for (int s = 0; s < 2; ++s) {
                u32x4 pw; pw.x = cvt_pk_bf16(sc[i][8 * s + 0], sc[i][8 * s + 1]); pw.y = cvt_pk_bf16(sc[i][8 * s + 2], sc[i][8 * s + 3]); pw.z = cvt_pk_bf16(sc[i][8 * s + 4], sc[i][8 * s + 5]); pw.w = cvt_pk_bf16(sc[i][8 * s + 6], sc[i][8 * s + 7]);
                const bf16x8 pb = __builtin_bit_cast(bf16x8, pw);
                { const s16x4 lo = trld(va + s * 1024), h2 = trld(va + s * 1024 + 512); const bf16x8 A = {lo[0], lo[1], lo[2], lo[3], h2[0], h2[1], h2[2], h2[3]}; o0 = mfma32(A, pb, o0); }
                { const s16x4 lo = trld(va + 2048 + s * 1024), h2 = trld(va + 2048 + s * 1024 + 512); const bf16x8 A = {lo[0], lo[1], lo[2], lo[3], h2[0], h2[1], h2[2], h2[3]}; o1 = mfma32(A, pb, o1); }
            }
        }
    }
#undef AT_LD4
    const float inv = 1.0f / l;
    {
        LAS unsigned char* ob = wl;
#pragma unroll
        for (int G4 = 0; G4 < 4; ++G4) {
            u32x2 w0; w0.x = cvt_pk_bf16(o0[4 * G4] * inv, o0[4 * G4 + 1] * inv); w0.y = cvt_pk_bf16(o0[4 * G4 + 2] * inv, o0[4 * G4 + 3] * inv); *(LAS u32x2*)(ob + r32 * 144 + (8 * G4 + 4 * hi) * 2) = w0;
            u32x2 w1; w1.x = cvt_pk_bf16(o1[4 * G4] * inv, o1[4 * G4 + 1] * inv); w1.y = cvt_pk_bf16(o1[4 * G4 + 2] * inv, o1[4 * G4 + 3] * inv); *(LAS u32x2*)(ob + r32 * 144 + (32 + 8 * G4 + 4 * hi) * 2) = w1;
        }
        bf16* OGb = WSP(bf16, WS_OG);
#pragma unroll
        for (int ii = 0; ii < 4; ++ii) { const int qi = 8 * ii + (lane >> 3), ch = lane & 7;
            const u32x4 w = *(const LAS u32x4*)(ob + qi * 144 + ch * 16);
            *(u32x4*)(OGb + (size_t)gj * PLQ + (rowbase + (size_t)((m0 + qi) * d + r)) * 64 + ch * 8) = w; }
    }
    if (hi == 0) WSP(float, WS_LSE)[(rowbase + tq) * 12 + gj] = (mx + __builtin_amdgcn_logf(l)) * LN2F;
}

__device__ __forceinline__ void attn_sample_task(Frame& F, int task, LAS unsigned char* wl) {
    int lane = F.lane; asm volatile("" : "+v"(lane));
    const int sub = lane >> 4, l16 = lane & 15, t = task & 3, gj = (task >> 2) % 12, bd = task / 48, g = gj >> 2, j = gj & 3;
    const int W = 128 << (2 * g), d = 1 << (2 * g), hc = g * 256 + j * 64;
    const size_t row = (size_t)MP + bd * 4 + t;
    const float* stu = (g == 0 ? F.in[2] : g == 1 ? F.in[3] : F.in[4]) + (size_t)bd * W * 512 + j * 64;
    const float* st = stu + 4 * l16;
    const float* nw = F.out + (g == 0 ? O_W0S : g == 1 ? O_W1S : O_W2S) + (size_t)bd * W * 512 + j * 64 + 4 * l16;
    const float* bt = WSP(float, WS_SMALL) + SM_BT + gj * 192 + 32;
    LAS float* scb = (LAS float*)(wl + 10240);
    const u32x2 qw = *(const u32x2*)(WSP(bf16, WS_Q) + (size_t)gj * PLQ + row * 64 + 4 * l16);
    const f32x4 qv = {bflo(qw.x), bfhi(qw.x), bflo(qw.y), bfhi(qw.y)};
    const float* r0p; { const int idx = W + t - sub * d; r0p = idx < W ? st + (size_t)idx * 512 : nw + (size_t)(idx - 4) * 512; }
#define SOFF(u_) ((unsigned)((W + t - (4 * (u_) + sub < 128 ? 4 * (u_) + sub : 128) * d) * 512 + 4 * l16))
    {
        f32x4 kv[17];
        kv[0] = *(const f32x4*)r0p;
#pragma unroll
        for (int u = 1; u < 17; ++u) kv[u] = *(const f32x4*)(stu + SOFF(u));
#pragma unroll
        for (int u = 0; u < 17; ++u) { const int i = u * 4 + sub;
            float s = (qv[0] * kv[u][0] + qv[1] * kv[u][1]) + (qv[2] * kv[u][2] + qv[3] * kv[u][3]);
            s += __shfl_xor(s, 1); s += __shfl_xor(s, 2); s += __shfl_xor(s, 4); s += __shfl_xor(s, 8);
            if (l16 == 0) scb[i] = s + bt[i]; }
        asm volatile("" ::: "memory");
    }
    f32x4 vA[11], vB[11], vC[11];
    {
        f32x4 kv[16];
#pragma unroll
        for (int u = 0; u < 16; ++u) kv[u] = *(const f32x4*)(stu + SOFF(17 + u));
        vA[0] = *(const f32x4*)(r0p + 256);
#pragma unroll
        for (int u = 1; u < 11; ++u) vA[u] = *(const f32x4*)(stu + 256 + SOFF(u));
#pragma unroll
        for (int u = 0; u < 16; ++u) { const int i = (17 + u) * 4 + sub, ii = i < 128 ? i : 128;
            float s = (qv[0] * kv[u][0] + qv[1] * kv[u][1]) + (qv[2] * kv[u][2] + qv[3] * kv[u][3]);
            s += __shfl_xor(s, 1); s += __shfl_xor(s, 2); s += __shfl_xor(s, 4); s += __shfl_xor(s, 8);
            if (l16 == 0 && i <= 128) scb[i] = s + bt[ii]; }
    }
    asm volatile("s_waitcnt lgkmcnt(0)" ::: "memory");
#pragma unroll
    for (int u = 0; u < 11; ++u) vB[u] = *(const f32x4*)(stu + 256 + SOFF(11 + u));
    const float v0 = scb[lane], v1 = scb[lane + 64], v2 = lane == 0 ? scb[128] : NEGBIG;
    const float mx = wave_max(fmaxf(fmaxf(v0, v1), v2));
    const float p0 = fast_exp2(v0 - mx), p1 = fast_exp2(v1 - mx), p2 = lane == 0 ? fast_exp2(v2 - mx) : 0.f;
    const float l = wave_sum(p0 + p1 + p2);
    scb[lane] = p0; scb[lane + 64] = p1; if (lane < 4) scb[128 + lane] = p2;
    asm volatile("s_waitcnt lgkmcnt(0)" ::: "memory");
    f32x4 o4 = {0.f, 0.f, 0.f, 0.f};
#pragma unroll
    for (int u = 0; u < 11; ++u) o4 += scb[u * 4 + sub] * vA[u];
    asm volatile("" ::: "memory");
#pragma unroll
    for (int u = 0; u < 11; ++u) vC[u] = *(const f32x4*)(stu + 256 + SOFF(22 + u));
#pragma unroll
    for (int u = 0; u < 11; ++u) o4 += scb[(11 + u) * 4 + sub] * vB[u];
#pragma unroll
    for (int u = 0; u < 11; ++u) o4 += scb[(22 + u) * 4 + sub] * vC[u];
#undef SOFF
#pragma unroll
    for (int c = 0; c < 4; ++c) { o4[c] += __shfl_xor(o4[c], 16); o4[c] += __shfl_xor(o4[c], 32); }
    const float inv = 1.0f / l;
    if (lane < 16) { u32x2 w; w.x = cvt_pk_bf16(o4[0] * inv, o4[1] * inv); w.y = cvt_pk_bf16(o4[2] * inv, o4[3] * inv); *(u32x2*)(WSP(bf16, WS_OG) + (size_t)gj * PLQ + row * 64 + 4 * l16) = w; }
    if (lane == 0) WSP(float, WS_LSE)[row * 12 + gj] = (mx + __builtin_amdgcn_logf(l)) * LN2F;
    asm volatile("s_waitcnt lgkmcnt(0)" ::: "memory");
}

__device__ __forceinline__ void sgu_unit(Frame& F, int su, LAS unsigned char* wl) {
    const int lane = F.lane, r32 = lane & 31, hi = lane >> 5;
    const int cb = su & 3, gg = (su >> 2) & 3, chunk = su >> 4, c0 = gg * 128 + cb * 32; const size_t row0 = (size_t)chunk * 128;
    LAS f32x2* st = (LAS f32x2*)(wl + 9216);
    const u64* sgv = WSP(u64, WS_SGV);
#pragma unroll
    for (int h = 0; h < 2; ++h) { const int rr = lane + 64 * h; const u32x4* p = (const u32x4*)(sgv + (row0 + rr) * 8);
        const u32x4 a = p[0], b = p[1], c = p[2], dd = p[3];
        const float mn[8] = {__uint_as_float(a.x), __uint_as_float(a.z), __uint_as_float(b.x), __uint_as_float(b.z), __uint_as_float(c.x), __uint_as_float(c.z), __uint_as_float(dd.x), __uint_as_float(dd.z)};
        const float m2[8] = {__uint_as_float(a.y), __uint_as_float(a.w), __uint_as_float(b.y), __uint_as_float(b.w), __uint_as_float(c.y), __uint_as_float(c.w), __uint_as_float(dd.y), __uint_as_float(dd.w)};
        float smn = 0.f;
#pragma unroll
        for (int i = 0; i < 8; ++i) smn += mn[i];
        const float mt = smn * 0.125f; float q = 0.f;
#pragma unroll
        for (int i = 0; i < 8; ++i) { const float e = mn[i] - mt; q += m2[i] + 64.0f * e * e; }
        st[rr] = (f32x2){mt, 1.0f / sqrtf(q * (1.0f / 512.0f) + LN_EPS)}; }
    const int ch = lane & 3;
    const float* lg = F.in[13] + c0 + ch * 8; const float* lb = F.in[14] + c0 + ch * 8;
    const f32x4 g0 = *(const f32x4*)lg, g1 = *(const f32x4*)(lg + 4), b0 = *(const f32x4*)lb, b1 = *(const f32x4*)(lb + 4);
    const bf16* GVb = WSP(bf16, WS_GV);
#pragma unroll
    for (int it = 0; it < 8; ++it) { const int rw = 16 * it + (lane >> 2);
        const u32x4 w = *(const u32x4*)(GVb + (size_t)(gg * 4 + cb) * PLU + (row0 + rw) * 32 + ch * 8); f32x4 x0, x1; unpack8(w, x0, x1); const f32x2 s = st[rw];
        x0 = (x0 - s.x) * s.y * g0 + b0; x1 = (x1 - s.x) * s.y * g1 + b1;
        *(LAS u32x4*)(wl + rw * 64 + ch * 16) = pack8(x0, x1); }
    const LAS unsigned char* va = wl + (8 * hi + ((lane & 15) >> 2)) * 64 + ((lane >> 4) & 1) * 32 + (lane & 3) * 8;
    bf16x8 Af[8];
#pragma unroll
    for (int ks = 0; ks < 8; ++ks) { const s16x4 lo = trld(va + ks * 1024), h2 = trld(va + ks * 1024 + 256); Af[ks] = (bf16x8){lo[0], lo[1], lo[2], lo[3], h2[0], h2[1], h2[2], h2[3]}; }
    const bf16* Wsb = WSP(bf16, WS_WSB) + (size_t)gg * 128 * 128;
    const bf16* Ub = WSP(bf16, WS_U); bf16* AY = WSP(bf16, WS_AY);
#pragma unroll
    for (int pt = 0; pt < 4; ++pt) {
        f32x16 acc = {};
#pragma unroll
        for (int ks = 0; ks < 2 * pt + 2; ++ks) { const bf16x8 B = *(const bf16x8*)(Wsb + (size_t)(32 * pt + r32) * 128 + 16 * ks + 8 * hi); acc = mfma32(Af[ks], B, acc); }
        const float sbv = F.in[16][gg * 128 + 32 * pt + r32];
        const size_t prow = row0 + 32 * pt + r32;
#pragma unroll
        for (int G4 = 0; G4 < 4; ++G4) { const int c4 = 8 * G4 + 4 * hi;
            const u32x2 uw = *(const u32x2*)(Ub + (size_t)(gg * 4 + cb) * PLU + prow * 32 + c4);
            u32x2 y; y.x = cvt_pk_bf16(bflo(uw.x) * (acc[4 * G4] + sbv), bfhi(uw.x) * (acc[4 * G4 + 1] + sbv)); y.y = cvt_pk_bf16(bflo(uw.y) * (acc[4 * G4 + 2] + sbv), bfhi(uw.y) * (acc[4 * G4 + 3] + sbv));
            *(u32x2*)(AY + prow * 768 + 256 + c0 + c4) = y; }
    }
    asm volatile("s_waitcnt lgkmcnt(0)" ::: "memory");
}
__device__ __forceinline__ void sgu_sample_task(Frame& F, int bd) {
    const int lane = F.lane, c = lane * 8, gg = lane >> 4;
    const size_t row0 = (size_t)MP + bd * 4;
    const u64* sgv = WSP(u64, WS_SGV); const bf16* GVb = WSP(bf16, WS_GV); const bf16* Ub = WSP(bf16, WS_U); bf16* AY = WSP(bf16, WS_AY);
    const f32x4 g0 = *(const f32x4*)(F.in[13] + c), g1 = *(const f32x4*)(F.in[13] + c + 4), b0 = *(const f32x4*)(F.in[14] + c), b1 = *(const f32x4*)(F.in[14] + c + 4);
    f32x4 vn[4][2];
#pragma unroll
    for (int t = 0; t < 4; ++t) {
        const u32x4* p = (const u32x4*)(sgv + (row0 + t) * 8);
        const u32x4 a = p[0], b = p[1], cc = p[2], dd = p[3];
        const float mn[8] = {__uint_as_float(a.x), __uint_as_float(a.z), __uint_as_float(b.x), __uint_as_float(b.z), __uint_as_float(cc.x), __uint_as_float(cc.z), __uint_as_float(dd.x), __uint_as_float(dd.z)};
        const float m2[8] = {__uint_as_float(a.y), __uint_as_float(a.w), __uint_as_float(b.y), __uint_as_float(b.w), __uint_as_float(cc.y), __uint_as_float(cc.w), __uint_as_float(dd.y), __uint_as_float(dd.w)};
        float smn = 0.f;
#pragma unroll
        for (int i = 0; i < 8; ++i) smn += mn[i];
        const float mt = smn * 0.125f; float q = 0.f;
#pragma unroll
        for (int i = 0; i < 8; ++i) { const float e = mn[i] - mt; q += m2[i] + 64.0f * e * e; }
        const float rs = 1.0f / sqrtf(q * (1.0f / 512.0f) + LN_EPS);
        f32x4 x0, x1; unpack8(*(const u32x4*)(GVb + (size_t)(lane >> 2) * PLU + (row0 + t) * 32 + (lane & 3) * 8), x0, x1);
        vn[t][0] = (x0 - mt) * rs * g0 + b0; vn[t][1] = (x1 - mt) * rs * g1 + b1;
        float* sv = F.out + O_SV + (size_t)(bd * 4 + t) * SGUW + c; *(f32x4*)sv = vn[t][0]; *(f32x4*)(sv + 4) = vn[t][1];
    }
#pragma unroll
    for (int p = 0; p < 4; ++p) {
        const float sbv = F.in[16][gg * 128 + p];
        f32x4 m0 = {sbv, sbv, sbv, sbv}, m1 = m0;
#pragma unroll
        for (int q = 0; q <= p; ++q) { const float w = F.in[15][(size_t)(gg * 128 + p) * 128 + q]; m0 += w * vn[q][0]; m1 += w * vn[q][1]; }
        f32x4 u0, u1; unpack8(*(const u32x4*)(Ub + (size_t)(lane >> 2) * PLU + (row0 + p) * 32 + (lane & 3) * 8), u0, u1);
        *(u32x4*)(AY + (row0 + p) * 768 + 256 + c) = pack8(u0 * m0, u1 * m1);
    }
}


#ifdef MK_PROBE
__device__ __constant__ int PRB_B[8] = {0, 0, 3, 5, 7, 12, 20, 31};
__device__ __constant__ int PRB_T[8] = {0, 37, 130, 1000, 2047, 255, 1290, 64};
__device__ __forceinline__ size_t probe_row(int w) { return (size_t)PRB_B[w] * SEQ + PRB_T[w]; }
__device__ __forceinline__ void probe_put(unsigned* ctl, int stage, float ref, float got) {
    float d = fabsf(ref - got) / (fabsf(ref) + 0.3f); if (!(d == d)) d = 1e30f; d = wave_max(d);
    if ((threadIdx.x & 63) == 0) atomicMax(ctl + 64 + stage, __float_as_uint(d));
}
__device__ __forceinline__ float probe_dot(const LAS float* vec, const float* W, int K, int ldw, int col) {
    float a = 0.f;
#pragma unroll 8
    for (int k = 0; k < K; ++k) a += vec[k] * W[(size_t)k * ldw + col];
    return a;
}
__device__ __forceinline__ void probe_ln_row(LAS float* vec, const bf16* rowp, const float* g, const float* b, int lane) {
    float x[16], s = 0.f;
    for (int i = 0; i < 16; ++i) { x[i] = bflo((unsigned)rowp[i * 64 + lane]); s += x[i]; }
    const float mean = wave_sum(s) * (1.0f / 1024.0f); float q = 0.f;
    for (int i = 0; i < 16; ++i) q += (x[i] - mean) * (x[i] - mean);
    const float rs = 1.0f / sqrtf(wave_sum(q) * (1.0f / 1024.0f) + LN_EPS);
    for (int i = 0; i < 16; ++i) { const int c = i * 64 + lane; vec[c] = (x[i] - mean) * rs * g[c] + b[c]; }
    asm volatile("s_waitcnt lgkmcnt(0)" ::: "memory");
}
__device__ __forceinline__ void probe_stage(Frame& F, unsigned* ctl, int stage) {
    const int lane = F.lane, w = F.wave; const size_t row = probe_row(w);
    LAS float* vec = (LAS float*)(F.lds + w * 16384);
    if (stage == 0) {
        const float* x = F.in[0] + row * DM;
        for (int i = 0; i < 16; ++i) vec[i * 64 + lane] = x[i * 64 + lane];
        asm volatile("s_waitcnt lgkmcnt(0)" ::: "memory");
        const int hc = lane * 44 + (lane * 5 + w) % 44; const float a = probe_dot(vec, F.in[8], DM, DFF, hc), b = probe_dot(vec, F.in[9], DM, DFF, hc);
        probe_put(ctl, 0, a * b / (1.0f + expf(-a)), bflo((unsigned)WSP(bf16, WS_ACT)[row * DFF + hc]));
        for (int i = 0; i < 44; ++i) vec[i * 64 + lane] = bflo((unsigned)WSP(bf16, WS_ACT)[row * DFF + i * 64 + lane]);
        asm volatile("s_waitcnt lgkmcnt(0)" ::: "memory");
        const int c = lane * 16 + (lane * 7 + w * 3) % 16; probe_put(ctl, 1, ALPHA * x[c] + 0.5f * probe_dot(vec, F.in[10], DFF, DM, c), bflo((unsigned)WSP(bf16, WS_V1)[row * DM + c]));
    } else if (stage == 1) {
        probe_ln_row(vec, WSP(bf16, WS_V1) + row * DM, F.in[6], F.in[7], lane);
        const int c = lane * 84 + (lane * 11 + w * 7) % 84; const float z = probe_dot(vec, F.in[11], DM, INW, c) + F.in[12][c];
        float ref, got;
        if (c < 768) { ref = z * QSCALE; got = bflo((unsigned)WSP(bf16, WS_Q)[row * QKVW + c]); }
        else if (c < 1536) { ref = z; got = bflo((unsigned)WSP(bf16, WS_K)[row * QKVW + c - 768]); }
        else if (c < 2304) { ref = z; got = bflo((unsigned)WSP(bf16, WS_V)[row * QKVW + c - 1536]); }
        else if (c < 2816) { ref = 0.5f * z * (1.0f + erff(z * 0.70710678f)); got = bflo((unsigned)WSP(bf16, WS_U)[row * SGUW + c - 2304]); }
        else if (c < 3328) { ref = 0.5f * z * (1.0f + erff(z * 0.70710678f)); got = bflo((unsigned)WSP(bf16, WS_GV)[row * SGUW + c - 2816]); }
        else if (c < 4352) { ref = 1.0f / (1.0f + expf(-z)); got = bflo((unsigned)WSP(bf16, WS_SA)[row * DM + c - 3328]); }
        else { ref = 1.0f / (1.0f + expf(-z)); got = bflo((unsigned)WSP(bf16, WS_SB)[row * DM + c - 4352]); }
        if (c >= 4352) {
            float csr = 0.f, bir = 0.f; unsigned wbad = 0u;
            for (int k = 0; k < DM; ++k) { const float wv = F.in[11][(size_t)k * INW + c]; csr += bfround(F.in[6][k] * wv); bir += F.in[7][k] * wv;
                if (f2bf(F.in[6][k] * wv) != (unsigned)WSP(bf16, WS_WIN)[(size_t)c * DM + k]) wbad = 1u; }
            bir += F.in[12][c];
            const float* smm = WSP(float, WS_SMALL);
            if (fabsf(csr - smm[SM_CS1 + c]) > 1e-3f) atomicOr(ctl + 98, 1u);
            if (fabsf(bir - smm[SM_B1 + c]) > 1e-3f) atomicOr(ctl + 98, 2u);
            if (wbad) atomicOr(ctl + 98, 4u);
        }
        if (c >= 4352) { float d = fabsf(ref - got) / (fabsf(ref) + 0.3f); if (d > 0.1f) { atomicOr(ctl + 96, 1u << (c & 7)); atomicOr(ctl + 97, 1u << ((c - 4352) >> 7)); } }
        { const int cls = c < 768 ? 0 : c < 1536 ? 1 : c < 2304 ? 2 : c < 2816 ? 3 : c < 3328 ? 4 : c < 4352 ? 5 : 6;
          for (int k = 0; k < 7; ++k) probe_put(ctl, 8 + k, cls == k ? ref : 0.f, cls == k ? got : 0.f); }
        probe_put(ctl, 2, ref, got);
    } else if (stage == 2) {
        const bf16* OG = WSP(bf16, WS_OG) + row * QKVW; const float* LSE = WSP(float, WS_LSE) + row * 12;
        for (int q = 0; q < 4; ++q) { const int c = lane * 4 + q, j = c >> 6;
            const float l0 = LSE[j], l1 = LSE[4 + j], l2 = LSE[8 + j], mx = fmaxf(fmaxf(l0, l1), l2), e0 = expf(l0 - mx), e1 = expf(l1 - mx), e2 = expf(l2 - mx);
            const float ref = (bflo((unsigned)OG[c]) * e0 + bflo((unsigned)OG[256 + c]) * e1 + bflo((unsigned)OG[512 + c]) * e2) / (e0 + e1 + e2);
            probe_put(ctl, 3, ref, bflo((unsigned)WSP(bf16, WS_AY)[row * 768 + c])); }
    } else if (stage == 3) {
        for (int i = 0; i < 12; ++i) vec[i * 64 + lane] = bflo((unsigned)WSP(bf16, WS_AY)[row * 768 + i * 64 + lane]);
        asm volatile("s_waitcnt lgkmcnt(0)" ::: "memory");
        const int c = lane * 16 + (lane * 7 + w * 3) % 16; const float a = probe_dot(vec, F.in[17], 256, DM, c), b = probe_dot(vec + 256, F.in[18], 512, DM, c);
        probe_put(ctl, 4, bflo((unsigned)WSP(bf16, WS_SA)[row * DM + c]) * a + bflo((unsigned)WSP(bf16, WS_SB)[row * DM + c]) * b, bflo((unsigned)WSP(bf16, WS_XB)[row * DM + c]));
    } else if (stage == 4) {
        probe_ln_row(vec, WSP(bf16, WS_V1) + row * DM, F.in[6], F.in[7], lane);
        const int c = lane * 16 + (lane * 7 + w * 3) % 16; const float h1 = vec[c];
        for (int i = 0; i < 16; ++i) vec[i * 64 + lane] = bflo((unsigned)WSP(bf16, WS_XB)[row * DM + i * 64 + lane]);
        asm volatile("s_waitcnt lgkmcnt(0)" ::: "memory");
        probe_put(ctl, 5, ALPHA * h1 + probe_dot(vec, F.in[19], DM, DM, c), bflo((unsigned)WSP(bf16, WS_V2)[row * DM + c]));
    } else if (stage == 5) {
        probe_ln_row(vec, WSP(bf16, WS_V2) + row * DM, F.in[20], F.in[21], lane);
        const int hc = lane * 44 + (lane * 5 + w) % 44; const float a = probe_dot(vec, F.in[22], DM, DFF, hc), b = probe_dot(vec, F.in[23], DM, DFF, hc);
        probe_put(ctl, 6, a * b / (1.0f + expf(-a)), bflo((unsigned)WSP(bf16, WS_ACT)[row * DFF + hc]));
    } else {
        probe_ln_row(vec, WSP(bf16, WS_V2) + row * DM, F.in[20], F.in[21], lane);
        const int c = lane * 16 + (lane * 7 + w * 3) % 16; const float h2 = vec[c];
        for (int i = 0; i < 44; ++i) vec[i * 64 + lane] = bflo((unsigned)WSP(bf16, WS_ACT)[row * DFF + i * 64 + lane]);
        asm volatile("s_waitcnt lgkmcnt(0)" ::: "memory");
        probe_put(ctl, 7, ALPHA * h2 + 0.5f * probe_dot(vec, F.in[24], DFF, DM, c), F.out[O_Y + row * DM + c]);
    }
    asm volatile("s_waitcnt lgkmcnt(0)" ::: "memory");
}
#define PROBE(stage) do { if (F.vcu == 0) probe_stage(F, ctl, stage); __syncthreads(); } while (0)
#else
#define PROBE(stage) do {} while (0)
#endif
__device__ __forceinline__ int rot_c(int rot, int G) { int c = (int)blockIdx.x + rot; while (c >= G) c -= G; return c; }
constexpr int N_PHASES = 11;
__global__ void __launch_bounds__(512, 2) mk_fwd(Args args) {
    extern __shared__ __attribute__((aligned(16))) unsigned char lds_raw[];
    Frame F;
    F.lds = (LAS unsigned char*)lds_raw;
    F.wave = __builtin_amdgcn_readfirstlane(threadIdx.x >> 6); F.lane = lane_now(); F.tid = F.wave * 64 + F.lane;
    F.G = gridDim.x; { const int bx = blockIdx.x; F.vcu = (F.G % 8 == 0) ? (bx % 8) * (F.G / 8) + bx / 8 : bx; }
    F.in = args.in; F.out = args.out; F.ws = args.ws;
    volatile LAS unsigned* MISC = (volatile LAS unsigned*)(F.lds + MISC_OFF);
    for (int u = F.tid; u < (LDS_BYTES - MISC_OFF) / 4; u += 512) ((LAS unsigned*)(F.lds + MISC_OFF))[u] = 0u;
    __syncthreads();
    unsigned* ctl = (unsigned*)(F.ws + WS_CTL);
    XcdBarrier bar; bar.bar = ctl + CW_BAR; bar.x = 0; bar.st = nullptr;
    if (MK_N_LAUNCHES == 1) bar = xcd_barrier_post(ctl + CW_BAR, MISC + 8, F.tid == 0);
    const int lo = args.ph_lo, hi = args.ph_hi;
#ifdef MK_PROBE
    if (lo >= 100) { if (F.vcu == 0) probe_stage(F, (unsigned*)(F.ws + WS_CTL), lo - 100); return; }
#endif
#ifdef MK_ONLY
#define IN(k) ((k) == MK_ONLY)
#else
#define IN(k) (lo <= (k) && (k) < hi)
#endif
#ifdef MK_STAMP_A
    u64* tsw = (u64*)(F.ws + WS_CTL) + 1024;
#define STAMP(k) do { if (blockIdx.x == 0 && F.tid == 0) tsw[(k)] = __builtin_amdgcn_s_memrealtime(); } while (0)
#else
#define STAMP(k) do {} while (0)
#endif
    STAMP(0);
#define SEAM(k) do { if (IN(k) && IN((k) + 1)) xcd_barrier(bar, F.wave == 0 && lane_now() == 0); STAMP((k) + 1); F.lane = lane_now(); F.tid = F.wave * 64 + F.lane; } while (0)
    LAS f32x2* stab = (LAS f32x2*)(F.lds + STAB_OFF);
#ifdef MK_PROBE
    const bool alt = (args.li == 99);
    if (args.li >= 200) {
        const int k = args.li - 200; const unsigned* A = (const unsigned*)(F.ws + (k == 0 ? WS_ACT : k == 1 ? WS_V1 : WS_V2)); const unsigned* B = (const unsigned*)(F.ws + (k == 0 ? 1412 * MiB : k == 1 ? 1767 * MiB : 1896 * MiB));
        const size_t n = (size_t)M * (k == 0 ? DFF : DM) / 2; unsigned cnt = 0;
        for (size_t i = (size_t)F.vcu * 512 + F.tid; i < n; i += (size_t)F.G * 512) cnt += (A[i] != B[i]) ? 1u : 0u;
        if (cnt) atomicAdd((unsigned*)(F.ws + WS_CTL) + 80 + k, cnt);
        return;
    }
#else
    const bool alt = false;
#endif
    const int gw = F.vcu * 8 + F.wave, NGW = F.G * 8;
    const int gt = F.vcu * 512 + F.tid, NGT = F.G * 512;
    float* sm = WSP(float, WS_SMALL);

    if (IN(0)) { p0_prologue(F); if (MK_DUP == 0) { __syncthreads(); p0_prologue(F); } }
    SEAM(0);
    if (IN(1)) {
        for (int i = gt; i < 22016; i += NGT) { float a = 0.f;
#pragma unroll
            for (int ks = 0; ks < 16; ++ks) a += WSP(float, WS_LSE)[ks * 22016 + i];
            if (i < 5376) sm[SM_CS1 + i] = a; else if (i < 10752) { const int rw = i - 5376; int col = rw; if (rw >= 3328) { const int q = rw - 3328, blk = q >> 8, wi = q & 255; col = (wi < 128 ? 3328 : 4352) + 128 * blk + (wi & 127); } sm[SM_B1 + rw] = a + F.in[12][col]; } else if (i < 16384) sm[SM_CS2 + i - 10752] = a; else sm[SM_B2 + i - 16384] = a; }
        pg8::Gemm g{WSP(bf16, WS_XB), WSP(bf16, WS_WF1), M, NFF2, DM}; pg8::StaticOrder S; S.init(M, NFF2, F.G, rot_c(0, F.G));
        pg8::EpiSwiglu<false> E{alt ? WSP(bf16, 1412 * MiB) : WSP(bf16, WS_ACT), nullptr, nullptr, nullptr, stab};
        pg8::gemm_phase(F.lds, g, S, E, F.wave);
        if (MK_DUP == 1) pg8::gemm_phase(F.lds, g, S, E, F.wave);
    }
    SEAM(1);
    if (IN(2)) {
        pg8::Gemm g{WSP(bf16, WS_ACT), WSP(bf16, WS_WF1D), M, DM, DFF}; pg8::StaticOrder S; S.init(M, DM, F.G, rot_c(112, F.G));
        pg8::EpiDown<0> E{F.in[0], F.in[1], WSP(bf16, WS_XB), nullptr, nullptr, nullptr, stab, alt ? WSP(bf16, 1767 * MiB) : WSP(bf16, WS_V1), nullptr, alt ? WSP(u64, WS_S3) : WSP(u64, WS_S1), 0.5f};
        pg8::gemm_phase(F.lds, g, S, E, F.wave);
        if (MK_DUP == 2) pg8::gemm_phase(F.lds, g, S, E, F.wave);
        copy_fill(F, ctl, 2, false);
    }
    SEAM(2);
    if (IN(3)) {
        pg8::Gemm g{WSP(bf16, WS_V1), WSP(bf16, WS_WIN), M, INW, DM}; pg8::StaticOrder S; S.init(M, INW, F.G, rot_c(208, F.G));
        pg8::EpiWin E{sm + SM_CS1, sm + SM_B1, WSP(u64, WS_S1), stab, WSP(bf16, WS_Q), WSP(bf16, WS_K), WSP(bf16, WS_V), WSP(bf16, WS_U), WSP(bf16, WS_GV), WSP(bf16, WS_SA), WSP(bf16, WS_SB), WSP(u64, WS_SGV), F.out};
        pg8::gemm_phase(F.lds, g, S, E, F.wave);
        if (MK_DUP == 3) pg8::gemm_phase(F.lds, g, S, E, F.wave);
    }
    SEAM(3);
    if (IN(4)) {
        LAS unsigned char* wl = F.lds + F.wave * 16384;
        const bf16* OG = WSP(bf16, WS_OG); const float* LSE = WSP(float, WS_LSE); bf16* AY = WSP(bf16, WS_AY);
        int cur_gj = -1;
        ((LAS float*)(wl + 8192))[192 + F.lane] = NEGBIG;
#pragma unroll 1
        for (int rep = 0; rep < (MK_DUP == 4 ? 2 : 1); ++rep) {
        if (MK_DUP == 4) { asm volatile("" : "+v"(F.lane), "+v"(F.tid)); cur_gj = -1; }
        int T = F.vcu, vw = F.vcu; const int sslot = F.vcu % 3;
        for (int step = 0; T < NB * 16 || vw < DEC_B * 2; ++step) {
          const bool do_s = vw < DEC_B * 2 && (step % 3 == sslot || T >= NB * 16);
          if (!do_s) {
            const int b = T >> 4, j = (T >> 2) & 3, ck = T & 3;
#pragma unroll 1
            for (int u = F.wave; u < 48; u += 8) { const int g = u >> 4, k = u & 15;
                const int blk = (g == 0) ? ck * 16 + k : (g == 1) ? (k >> 2) * 16 + 4 * ck + (k & 3) : k * 4 + ck;
                attn_unit(F, ((b * 12 + g * 4 + j) << 6) | blk, wl, cur_gj); }
            asm volatile("s_waitcnt vmcnt(0)" ::: "memory"); __syncthreads();
            int ctid = F.tid; asm volatile("" : "+v"(ctid));
#pragma unroll 1
            for (int h = 0; h < 1; ++h) {
                float l0[8], l1[8], l2[8]; u32x4 wa[8], wb[8], wc[8];
#pragma unroll
                for (int q = 0; q < 8; ++q) { const int idx = ctid + 512 * (8 * h + q); const size_t row = (size_t)b * SEQ + ck * 512 + (idx >> 3); const int c = idx & 7;
                    l0[q] = LSE[row * 12 + j]; l1[q] = LSE[row * 12 + 4 + j]; l2[q] = LSE[row * 12 + 8 + j];
                    const bf16* og = OG + (size_t)j * PLQ + row * 64 + c * 8; wa[q] = *(const u32x4*)og; wb[q] = *(const u32x4*)(og + 4 * PLQ); wc[q] = *(const u32x4*)(og + 8 * PLQ); }
#pragma unroll
                for (int q = 0; q < 8; ++q) { const int idx = ctid + 512 * (8 * h + q); const size_t row = (size_t)b * SEQ + ck * 512 + (idx >> 3); const int c = idx & 7;
                    const float mx = fmaxf(fmaxf(l0[q], l1[q]), l2[q]);
                    const float e0 = __expf(l0[q] - mx), e1 = __expf(l1[q] - mx), e2 = __expf(l2[q] - mx), inv = 1.0f / (e0 + e1 + e2);
                    f32x4 a0, a1, b0, b1, c0, c1; unpack8(wa[q], a0, a1); unpack8(wb[q], b0, b1); unpack8(wc[q], c0, c1);
                    *(u32x4*)(AY + row * 768 + j * 64 + c * 8) = pack8((a0 * e0 + b0 * e1 + c0 * e2) * inv, (a1 * e0 + b1 * e1 + c1 * e2) * inv); }
            }
            __syncthreads();
            T += F.G;
          } else {
            const int bd = vw >> 1, jh = vw & 1;
#pragma unroll 1
            for (int v = F.wave; v < (MK_DUP == 43 ? 48 : 24); v += 8) { const int v24 = v >= 24 ? v - 24 : v, g = v24 >> 3, j = 2 * jh + ((v24 >> 2) & 1), t = v24 & 3; attn_sample_task(F, ((bd * 12 + g * 4 + j) << 2) | t, wl); }
            asm volatile("s_waitcnt vmcnt(0)" ::: "memory"); __syncthreads();
            if (F.tid < 64) { const size_t row = (size_t)MP + bd * 4 + (F.tid >> 4); const int j = 2 * jh + ((F.tid >> 3) & 1), c = F.tid & 7;
                const float l0 = LSE[row * 12 + j], l1 = LSE[row * 12 + 4 + j], l2 = LSE[row * 12 + 8 + j], mx = fmaxf(fmaxf(l0, l1), l2);
                const float e0 = __expf(l0 - mx), e1 = __expf(l1 - mx), e2 = __expf(l2 - mx), inv = 1.0f / (e0 + e1 + e2);
                const bf16* og = OG + (size_t)j * PLQ + row * 64 + c * 8;
                f32x4 a0, a1, b0, b1, c0, c1; unpack8(*(const u32x4*)og, a0, a1); unpack8(*(const u32x4*)(og + 4 * PLQ), b0, b1); unpack8(*(const u32x4*)(og + 8 * PLQ), c0, c1);
                *(u32x4*)(AY + row * 768 + j * 64 + c * 8) = pack8((a0 * e0 + b0 * e1 + c0 * e2) * inv, (a1 * e0 + b1 * e1 + c1 * e2) * inv); }
            __syncthreads();
            vw += F.G;
          }
        }
        for (int su = gw; su < (MP / 128) * 16 * (MK_DUP == 42 ? 2 : 1); su += NGW) sgu_unit(F, su >= (MP / 128) * 16 ? su - (MP / 128) * 16 : su, wl);
        for (int bd = gw; bd < DEC_B; bd += NGW) sgu_sample_task(F, bd);
        if (MK_DUP == 4) { asm volatile("s_waitcnt vmcnt(0)" ::: "memory"); __syncthreads(); }
        }
    }
    SEAM(4);
    if (IN(6)) {
        pg8::Gemm g{WSP(bf16, WS_AY), WSP(bf16, WS_WOAB), M, DM, 768}; pg8::StaticOrder S; S.init(M, DM, F.G, rot_c(96, F.G));
        pg8::EpiGate E{WSP(bf16, WS_SA), WSP(bf16, WS_SB), WSP(bf16, WS_XB)};
        pg8::gemm_phase(F.lds, g, S, E, F.wave);
        if (MK_DUP == 6) pg8::gemm_phase(F.lds, g, S, E, F.wave);
        copy_fill(F, ctl, 6, false);
    }
    SEAM(6);
    if (IN(7)) {
        pg8::Gemm g{WSP(bf16, WS_XB), WSP(bf16, WS_WOUT), M, DM, DM}; pg8::StaticOrder S; S.init(M, DM, F.G, rot_c(88, F.G));
        pg8::EpiDown<1> E{nullptr, nullptr, WSP(bf16, WS_V1), F.in[6], F.in[7], WSP(u64, WS_S1), stab, alt ? WSP(bf16, 1896 * MiB) : WSP(bf16, WS_V2), nullptr, alt ? WSP(u64, WS_S3) : WSP(u64, WS_S2), 1.0f};
        pg8::gemm_phase(F.lds, g, S, E, F.wave);
        if (MK_DUP == 7) pg8::gemm_phase(F.lds, g, S, E, F.wave);
        copy_fill(F, ctl, 7, false);
    }
    SEAM(7);
    if (IN(8)) {
        pg8::Gemm g{WSP(bf16, WS_V2), WSP(bf16, WS_WF2), M, NFF2, DM}; pg8::StaticOrder S; S.init(M, NFF2, F.G, rot_c(160, F.G));
        pg8::EpiSwiglu<true> E{WSP(bf16, WS_ACT), sm + SM_CS2, sm + SM_B2, WSP(u64, WS_S2), stab};
        pg8::gemm_phase(F.lds, g, S, E, F.wave);
        if (MK_DUP == 8) pg8::gemm_phase(F.lds, g, S, E, F.wave);
    }
    SEAM(8);
    if (IN(9)) {
        pg8::Gemm g{WSP(bf16, WS_ACT), WSP(bf16, WS_WF2D), M, DM, DFF}; pg8::PanelOrder S; S.init(M, F.G, rot_c(104, F.G));
        pg8::EpiDown<3> E{nullptr, nullptr, WSP(bf16, WS_V2), F.in[20], F.in[21], WSP(u64, WS_S2), stab, nullptr, F.out + O_Y, WSP(u64, WS_S3), 0.5f,
                          F.in[25], F.in[26], ctl + CW_PCNT, (LAS f32x2*)(F.lds + MISC_OFF + 4096)};
        pg8::gemm_phase(F.lds, g, S, E, F.wave);
        F.lane = lane_now(); F.tid = F.wave * 64 + F.lane;
        copy_fill(F, ctl, 9, false);
        copy_fill(F, ctl, 10, true);
    }
#ifdef MK_STAMP_A
    STAMP(11);
    __syncthreads();
    if (blockIdx.x == 0) {
        asm volatile("s_waitcnt vmcnt(0)" ::: "memory");
        const float da = (float)(tsw[MK_STAMP_A + 1] - tsw[MK_STAMP_A]) * 0.01f, db = (float)(tsw[MK_STAMP_B + 1] - tsw[MK_STAMP_B]) * 0.01f;
        if (F.tid == 0) F.out[O_W0P] += da;
        for (int i = F.tid; i < DEC_B * DEC_T * SGUW; i += 512) F.out[O_SV + i] += db * 0.01f;
    }
#endif
#ifdef MK_PROBE
    if (IN(10) && MK_PROBE == 1 && F.vcu == 0) {
        __builtin_amdgcn_fence(__ATOMIC_ACQUIRE, "agent");
        float dmax = 0.f; for (int st = 0; st < 8; ++st) dmax = fmaxf(dmax, __uint_as_float(__hip_atomic_load(ctl + 64 + st, __ATOMIC_RELAXED, __HIP_MEMORY_SCOPE_AGENT)));
        for (int i = F.tid; i < DEC_B * DEC_T * SGUW; i += 512) F.out[O_SV + i] += 100.0f * dmax;
    }
    if (IN(10) && gt == 0) {
        __builtin_amdgcn_fence(__ATOMIC_ACQUIRE, "agent");
        float val = 0.f; float scale = 100.f;
        for (int st = 8; st < 15; ++st) { const float d = __uint_as_float(__hip_atomic_load(ctl + 64 + st, __ATOMIC_RELAXED, __HIP_MEMORY_SCOPE_AGENT));
            if (val == 0.f && d > MK_PROBE_TOL) { int ex; (void)frexpf(d, &ex); val = scale * (float)(ex + 40); } scale *= 10.f; }
        if (MK_PROBE == 2) { val = 0.f; scale = 100.f;
            for (int k = 0; k < 3; ++k) { const unsigned c = __hip_atomic_load(ctl + 80 + k, __ATOMIC_RELAXED, __HIP_MEMORY_SCOPE_AGENT);
                if (val == 0.f && c > 0u) { int ex; (void)frexpf((float)c, &ex); val = scale * (float)(ex + 40); } scale *= 10.f; } }
        if (MK_PROBE == 1) { val = 1.0e4f * (float)(100u + __hip_atomic_load(ctl + 96, __ATOMIC_RELAXED, __HIP_MEMORY_SCOPE_AGENT)); }
        if (MK_PROBE == 11) { val = 1000.0f * (float)__hip_atomic_load(ctl + 96, __ATOMIC_RELAXED, __HIP_MEMORY_SCOPE_AGENT) + 1.0e6f * (float)__hip_atomic_load(ctl + 97, __ATOMIC_RELAXED, __HIP_MEMORY_SCOPE_AGENT); }
        if (MK_PROBE == 3) { F.out[O_SV] += 1.0e6f; val = 0.f; }
        if (MK_PROBE == 4) { F.out[O_Y] += 1.0e6f; val = 0.f; }
        if (MK_PROBE == 5) { F.out[O_Y + (size_t)MP * DM] += 1.0e6f; val = 0.f; }
        F.out[O_W0P] += val;
    }
#endif
#undef IN
#undef SEAM
}

extern "C" void kernel_launch(void* const* d_in, const int* in_sizes, int n_in, void* d_out, int out_size, void* d_ws, size_t ws_size, hipStream_t stream) {
    static int grid = 0;
    if (grid == 0) {
        if (n_in != 27 || (size_t)out_size != O_END || ws_size < WS_END) { fprintf(stderr, "kernel_launch: unexpected shapes: n_in %d out %d ws %zu (need %zu)\n", n_in, out_size, ws_size, (size_t)WS_END); grid = -1; return; }
        int dev = 0, cus = 0, per_cu = 0;
        if (hipGetDevice(&dev) != hipSuccess || hipDeviceGetAttribute(&cus, hipDeviceAttributeMultiprocessorCount, dev) != hipSuccess) { grid = -1; return; }
        if (hipFuncSetAttribute((const void*)mk_fwd, hipFuncAttributeMaxDynamicSharedMemorySize, LDS_BYTES) != hipSuccess) { fprintf(stderr, "kernel_launch: hipFuncSetAttribute failed\n"); grid = -1; return; }
        if (hipOccupancyMaxActiveBlocksPerMultiprocessor(&per_cu, (const void*)mk_fwd, 512, LDS_BYTES) != hipSuccess || per_cu < 1) { fprintf(stderr, "kernel_launch: occupancy query says %d\n", per_cu); }
        (void)hipGetLastError();
        grid = cus;
    }
    if (grid < 0) return;
    (void)hipMemsetAsync((char*)d_ws + WS_CTL, 0, 65536, stream);
    Args a{};
    for (int i = 0; i < 27; ++i) a.in[i] = (const float*)d_in[i];
    a.out = (float*)d_out; a.ws = (unsigned char*)d_ws;
    const int nph = MK_PH_MAX < N_PHASES ? MK_PH_MAX : N_PHASES;
    if (MK_N_LAUNCHES == 1) {
        a.ph_lo = 0; a.ph_hi = nph; a.li = 0;
        hipLaunchKernelGGL(mk_fwd, dim3(grid), dim3(512), LDS_BYTES, stream, a);
    } else {
        for (int p = 0; p < nph; ++p) { a.ph_lo = p; a.ph_hi = p + 1; a.li = p; hipLaunchKernelGGL(mk_fwd, dim3(grid), dim3(512), LDS_BYTES, stream, a);
#ifdef MK_PROBE
            const int stage_after[11] = {-1, -1, 0, 1, -1, 2, 3, 4, 5, 6, -1};
            if (MK_PROBE == 1 && stage_after[p] >= 0) { a.ph_lo = 100 + stage_after[p]; a.ph_hi = a.ph_lo + 1; hipLaunchKernelGGL(mk_fwd, dim3(grid), dim3(512), LDS_BYTES, stream, a); }
            if (MK_PROBE == 2 && (p == 1 || p == 2 || p == 7)) { const int k = p == 1 ? 0 : p == 2 ? 1 : 2;
                a.ph_lo = p; a.ph_hi = p + 1; a.li = 99; hipLaunchKernelGGL(mk_fwd, dim3(grid), dim3(512), LDS_BYTES, stream, a);
                a.li = 200 + k; hipLaunchKernelGGL(mk_fwd, dim3(grid), dim3(512), LDS_BYTES, stream, a); }
#endif
        }
    }
}
```

```cpp
#include <hip/hip_runtime.h>
#include <cstdio>
#include <cstdint>
#define MK_PROBE_TOL 0.02f
#define MK_PROBE_WS (2025ull << 20)

#ifndef MK_N_LAUNCHES
#define MK_N_LAUNCHES 1
#endif
#ifndef MK_DUP
#define MK_DUP -1
#endif
#ifndef MK_PH_MAX
#define MK_PH_MAX 11
#endif

#define GAS __attribute__((address_space(1)))
#define LAS __attribute__((address_space(3)))
typedef unsigned short bf16;
typedef unsigned long long u64;
typedef float f32x2 __attribute__((ext_vector_type(2)));
typedef float f32x4 __attribute__((ext_vector_type(4)));
typedef float f32x16 __attribute__((ext_vector_type(16)));
typedef short bf16x8 __attribute__((ext_vector_type(8)));
typedef short s16x4 __attribute__((ext_vector_type(4)));
typedef unsigned u32x2 __attribute__((ext_vector_type(2)));
typedef unsigned u32x4 __attribute__((ext_vector_type(4)));

constexpr int DM = 1024, SEQ = 2048, NB = 32, MP = NB * SEQ, DEC_B = 128, DEC_T = 4, MS = DEC_B * DEC_T, M = MP + MS;
constexpr size_t PLQ = (size_t)(MP + MS) * 64, PLU = (size_t)(MP + MS) * 32 + 2176;
constexpr int DFF = 2816, NFF2 = 2 * DFF, INW = 5376, QKVW = 768, SGUW = 512;
constexpr float LN_EPS = 1e-5f;
constexpr float ALPHA = 1.189207115002721f;
constexpr float LOG2E = 1.4426950408889634f, LN2F = 0.6931471805599453f;
constexpr float QSCALE = 0.125f * LOG2E;
constexpr float NEGBIG = -1e30f;

constexpr size_t O_Y = 0, O_W0P = 67633152ull, O_W1P = 69730304ull, O_W2P = 78118912ull, O_W0S = 111673344ull, O_W1S = 120061952ull, O_W2S = 153616384ull, O_SV = 287834112ull, O_END = 288096256ull;

constexpr size_t MiB = 1u << 20;
constexpr size_t WS_CTL = 0, CTL_ZERO_BYTES = 1 * MiB;
constexpr size_t WS_SMALL = 1 * MiB;
constexpr size_t WS_WF1 = 2 * MiB, WS_WF1D = 13 * MiB, WS_WIN = 19 * MiB, WS_WOAB = 30 * MiB, WS_WOUT = 32 * MiB, WS_WF2 = 34 * MiB, WS_WF2D = 45 * MiB, WS_WSB = 51 * MiB;
constexpr size_t WS_S1 = 52 * MiB, WS_S2 = 61 * MiB, WS_S3 = 70 * MiB, WS_SGV = 79 * MiB, WS_LSE = 84 * MiB;
constexpr size_t WS_XB = 88 * MiB;
constexpr size_t WS_V1 = 217 * MiB, WS_V2 = 346 * MiB, WS_U = 475 * MiB, WS_GV = 540 * MiB, WS_SA = 605 * MiB, WS_SB = 734 * MiB, WS_OG = 863 * MiB, WS_AY = 960 * MiB;
constexpr size_t WS_ACT = 1057 * MiB;
constexpr size_t WS_Q = WS_ACT, WS_K = WS_ACT + 97 * MiB, WS_V = WS_ACT + 194 * MiB;
constexpr size_t WS_END = 1412 * MiB;
static_assert(12 * PLQ * 2 <= 97 * MiB && 16 * PLU * 2 <= 65 * MiB, "plane map");
static_assert((size_t)M * DFF * 2 <= 355 * MiB && (size_t)M * QKVW * 2 <= 97 * MiB && (size_t)M * DM * 2 <= 129 * MiB, "ws map");
constexpr int SM_CS1 = 0, SM_B1 = 8192, SM_CS2 = 16384, SM_B2 = 24576, SM_BT = 32768, SM_PART = 65536;

constexpr int CW_BAR = 4096;

constexpr int RING_BYTES = 131072, STAB_OFF = RING_BYTES  , MISC_OFF = STAB_OFF + 4096, LDS_BYTES = 147456;

__device__ const unsigned char T5BUCKET[3][129] = {
{0,1,2,3,4,5,6,7,8,9,10,11,12,13,14,15,16,16,16,16,16,16,17,17,17,17,17,17,17,17,18,18,18,18,18,18,18,18,18,18,19,19,19,19,19,19,19,19,19,19,19,19,19,19,20,20,20,20,20,20,20,20,20,20,20,20,20,20,20,20,20,20,20,21,21,21,21,21,21,21,21,21,21,21,21,21,21,21,21,21,21,21,21,21,21,21,21,21,21,22,22,22,22,22,22,22,22,22,22,22,22,22,22,22,22,22,22,22,22,22,22,22,22,22,22,22,22,22,22},
{0,4,8,12,16,16,17,17,18,18,19,19,19,19,20,20,20,20,20,21,21,21,21,21,21,22,22,22,22,22,22,22,22,22,23,23,23,23,23,23,23,23,23,23,23,23,24,24,24,24,24,24,24,24,24,24,24,24,24,24,24,24,25,25,25,25,25,25,25,25,25,25,25,25,25,25,25,25,25,25,25,25,25,26,26,26,26,26,26,26,26,26,26,26,26,26,26,26,26,26,26,26,26,26,26,26,26,26,26,26,26,26,26,27,27,27,27,27,27,27,27,27,27,27,27,27,27,27,27},
{0,16,18,19,20,21,21,22,22,23,23,23,24,24,24,24,25,25,25,25,25,26,26,26,26,26,26,26,26,27,27,27,27,27,27,27,27,27,27,28,28,28,28,28,28,28,28,28,28,28,28,28,29,29,29,29,29,29,29,29,29,29,29,29,29,29,29,29,29,29,30,30,30,30,30,30,30,30,30,30,30,30,30,30,30,30,30,30,30,30,30,30,30,30,30,31,31,31,31,31,31,31,31,31,31,31,31,31,31,31,31,31,31,31,31,31,31,31,31,31,31,31,31,31,31,31,31,31,31}};

__device__ __forceinline__ unsigned f2bf(float f) { unsigned u = __builtin_bit_cast(unsigned, f); return (u + 0x7fffu + ((u >> 16) & 1u)) >> 16; }
__device__ __forceinline__ unsigned pk2(float lo, float hi) { return f2bf(lo) | (f2bf(hi) << 16); }
__device__ __forceinline__ float bfround(float f) { return __uint_as_float(f2bf(f) << 16); }
typedef __bf16 bf16x2_t __attribute__((ext_vector_type(2)));
__device__ __forceinline__ unsigned cvt_pk_bf16(float lo, float hi) { const f32x2 v = {lo, hi}; const bf16x2_t b = __builtin_convertvector(v, bf16x2_t); return __builtin_bit_cast(unsigned, b); }
__device__ __forceinline__ float bflo(unsigned u) { return __uint_as_float(u << 16); }
__device__ __forceinline__ float bfhi(unsigned u) { return __uint_as_float(u & 0xffff0000u); }
__device__ __forceinline__ u32x4 pack8(f32x4 a, f32x4 b) { u32x4 w; w.x = cvt_pk_bf16(a[0], a[1]); w.y = cvt_pk_bf16(a[2], a[3]); w.z = cvt_pk_bf16(b[0], b[1]); w.w = cvt_pk_bf16(b[2], b[3]); return w; }
__device__ __forceinline__ int lane_now() { int l; asm volatile("v_mbcnt_lo_u32_b32 %0, -1, 0\n\tv_mbcnt_hi_u32_b32 %0, -1, %0" : "=v"(l)); return l & 63; }
__device__ __forceinline__ void unpack8(u32x4 w, f32x4& a, f32x4& b) { a = (f32x4){bflo(w.x), bfhi(w.x), bflo(w.y), bfhi(w.y)}; b = (f32x4){bflo(w.z), bfhi(w.z), bflo(w.w), bfhi(w.w)}; }
__device__ __forceinline__ float fast_exp2(float x) { return __builtin_amdgcn_exp2f(x); }
__device__ __forceinline__ float fast_rcp(float x) { return __builtin_amdgcn_rcpf(x); }
__device__ __forceinline__ float sigmoidf_(float x) { return fast_rcp(1.0f + fast_exp2(-x * LOG2E)); }
__device__ __forceinline__ f32x4 sigmoid4(f32x4 v) { return (f32x4){sigmoidf_(v[0]), sigmoidf_(v[1]), sigmoidf_(v[2]), sigmoidf_(v[3])}; }
__device__ __forceinline__ float gelu1(float v) {
    const float av = __builtin_fabsf(v), t = fast_rcp(av * 0.2316418882f + 1.0f);
    float q = t * 0.5307027145f + (-0.7265760135f); q = q * t + 0.7107068705f; q = q * t + (-0.142248368f); q = q * t + 0.127414796f; q = q * t;
    const float e = fast_exp2((v * v) * (-0.72134752044f));
    const float m = v * (q * e);
    return v < 0.f ? m : v - m;
}
__device__ __forceinline__ f32x4 gelu4(f32x4 v) {
    const f32x4 av = __builtin_elementwise_abs(v), dd = av * 0.2316418882f + 1.0f;
    const f32x4 t = {fast_rcp(dd[0]), fast_rcp(dd[1]), fast_rcp(dd[2]), fast_rcp(dd[3])};
    f32x4 q = t * 0.5307027145f + (-0.7265760135f); q = q * t + 0.7107068705f; q = q * t + (-0.142248368f); q = q * t + 0.127414796f; q = q * t;
    const f32x4 s2 = (v * v) * (-0.72134752044f);
    const f32x4 e = {fast_exp2(s2[0]), fast_exp2(s2[1]), fast_exp2(s2[2]), fast_exp2(s2[3])};
    const f32x4 m = v * (q * e), r = v - m;
    return (f32x4){v[0] < 0.f ? m[0] : r[0], v[1] < 0.f ? m[1] : r[1], v[2] < 0.f ? m[2] : r[2], v[3] < 0.f ? m[3] : r[3]};
}
__device__ __forceinline__ float wave_sum(float v) {
#pragma unroll
    for (int o = 1; o < 64; o <<= 1) v += __shfl_xor(v, o);
    return v;
}
__device__ __forceinline__ float wave_max(float v) {
#pragma unroll
    for (int o = 1; o < 64; o <<= 1) v = fmaxf(v, __shfl_xor(v, o));
    return v;
}

namespace pg8 {
constexpr int BM = 256, BK = 64, HALF = 128, HTB = HALF * BK * 2, STAGE_BYTES = 8 * HTB, NXCD = 8, WGM = 8;
__host__ __device__ __forceinline__ int lds_byte(int r, int c) { const int st = (r >> 4) * 2 + (c >> 5), rr = r & 15, cc = c & 31, ob = rr * 64 + cc * 2; return st * 1024 + (ob ^ (((ob >> 9) & 1) << 5)); }
__host__ __device__ __forceinline__ void stage_rc(int b, int& R, int& C) { const int st = b / 1024, sb = b % 1024, swz = sb ^ (((sb >> 9) & 1) << 5); R = (st >> 1) * 16 + swz / 64; C = (st & 1) * 32 + (swz % 64) / 2; }
__host__ __device__ __forceinline__ int perm32(int rho) { const int n = rho >> 4, i = rho & 15; return 8 * (i >> 2) + 4 * n + (i & 3); }

struct Unit { int pm, pn; };
struct Gemm { const bf16* A; const bf16* Bt; int M, N, K; };

struct StaticOrder {
    int nM, nN, nwg, G, c;
    __device__ void init(int M_, int N_, int G_, int c_) { nM = M_ / BM; nN = N_ / BM; nwg = nM * nN; G = G_; c = c_; }
    __device__ bool next(int i, Unit& u) const {
        const long L = (long)i * G + c; if (L >= nwg) return false;
        int wgid = (int)L; { const int q = nwg / NXCD, r = nwg % NXCD, xcd = wgid % NXCD, off = wgid / NXCD; wgid = (xcd < r ? xcd * (q + 1) : r * (q + 1) + (xcd - r) * q) + off; }
        const int nig = WGM * nN, gid = wgid / nig, fm = gid * WGM, gsz = (nM - fm) < WGM ? (nM - fm) : WGM;
        u.pm = fm + ((wgid % nig) % gsz); u.pn = (wgid % nig) / gsz; return true;
    }
};

struct PanelOrder {
    int nM, G, slot, tile;
    __device__ void init(int M_, int G_, int c_) { nM = M_ / BM; G = G_;
        if (G % 32 == 0) { const int R = G / 8, x = c_ & 7, k = c_ >> 3; slot = x * (R / 4) + (k >> 2); tile = k & 3; } else { slot = c_ >> 2; tile = c_ & 3; if (c_ >= (G / 4) * 4) slot = 1 << 20; } }
    __device__ bool next(int i, Unit& u) const { const int pm = i * (G / 4) + slot; if (pm >= nM) return false; u.pm = pm; u.pn = tile; return true; }
};

template <class Order, class Epi>
__device__ __forceinline__ void gemm_phase(LAS unsigned char* lds, const Gemm g, const Order& S, const Epi& E, const int wid) {
    const int lane = lane_now(), tid = wid * 64 + lane, wr = wid >> 2, wc = wid & 3, fr = lane & 15, fq = lane >> 4;
    const int K = g.K, nt = K / BK;
    unsigned voffA[2], voffB[2];
#pragma unroll
    for (int i = 0; i < 2; ++i) { int R, C; stage_rc(tid * 16 + i * 8192, R, C); const int Rb = (R & ~31) + perm32(R & 31);
        voffA[i] = (unsigned)(R * K + C) * 2u; voffB[i] = (unsigned)(Rb * K + C) * 2u; }
    const size_t kstep = (size_t)(BK * 2);
    const size_t hstep = (size_t)HALF * K * 2;
    const size_t tstep = 2 * hstep;
    const unsigned ldsw = (unsigned)wid * 1024u;
    const int aoff = lds_byte(wr * 64 + fr, fq * 8), boff = lds_byte(wc * 32 + fr, fq * 8);
#define PG8_SA(b, h) (((b) * 2 + (h)) * HTB)
#define PG8_SB(b, h) ((4 + (b) * 2 + (h)) * HTB)
#define PG8_STAGE(bufoff, gbase, voff) do { _Pragma("unroll") for (int _i = 0; _i < 2; ++_i) \
        __builtin_amdgcn_global_load_lds((const unsigned*)((const char*)(gbase) + (voff)[_i]), (LAS unsigned*)(lds + (bufoff) + ldsw + _i * 8192), 16, 0, 0); } while (0)
#define PG8_LDA(dst, b, h) do { _Pragma("unroll") for (int m = 0; m < 4; ++m) _Pragma("unroll") for (int k = 0; k < 2; ++k) dst[m][k] = *(const LAS bf16x8*)(lds + PG8_SA(b, h) + aoff + m * 2048 + k * 1024); } while (0)
#define PG8_LDB(dst, b, h) do { _Pragma("unroll") for (int n = 0; n < 2; ++n) _Pragma("unroll") for (int k = 0; k < 2; ++k) dst[n][k] = *(const LAS bf16x8*)(lds + PG8_SB(b, h) + boff + n * 2048 + k * 1024); } while (0)
#define PG8_MMA(ai, bj, At, Bt) do { __builtin_amdgcn_s_setprio(1); _Pragma("unroll") for (int m = 0; m < 4; ++m) _Pragma("unroll") for (int n = 0; n < 2; ++n) _Pragma("unroll") for (int k = 0; k < 2; ++k) \
        acc[ai][bj][m][n] = __builtin_amdgcn_mfma_f32_16x16x32_bf16(Bt[n][k], At[m][k], acc[ai][bj][m][n], 0, 0, 0); __builtin_amdgcn_s_setprio(0); } while (0)
#define PG8_WAIT_V(n) asm volatile("s_waitcnt vmcnt(" #n ")" ::: "memory")
#define PG8_WAIT_L(n) asm volatile("s_waitcnt lgkmcnt(" #n ")" ::: "memory")
#define PG8_BAR __builtin_amdgcn_s_barrier()
#define PG8_SCHED __builtin_amdgcn_sched_barrier(0)
    Unit cur, nxt; int ui = 0;
    if (!S.next(0, cur)) return;
    f32x4 acc[2][2][4][2];
#pragma unroll
    for (int a = 0; a < 2; ++a)
#pragma unroll
        for (int b = 0; b < 2; ++b)
#pragma unroll
            for (int m = 0; m < 4; ++m)
#pragma unroll
                for (int n = 0; n < 2; ++n) acc[a][b][m][n] = (f32x4){0.f, 0.f, 0.f, 0.f};
    bf16x8 At[4][2], B0[2][2], B1[2][2];
    const char* cA = (const char*)g.A + (size_t)cur.pm * tstep; const char* cB = (const char*)g.Bt + (size_t)cur.pn * tstep;
    int tpar = 0, tpm = cur.pm;
    if constexpr (Epi::HAS_PREP) E.prep(cur, 0, tid);
    PG8_STAGE(PG8_SB(0, 0), cB, voffB); PG8_STAGE(PG8_SB(0, 1), cB + hstep, voffB); PG8_STAGE(PG8_SA(0, 0), cA, voffA); PG8_STAGE(PG8_SA(0, 1), cA + hstep, voffA);
    if (wr == 1) PG8_BAR;
    PG8_WAIT_V(2); PG8_BAR;
    PG8_STAGE(PG8_SB(1, 0), cB + kstep, voffB); PG8_STAGE(PG8_SA(1, 0), cA + kstep, voffA); PG8_STAGE(PG8_SB(1, 1), cB + hstep + kstep, voffB);
    PG8_WAIT_V(6); PG8_BAR;
    for (;;) {
        const bool has_next = S.next(ui + 1, nxt);
        const char* nA = has_next ? (const char*)g.A + (size_t)nxt.pm * tstep : cA; const char* nB = has_next ? (const char*)g.Bt + (size_t)nxt.pn * tstep : cB;
        for (int t = 0; t < nt; t += 2) {
            const bool last = (t == nt - 2);
            const char* a1 = cA + (size_t)(t + 1) * kstep;
            const char* a2 = last ? nA : cA + (size_t)(t + 2) * kstep; const char* b2 = last ? nB : cB + (size_t)(t + 2) * kstep;
            const char* a3 = a2 + kstep; const char* b3 = b2 + kstep;
            if constexpr (Epi::MID_T >= 0) { if (t == Epi::MID_T) E.mid(acc, cur, wr, wc, fr, fq); }
            PG8_LDB(B0, 0, 0); PG8_LDB(B1, 0, 1); PG8_SCHED; PG8_LDA(At, 0, 0); PG8_STAGE(PG8_SA(1, 1), a1 + hstep, voffA);
            PG8_WAIT_V(8); PG8_WAIT_L(0); PG8_BAR; PG8_MMA(0, 0, At, B0); PG8_MMA(0, 1, At, B1); PG8_BAR; PG8_SCHED;
            PG8_LDA(At, 0, 1); PG8_STAGE(PG8_SB(0, 0), b2, voffB); PG8_STAGE(PG8_SB(0, 1), b2 + hstep, voffB); PG8_STAGE(PG8_SA(0, 0), a2, voffA);
            PG8_WAIT_V(8); PG8_WAIT_L(0); PG8_BAR; PG8_MMA(1, 0, At, B0); PG8_MMA(1, 1, At, B1); PG8_BAR; PG8_SCHED;
            PG8_LDB(B0, 1, 0); PG8_LDB(B1, 1, 1); PG8_SCHED; PG8_LDA(At, 1, 0); PG8_STAGE(PG8_SA(0, 1), a2 + hstep, voffA);
            PG8_WAIT_V(8); PG8_WAIT_L(0); PG8_BAR; PG8_MMA(0, 0, At, B0); PG8_MMA(0, 1, At, B1); PG8_BAR; PG8_SCHED;
            PG8_LDA(At, 1, 1); PG8_STAGE(PG8_SB(1, 0), b3, voffB); PG8_STAGE(PG8_SB(1, 1), b3 + hstep, voffB); PG8_STAGE(PG8_SA(1, 0), a3, voffA);
            PG8_WAIT_V(8); PG8_WAIT_L(0); PG8_BAR; PG8_MMA(1, 0, At, B0); PG8_MMA(1, 1, At, B1); PG8_BAR; PG8_SCHED;
        }
        if (wr == 0) PG8_BAR;
        E(acc, cur, wr, wc, fr, fq, tpar);
        if (!has_next) break;
#pragma unroll
        for (int a = 0; a < 2; ++a)
#pragma unroll
            for (int b = 0; b < 2; ++b)
#pragma unroll
                for (int m = 0; m < 4; ++m)
#pragma unroll
                    for (int n = 0; n < 2; ++n) acc[a][b][m][n] = (f32x4){0.f, 0.f, 0.f, 0.f};
        if constexpr (Epi::HAS_PREP) { if (nxt.pm != tpm) { tpar ^= 1; tpm = nxt.pm; E.prep(nxt, tpar, tid); } }
        cur = nxt; cA = nA; cB = nB; ++ui;
        if (wr == 1) PG8_BAR;
    }
    PG8_WAIT_V(0);
    PG8_BAR;
#undef PG8_SA
#undef PG8_SB
#undef PG8_STAGE
#undef PG8_LDA
#undef PG8_LDB
#undef PG8_MMA
#undef PG8_WAIT_V
#undef PG8_WAIT_L
#undef PG8_BAR
#undef PG8_SCHED
}

template <bool WT = false>
__device__ __forceinline__ void wave_row_stats(const f32x4 (&v)[2][2][4][2], u64* slots, int ns, int sidx, int row0, int fq) {
#pragma unroll
    for (int ai = 0; ai < 2; ++ai)
#pragma unroll
        for (int m = 0; m < 4; ++m) {
            float s = 0.f;
#pragma unroll
            for (int bj = 0; bj < 2; ++bj)
#pragma unroll
                for (int n = 0; n < 2; ++n) { const f32x4 x = v[ai][bj][m][n]; s += (x[0] + x[1]) + (x[2] + x[3]); }
            s += __shfl_xor(s, 16); s += __shfl_xor(s, 32);
            const float mw = s * (1.0f / 64.0f); float q = 0.f;
#pragma unroll
            for (int bj = 0; bj < 2; ++bj)
#pragma unroll
                for (int n = 0; n < 2; ++n) { const f32x4 d = v[ai][bj][m][n] - mw; q += (d[0] * d[0] + d[1] * d[1]) + (d[2] * d[2] + d[3] * d[3]); }
            q += __shfl_xor(q, 16); q += __shfl_xor(q, 32);
            if (fq == 0) { u64* sp = slots + (size_t)(row0 + ai * HALF + m * 16) * ns + sidx; const u64 val = ((u64)__float_as_uint(q) << 32) | (u64)__float_as_uint(mw);
                if constexpr (WT) __hip_atomic_store(sp, val, __ATOMIC_RELAXED, __HIP_MEMORY_SCOPE_AGENT); else *sp = val; }
        }
}
__device__ __forceinline__ void stats_table16(const u64* slots, int pm, LAS f32x2* tab, int tid) {
    asm volatile("" : "+v"(tid));
    const int row = tid >> 1, half = tid & 1;
    const u32x4* p = (const u32x4*)(slots + (size_t)(pm * 256 + row) * 16 + half * 8);
    const u32x4 a = p[0], b = p[1], c = p[2], d = p[3];
    const float mn[8] = {__uint_as_float(a.x), __uint_as_float(a.z), __uint_as_float(b.x), __uint_as_float(b.z), __uint_as_float(c.x), __uint_as_float(c.z), __uint_as_float(d.x), __uint_as_float(d.z)};
    const float m2[8] = {__uint_as_float(a.y), __uint_as_float(a.w), __uint_as_float(b.y), __uint_as_float(b.w), __uint_as_float(c.y), __uint_as_float(c.w), __uint_as_float(d.y), __uint_as_float(d.w)};
    float sm = 0.f;
#pragma unroll
    for (int i = 0; i < 8; ++i) sm += mn[i];
    sm += __shfl_xor(sm, 1);
    const float mt = sm * (1.0f / 16.0f);
    float q = 0.f;
#pragma unroll
    for (int i = 0; i < 8; ++i) { const float dd = mn[i] - mt; q += m2[i] + 64.0f * dd * dd; }
    q += __shfl_xor(q, 1);
    if (half == 0) tab[row] = (f32x2){mt, 1.0f / sqrtf(q * (1.0f / 1024.0f) + LN_EPS)};
}

__device__ __forceinline__ void stats_table16_coh(u64* slots, int pm, LAS f32x2* tab, int tid) {
    asm volatile("" : "+v"(tid));
    const int row = tid >> 1, half = tid & 1;
    u64* p = slots + (size_t)(pm * 256 + row) * 16 + half * 8;
    u64 w[8];
#pragma unroll
    for (int i = 0; i < 8; ++i) w[i] = __hip_atomic_load(p + i, __ATOMIC_RELAXED, __HIP_MEMORY_SCOPE_AGENT);
    float sm = 0.f;
#pragma unroll
    for (int i = 0; i < 8; ++i) sm += __uint_as_float((unsigned)w[i]);
    sm += __shfl_xor(sm, 1);
    const float mt = sm * (1.0f / 16.0f);
    float q = 0.f;
#pragma unroll
    for (int i = 0; i < 8; ++i) { const float dd = __uint_as_float((unsigned)w[i]) - mt; q += __uint_as_float((unsigned)(w[i] >> 32)) + 64.0f * dd * dd; }
    q += __shfl_xor(q, 1);
    if (half == 0) tab[row] = (f32x2){mt, 1.0f / sqrtf(q * (1.0f / 1024.0f) + LN_EPS)};
}

template <bool LN> struct EpiSwiglu {
    static constexpr bool HAS_PREP = LN; static constexpr int MID_T = -1;
    bf16* O; const float* cs; const float* bias; const u64* slots; LAS f32x2* stab;
    __device__ __forceinline__ void prep(const Unit& u, int par, int tid) const { stats_table16(slots, u.pm, stab + par * 256, tid); }
    __device__ __forceinline__ void mid(f32x4 (&)[2][2][4][2], const Unit&, int, int, int, int) const {}
    __device__ __forceinline__ void operator()(f32x4 (&acc)[2][2][4][2], const Unit& u, int wr, int wc, int fr, int fq, int par) const {
        asm volatile("" : "+v"(fr), "+v"(fq));
        const int ocol = u.pn * 128 + wc * 32 + 8 * fq, brow = u.pn * 256 + wc * 32 + 8 * fq;
        f32x4 csA[2], csB[2], biA[2], biB[2];
        if constexpr (LN) {
#pragma unroll
            for (int n = 0; n < 2; ++n) { csA[n] = *(const f32x4*)(cs + brow + 4 * n); csB[n] = *(const f32x4*)(cs + brow + 128 + 4 * n); biA[n] = *(const f32x4*)(bias + brow + 4 * n); biB[n] = *(const f32x4*)(bias + brow + 128 + 4 * n); }
        }
#pragma unroll
        for (int ai = 0; ai < 2; ++ai)
#pragma unroll
            for (int m = 0; m < 4; ++m) {
                const int r = ai * HALF + wr * 64 + m * 16 + fr;
                f32x4 o[2];
                f32x2 st; if constexpr (LN) st = stab[par * 256 + r];
#pragma unroll
                for (int n = 0; n < 2; ++n) {
                    f32x4 a = acc[ai][0][m][n], b = acc[ai][1][m][n];
                    if constexpr (LN) { a = (a - st.x * csA[n]) * st.y + biA[n]; b = (b - st.x * csB[n]) * st.y + biB[n]; }
                    o[n] = a * b * sigmoid4(a);
                }
                *(u32x4*)(O + (size_t)(u.pm * BM + r) * DFF + ocol) = pack8(o[0], o[1]);
            }
    }
};

template <int MODE> struct EpiDown {
    static constexpr bool HAS_PREP = (MODE != 0); static constexpr int MID_T = -1;
    const float* xp; const float* xs; const bf16* Vp; const float* g; const float* b; const u64* slots_in; LAS f32x2* stab;
    bf16* Ob; float* Of; u64* slots_out; float cacc;
    const float* g3; const float* b3; unsigned* pcnt; LAS f32x2* tab3;
    __device__ __forceinline__ void prep(const Unit& u, int par, int tid) const { stats_table16(slots_in, u.pm, stab + par * 256, tid); }
    __device__ __forceinline__ void mid(f32x4 (&)[2][2][4][2], const Unit&, int, int, int, int) const {}
    __device__ __forceinline__ void operator()(f32x4 (&acc)[2][2][4][2], const Unit& u, int wr, int wc, int fr, int fq, int par) const {
        asm volatile("" : "+v"(fr), "+v"(fq));
        u32x4 w[2][2][4];
        if constexpr (MODE == 99) {
#pragma unroll
            for (int bj = 0; bj < 2; ++bj)
#pragma unroll
                for (int ai = 0; ai < 2; ++ai)
#pragma unroll
                    for (int m = 0; m < 4; ++m) w[bj][ai][m] = *(const u32x4*)(Vp + (size_t)(u.pm * BM + ai * HALF + wr * 64 + m * 16 + fr) * DM + u.pn * BM + bj * HALF + wc * 32 + 8 * fq);
        }
#pragma unroll
        for (int bj = 0; bj < 2; ++bj) {
            const int col = u.pn * BM + bj * HALF + wc * 32 + 8 * fq;
            f32x4 g0, g1, b0, b1;
            if constexpr (MODE != 0) { g0 = *(const f32x4*)(g + col); g1 = *(const f32x4*)(g + col + 4); b0 = *(const f32x4*)(b + col); b1 = *(const f32x4*)(b + col + 4); }
#pragma unroll
            for (int ai = 0; ai < 2; ++ai)
#pragma unroll
                for (int m = 0; m < 4; ++m) w[bj][ai][m] = *(const u32x4*)(Vp + (size_t)(u.pm * BM + ai * HALF + wr * 64 + m * 16 + fr) * DM + col);
#pragma unroll
            for (int ai = 0; ai < 2; ++ai)
#pragma unroll
                for (int m = 0; m < 4; ++m) {
                    const int r = ai * HALF + wr * 64 + m * 16 + fr;
                    f32x4 r0, r1; unpack8(w[bj][ai][m], r0, r1);
                    if constexpr (MODE != 0) { const f32x2 st = stab[par * 256 + r]; r0 = (r0 - st.x) * st.y * g0 + b0; r1 = (r1 - st.x) * st.y * g1 + b1; }
                    acc[ai][bj][m][0] = ALPHA * r0 + cacc * acc[ai][bj][m][0]; acc[ai][bj][m][1] = ALPHA * r1 + cacc * acc[ai][bj][m][1];
                    asm volatile("" : "+v"(acc[ai][bj][m][0]), "+v"(acc[ai][bj][m][1]));
                }
            asm volatile("" ::: "memory");
        }
        if constexpr (MODE == 3) {
            wave_row_stats<true>(acc, slots_out, 16, u.pn * 4 + wc, u.pm * BM + wr * 64 + fr, fq);
            asm volatile("s_waitcnt vmcnt(0)" ::: "memory");
            __builtin_amdgcn_s_barrier();
            const int tid = (wr * 4 + wc) * 64 + fq * 16 + fr;
            if (tid == 0) {
                (void)__hip_atomic_fetch_add(pcnt + u.pm, 1u, __ATOMIC_RELAXED, __HIP_MEMORY_SCOPE_AGENT);
                unsigned sp = 0;
                while (__hip_atomic_load(pcnt + u.pm, __ATOMIC_RELAXED, __HIP_MEMORY_SCOPE_AGENT) < 4u) { __builtin_amdgcn_s_sleep(1); if (++sp > (1u << 20)) break; }
                __builtin_amdgcn_fence(__ATOMIC_ACQUIRE, "agent");
            }
            __builtin_amdgcn_s_barrier();
            stats_table16_coh(slots_out, u.pm, tab3, tid);
            asm volatile("s_waitcnt lgkmcnt(0)" ::: "memory");
            __builtin_amdgcn_s_barrier();
#pragma unroll
            for (int bj = 0; bj < 2; ++bj) {
                const int col = u.pn * BM + bj * HALF + wc * 32 + 8 * fq;
                const f32x4 h0 = *(const f32x4*)(g3 + col), h1 = *(const f32x4*)(g3 + col + 4), c0 = *(const f32x4*)(b3 + col), c1 = *(const f32x4*)(b3 + col + 4);
#pragma unroll
                for (int ai = 0; ai < 2; ++ai)
#pragma unroll
                    for (int m = 0; m < 4; ++m) {
                        const int r = ai * HALF + wr * 64 + m * 16 + fr; const f32x2 st = tab3[r];
                        float* y = Of + (size_t)(u.pm * BM + r) * DM + col;
                        __builtin_nontemporal_store((acc[ai][bj][m][0] - st.x) * st.y * h0 + c0, (f32x4*)y); __builtin_nontemporal_store((acc[ai][bj][m][1] - st.x) * st.y * h1 + c1, (f32x4*)(y + 4));
                    }
                asm volatile("" ::: "memory");
            }
            return;
        }
        wave_row_stats(acc, slots_out, 16, u.pn * 4 + wc, u.pm * BM + wr * 64 + fr, fq);
#pragma unroll
        for (int ai = 0; ai < 2; ++ai)
#pragma unroll
            for (int m = 0; m < 4; ++m) {
                const size_t row = (size_t)(u.pm * BM + ai * HALF + wr * 64 + m * 16 + fr);
#pragma unroll
                for (int bj = 0; bj < 2; ++bj) {
                    const int col = u.pn * BM + bj * HALF + wc * 32 + 8 * fq;
                    if constexpr (MODE == 2) { *(f32x4*)(Of + row * DM + col) = acc[ai][bj][m][0]; *(f32x4*)(Of + row * DM + col + 4) = acc[ai][bj][m][1]; }
                    else *(u32x4*)(Ob + row * DM + col) = pack8(acc[ai][bj][m][0], acc[ai][bj][m][1]);
                }
                asm volatile("" ::: "memory");
            }
    }
};

struct EpiWin {
    static constexpr bool HAS_PREP = true; static constexpr int MID_T = -1;
    const float* cs; const float* bias; const u64* slots; LAS f32x2* stab;
    bf16 *Q, *K, *V, *U, *GV, *SA, *SB; u64* sgv; float* out;
    __device__ __forceinline__ void prep(const Unit& u, int par, int tid) const { stats_table16(slots, u.pm, stab + par * 256, tid); }
    __device__ __forceinline__ void mid(f32x4 (&)[2][2][4][2], const Unit&, int, int, int, int) const {}
    template <int ACT>
    __device__ __forceinline__ void store_tile(f32x4 (&acc)[2][2][4][2], bf16* dst, int ld, int c0, const Unit& u, int wr, int wc, int fr, int fq) const {
#pragma unroll
        for (int ai = 0; ai < 2; ++ai)
#pragma unroll
            for (int m = 0; m < 4; ++m) {
                bf16* rowp = dst + (size_t)(u.pm * BM + ai * HALF + wr * 64 + m * 16 + fr) * ld + c0 + wc * 32 + 8 * fq;
#pragma unroll
                for (int bj = 0; bj < 2; ++bj) {
                    f32x4 v0 = acc[ai][bj][m][0], v1 = acc[ai][bj][m][1];
                    if (ACT == 1) { v0 = v0 * QSCALE; v1 = v1 * QSCALE; }
                    if (ACT == 2) { v0 = gelu4(v0); v1 = gelu4(v1); }
                    if (ACT == 3) { v0 = sigmoid4(v0); v1 = sigmoid4(v1); }
                    __builtin_nontemporal_store(pack8(v0, v1), (u32x4*)(rowp + bj * HALF));
                }
                asm volatile("" ::: "memory");
            }
    }
    template <int ACT>
    __device__ __forceinline__ void store_planes(f32x4 (&acc)[2][2][4][2], bf16* dst, int g, const Unit& u, int wr, int wc, int fr, int fq) const {
#pragma unroll
        for (int ai = 0; ai < 2; ++ai)
#pragma unroll
            for (int m = 0; m < 4; ++m) {
                bf16* rowp = dst + (size_t)(g * 4 + (wc >> 1)) * PLQ + (size_t)(u.pm * BM + ai * HALF + wr * 64 + m * 16 + fr) * 64 + (wc & 1) * 32 + 8 * fq;
#pragma unroll
                for (int bj = 0; bj < 2; ++bj) {
                    f32x4 v0 = acc[ai][bj][m][0], v1 = acc[ai][bj][m][1];
                    if (ACT == 1) { v0 = v0 * QSCALE; v1 = v1 * QSCALE; }
                    *(u32x4*)(rowp + (size_t)bj * 2 * PLQ) = pack8(v0, v1);
                }
                asm volatile("" ::: "memory");
            }
    }
    __device__ __forceinline__ void operator()(f32x4 (&acc)[2][2][4][2], const Unit& u, int wr, int wc, int fr, int fq, int par) const {
        asm volatile("" : "+v"(fr), "+v"(fq));
#pragma unroll
        for (int bj = 0; bj < 2; ++bj) {
            const int col = u.pn * BM + bj * HALF + wc * 32 + 8 * fq;
            const f32x4 c0 = *(const f32x4*)(cs + col), c1 = *(const f32x4*)(cs + col + 4), b0 = *(const f32x4*)(bias + col), b1 = *(const f32x4*)(bias + col + 4);
#pragma unroll
            for (int ai = 0; ai < 2; ++ai)
#pragma unroll
                for (int m = 0; m < 4; ++m) {
                    const f32x2 st = stab[par * 256 + ai * HALF + wr * 64 + m * 16 + fr];
                    const float k2 = -st.x * st.y;
                    acc[ai][bj][m][0] = acc[ai][bj][m][0] * st.y + (c0 * k2 + b0); acc[ai][bj][m][1] = acc[ai][bj][m][1] * st.y + (c1 * k2 + b1);
                    asm volatile("" : "+v"(acc[ai][bj][m][0]), "+v"(acc[ai][bj][m][1]));
                }
            asm volatile("" ::: "memory");
        }
        const int pn = u.pn;
        if (pn < 3) { store_planes<1>(acc, Q, pn, u, wr, wc, fr, fq); }
        else if (pn < 9) {
            const int kv = pn >= 6 ? 1 : 0, g = pn - 3 - 3 * kv, W = 128 << (2 * g);
            store_planes<0>(acc, kv ? V : K, g, u, wr, wc, fr, fq);
            const size_t obase_p = (g == 0) ? O_W0P : (g == 1) ? O_W1P : O_W2P, obase_s = (g == 0) ? O_W0S : (g == 1) ? O_W1S : O_W2S;
#pragma unroll
            for (int ai = 0; ai < 2; ++ai)
#pragma unroll
                for (int m = 0; m < 4; ++m) {
                    const int r = ai * HALF + wr * 64 + m * 16 + fr;
                    float* dst = nullptr;
                    if (u.pm < MP / BM) { const int b = u.pm >> 3, t = (u.pm & 7) * 256 + r, p = t - (SEQ - W); if (p >= 0) dst = out + obase_p + ((size_t)(b * W + p) * 2 + kv) * 256; }
                    else { const int ms = (u.pm - MP / BM) * 256 + r, bd = ms >> 2, tt = ms & 3; dst = out + obase_s + ((size_t)(bd * W + W - 4 + tt) * 2 + kv) * 256; }
                    if (dst) {
#pragma unroll
                        for (int bj = 0; bj < 2; ++bj) { float* d2 = dst + bj * HALF + wc * 32 + 8 * fq; __builtin_nontemporal_store(acc[ai][bj][m][0], (f32x4*)d2); __builtin_nontemporal_store(acc[ai][bj][m][1], (f32x4*)(d2 + 4)); }
                    }
                    asm volatile("" ::: "memory");
                }
        }
        else if (pn < 11) {
#pragma unroll
            for (int ai = 0; ai < 2; ++ai)
#pragma unroll
                for (int m = 0; m < 4; ++m) {
                    bf16* rowp = U + (size_t)((pn - 9) * 8 + wc) * PLU + (size_t)(u.pm * BM + ai * HALF + wr * 64 + m * 16 + fr) * 32 + 8 * fq;
#pragma unroll
                    for (int bj = 0; bj < 2; ++bj) *(u32x4*)(rowp + (size_t)bj * 4 * PLU) = pack8(gelu4(acc[ai][bj][m][0]), gelu4(acc[ai][bj][m][1]));
                    asm volatile("" ::: "memory");
                }
        }
        else if (pn < 13) {
            bf16* dstb = GV + (size_t)((pn - 11) * 8 + wc) * PLU + 8 * fq; const int sidx = (pn - 11) * 4 + wc;
#pragma unroll
            for (int ai = 0; ai < 2; ++ai)
#pragma unroll
                for (int m = 0; m < 4; ++m) {
                    const size_t row = (size_t)(u.pm * BM + ai * HALF + wr * 64 + m * 16 + fr);
                    f32x4 t[2][2]; float s = 0.f;
#pragma unroll
                    for (int bj = 0; bj < 2; ++bj)
#pragma unroll
                        for (int n = 0; n < 2; ++n) { t[bj][n] = gelu4(acc[ai][bj][m][n]); s += (t[bj][n][0] + t[bj][n][1]) + (t[bj][n][2] + t[bj][n][3]); }
                    s += __shfl_xor(s, 16); s += __shfl_xor(s, 32);
                    const float mw = s * (1.0f / 64.0f); float q = 0.f;
#pragma unroll
                    for (int bj = 0; bj < 2; ++bj)
#pragma unroll
                        for (int n = 0; n < 2; ++n) { const f32x4 d = t[bj][n] - mw; q += (d[0] * d[0] + d[1] * d[1]) + (d[2] * d[2] + d[3] * d[3]); }
                    q += __shfl_xor(q, 16); q += __shfl_xor(q, 32);
                    if (fq == 0) sgv[row * 8 + sidx] = ((u64)__float_as_uint(q) << 32) | (u64)__float_as_uint(mw);
#pragma unroll
                    for (int bj = 0; bj < 2; ++bj) *(u32x4*)(dstb + row * 32 + (size_t)bj * 4 * PLU) = pack8(t[bj][0], t[bj][1]);
                    asm volatile("" ::: "memory");
                }
        }
        else {
            const int p = pn - 13, wave = wr * 4 + wc, ln = fq * 16 + fr;
#pragma unroll
            for (int ai = 0; ai < 2; ++ai)
#pragma unroll
                for (int m = 0; m < 4; ++m) {
                    const size_t idx = ((((size_t)(u.pm * 8 + p) * 8 + wave) * 8 + (ai * 4 + m)) * 64 + ln) * 8;
                    f32x4 r[2], sb[2];
#pragma unroll
                    for (int n = 0; n < 2; ++n) {
                        const f32x4 xa = acc[ai][0][m][n] * (-LOG2E), xb = acc[ai][1][m][n] * (-LOG2E);
                        f32x4 ea = {fast_exp2(xa[0]), fast_exp2(xa[1]), fast_exp2(xa[2]), fast_exp2(xa[3])}, eb = {fast_exp2(xb[0]), fast_exp2(xb[1]), fast_exp2(xb[2]), fast_exp2(xb[3])};
                        ea = __builtin_elementwise_min(ea, (f32x4){1e30f, 1e30f, 1e30f, 1e30f}) + 1.0f; eb = __builtin_elementwise_min(eb, (f32x4){1e30f, 1e30f, 1e30f, 1e30f}) + 1.0f;
                        const f32x4 ia = {fast_rcp(ea[0]), fast_rcp(ea[1]), fast_rcp(ea[2]), fast_rcp(ea[3])};
                        sb[n] = (f32x4){fast_rcp(eb[0]), fast_rcp(eb[1]), fast_rcp(eb[2]), fast_rcp(eb[3])}; r[n] = eb * ia; }
                    __builtin_nontemporal_store(pack8(r[0], r[1]), (u32x4*)(SA + idx)); __builtin_nontemporal_store(pack8(sb[0], sb[1]), (u32x4*)(SB + idx));
                    asm volatile("" ::: "memory");
                }
        }
    }
};

struct EpiGate {
    static constexpr bool HAS_PREP = false; static constexpr int MID_T = 4;
    const bf16* SA; const bf16* SB; bf16* T;
    __device__ __forceinline__ void prep(const Unit&, int, int) const {}
    __device__ __forceinline__ void mid(f32x4 (&acc)[2][2][4][2], const Unit& u, int wr, int wc, int fr, int fq) const {
        asm volatile("" : "+v"(fr), "+v"(fq));
        const int wave = wr * 4 + wc, ln = fq * 16 + fr;
        u32x4 w[2][8];
#pragma unroll
        for (int bj = 0; bj < 2; ++bj)
#pragma unroll
            for (int j = 0; j < 8; ++j) w[bj][j] = *(const u32x4*)(SA + ((((size_t)(u.pm * 8 + 2 * u.pn + bj) * 8 + wave) * 8 + j) * 64 + ln) * 8);
#pragma unroll
        for (int bj = 0; bj < 2; ++bj)
#pragma unroll
            for (int j = 0; j < 8; ++j) { const int ai = j >> 2, m = j & 3; f32x4 r0, r1; unpack8(w[bj][j], r0, r1); acc[ai][bj][m][0] *= r0; acc[ai][bj][m][1] *= r1; asm volatile("" : "+v"(acc[ai][bj][m][0]), "+v"(acc[ai][bj][m][1])); }
        asm volatile("" ::: "memory");
    }
    __device__ __forceinline__ void operator()(f32x4 (&acc)[2][2][4][2], const Unit& u, int wr, int wc, int fr, int fq, int) const {
        asm volatile("" : "+v"(fr), "+v"(fq));
        const int wave = wr * 4 + wc, ln = fq * 16 + fr;
        u32x4 w[2][8];
#pragma unroll
        for (int bj = 0; bj < 2; ++bj)
#pragma unroll
            for (int j = 0; j < 8; ++j) w[bj][j] = *(const u32x4*)(SB + ((((size_t)(u.pm * 8 + 2 * u.pn + bj) * 8 + wave) * 8 + j) * 64 + ln) * 8);
#pragma unroll
        for (int bj = 0; bj < 2; ++bj)
#pragma unroll
            for (int j = 0; j < 8; ++j) { const int ai = j >> 2, m = j & 3; f32x4 b0, b1; unpack8(w[bj][j], b0, b1);
                *(u32x4*)(T + (size_t)(u.pm * BM + ai * HALF + wr * 64 + m * 16 + fr) * DM + u.pn * BM + bj * HALF + wc * 32 + 8 * fq) = pack8(acc[ai][bj][m][0] * b0, acc[ai][bj][m][1] * b1); }
        asm volatile("" ::: "memory");
    }
};
}

#define XB_TMO      128
#define XB_XCNT(j)  (256  + 64 * (j))
#define XB_XSUB(j)  (1280 + 64 * (j))
#define XB_XGEN(j)  (2304 + 64 * (j))
#define XB_TOP      3328
#define XB_TOPGEN   3392
#define XCD_BAR_WORDS 3456
#define XB_SPIN_CAP (1u << 18)
__device__ __forceinline__ unsigned xb_ld(unsigned* p)              { return __hip_atomic_load(p, __ATOMIC_RELAXED, __HIP_MEMORY_SCOPE_AGENT); }
__device__ __forceinline__ unsigned xb_add(unsigned* p, unsigned v) { return __hip_atomic_fetch_add(p, v, __ATOMIC_RELAXED, __HIP_MEMORY_SCOPE_AGENT); }
__device__ __forceinline__ unsigned xb_xcc_id() { return (unsigned)__builtin_amdgcn_s_getreg((3 << 11) | 20) & 0xFu; }
#define XB_SPIN(cond, bar) do { unsigned _sp = 0; while (cond) { __builtin_amdgcn_s_sleep(1); \
    if ((++_sp & 255u) == 0u) { if (xb_ld(&(bar)[XB_TMO])) break; if (_sp > XB_SPIN_CAP) { atomicAdd(&(bar)[XB_TMO], 1u); break; } } } } while (0)
struct XcdBarrier { unsigned* bar; unsigned x; volatile LAS unsigned* st; };
__device__ __forceinline__ XcdBarrier xcd_barrier_post(unsigned* bar, volatile LAS unsigned* st, const bool leader) {
    XcdBarrier b; b.bar = bar; b.x = xb_xcc_id(); b.st = st;
    if (leader) (void)xb_add(&bar[XB_XCNT(b.x)], 1u);
    return b;
}
__device__ __forceinline__ void xcd_barrier_complete(unsigned* bar, unsigned x, unsigned& nloc, unsigned& nx) {
    const unsigned G = gridDim.x * gridDim.y * gridDim.z;
    unsigned sum, cnt, mine, sp = 0u;
    for (;;) {
        sum = 0u; cnt = 0u; mine = 0u;
#pragma unroll
        for (unsigned j = 0; j < 16; ++j) { const unsigned c = xb_ld(&bar[XB_XCNT(j)]); sum += c; cnt += (c > 0u) ? 1u : 0u; mine = (j == x) ? c : mine; }
        if (sum == G) break;
        __builtin_amdgcn_s_sleep(1);
        if ((++sp & 255u) == 0u) { if (xb_ld(&bar[XB_TMO])) break; if (sp > XB_SPIN_CAP) { atomicAdd(&bar[XB_TMO], 1u); break; } }
    }
    nloc = mine > 0u ? mine : 1u; nx = cnt > 0u ? cnt : 1u;
}
__device__ __forceinline__ void xcd_barrier(const XcdBarrier& b, const bool leader) {
    asm volatile("s_waitcnt vmcnt(0)" ::: "memory");
    __syncthreads();
    if (leader) {
        unsigned* bar = b.bar;
        __builtin_amdgcn_s_waitcnt(0);
        unsigned nloc = b.st[0], nx = b.st[1];
        if (nloc == 0u) { xcd_barrier_complete(bar, b.x, nloc, nx); b.st[0] = nloc; b.st[1] = nx; }
        const unsigned old = xb_add(&bar[XB_XSUB(b.x)], 1u);
        const unsigned gen = old / nloc;
        if (old + 1u == (gen + 1u) * nloc) {
            __builtin_amdgcn_fence(__ATOMIC_RELEASE, "agent");
            asm volatile("s_waitcnt vmcnt(0)" ::: "memory");
            const unsigned og = xb_add(&bar[XB_TOP], 1u);
            const unsigned tg = og / nx;
            if (og + 1u == (tg + 1u) * nx) xb_add(&bar[XB_TOPGEN], 1u);
            else XB_SPIN(xb_ld(&bar[XB_TOPGEN]) == tg, bar);
            __builtin_amdgcn_fence(__ATOMIC_ACQUIRE, "agent");
            xb_add(&bar[XB_XGEN(b.x)], 1u);
            asm volatile("s_waitcnt vmcnt(0)" ::: "memory");
        } else {
            XB_SPIN(xb_ld(&bar[XB_XGEN(b.x)]) == gen, bar);
            __builtin_amdgcn_fence(__ATOMIC_ACQUIRE, "agent");
            asm volatile("s_waitcnt vmcnt(0)" ::: "memory");
        }
    }
    __syncthreads();
}

struct Args { const float* in[27]; float* out; unsigned char* ws; int ph_lo, ph_hi, li, pad; };
struct Frame {
    LAS unsigned char* lds; int tid, lane, wave, vcu, G;
    const float* const* in; float* out; unsigned char* ws;
};
#define WSP(T, off) ((T*)(F.ws + (off)))

__device__ __forceinline__ void p0_tr_item(const float* W, int N, bf16* WT, int ldk, int koff, int dst_row0, const float* g, LAS float* scr, int k0, int n0, int lane,
                                           float* part = nullptr, int bias_off = 0, const float* bvec = nullptr) {
    f32x4 w[8]; float gk[8], bk[8];
#pragma unroll
    for (int i = 0; i < 8; ++i) { const int kk = 8 * i + (lane >> 3); w[i] = *(const f32x4*)(W + (size_t)(k0 + kk) * N + n0 + 4 * (lane & 7)); gk[i] = g ? g[k0 + kk] : 1.0f; bk[i] = part ? bvec[k0 + kk] : 0.f; }
    f32x4 cs = {0.f, 0.f, 0.f, 0.f}, bi = cs;
#pragma unroll
    for (int i = 0; i < 8; ++i) { const int kk = 8 * i + (lane >> 3); LAS float* d = scr + kk * 33 + 4 * (lane & 7); f32x4 v = w[i]; if (g) v = v * gk[i]; d[0] = v[0]; d[1] = v[1]; d[2] = v[2]; d[3] = v[3];
        if (part) { cs += (f32x4){bfround(v[0]), bfround(v[1]), bfround(v[2]), bfround(v[3])}; bi += w[i] * bk[i]; } }
    if (part) {
#pragma unroll
        for (int c = 0; c < 4; ++c) { cs[c] += __shfl_xor(cs[c], 8); cs[c] += __shfl_xor(cs[c], 16); cs[c] += __shfl_xor(cs[c], 32); bi[c] += __shfl_xor(bi[c], 8); bi[c] += __shfl_xor(bi[c], 16); bi[c] += __shfl_xor(bi[c], 32); }
        if (lane < 8) { *(f32x4*)(part + 4 * lane) = cs; *(f32x4*)(part + bias_off + 4 * lane) = bi; }
    }
    asm volatile("s_waitcnt lgkmcnt(0)" ::: "memory");
    const int c = lane & 7;
#pragma unroll
    for (int j = 0; j < 4; ++j) { const int n = (lane >> 3) + 8 * j; const LAS float* s = scr + (8 * c) * 33 + n;
        u32x4 o; o.x = pk2(s[0 * 33], s[1 * 33]); o.y = pk2(s[2 * 33], s[3 * 33]); o.z = pk2(s[4 * 33], s[5 * 33]); o.w = pk2(s[6 * 33], s[7 * 33]);
        *(u32x4*)(WT + (size_t)(dst_row0 + n) * ldk + koff + k0 + 8 * c) = o; }
    asm volatile("s_waitcnt lgkmcnt(0)" ::: "memory");
}
__device__ __forceinline__ int swiglu_row(int n, int sel) { return 256 * (n >> 7) + (n & 127) + sel * 128; }
__device__ __forceinline__ int win_row(int n) { if (n < 3328) return n; const int q = n - 3328; return q < 1024 ? 3328 + 256 * (q >> 7) + (q & 127) : 3328 + 256 * ((q - 1024) >> 7) + 128 + (q & 127); }

__device__ __forceinline__ void p0_prologue(Frame& F) {
    const int gw = F.vcu * 8 + F.wave, NGW = F.G * 8, lane = F.lane;
    const int gt = F.vcu * 512 + F.tid, NGT = F.G * 512;
    float* sm = WSP(float, WS_SMALL);
    float* part16 = WSP(float, WS_LSE);
    LAS float* scr = (LAS float*)(F.lds + F.wave * 16384);
    for (int it = gw; it < 12032; it += NGW) {
        int r = it;
        if (r < 2816) { const int sel = r / 1408, q = r % 1408, kb = q / 88, nb = q % 88; p0_tr_item(sel ? F.in[9] : F.in[8], DFF, WSP(bf16, WS_WF1), DM, 0, swiglu_row(nb * 32, sel), nullptr, scr, kb * 64, nb * 32, lane); continue; } r -= 2816;
        if (r < 1408) { const int kb = r / 32, nb = r % 32; p0_tr_item(F.in[10], DM, WSP(bf16, WS_WF1D), DFF, 0, nb * 32, nullptr, scr, kb * 64, nb * 32, lane); continue; } r -= 1408;
        if (r < 2688) { const int kb = r / 168, nb = r % 168; p0_tr_item(F.in[11], INW, WSP(bf16, WS_WIN), DM, 0, win_row(nb * 32), F.in[6], scr, kb * 64, nb * 32, lane, part16 + kb * 22016 + win_row(nb * 32), 5376, F.in[7]); continue; } r -= 2688;
        if (r < 128) { const int kb = r / 32, nb = r % 32; p0_tr_item(F.in[17], DM, WSP(bf16, WS_WOAB), 768, 0, nb * 32, nullptr, scr, kb * 64, nb * 32, lane); continue; } r -= 128;
        if (r < 256) { const int kb = r / 32, nb = r % 32; p0_tr_item(F.in[18], DM, WSP(bf16, WS_WOAB), 768, 256, nb * 32, nullptr, scr, kb * 64, nb * 32, lane); continue; } r -= 256;
        if (r < 512) { const int kb = r / 32, nb = r % 32; p0_tr_item(F.in[19], DM, WSP(bf16, WS_WOUT), DM, 0, nb * 32, nullptr, scr, kb * 64, nb * 32, lane); continue; } r -= 512;
        if (r < 2816) { const int sel = r / 1408, q = r % 1408, kb = q / 88, nb = q % 88; p0_tr_item(sel ? F.in[23] : F.in[22], DFF, WSP(bf16, WS_WF2), DM, 0, swiglu_row(nb * 32, sel), F.in[20], scr, kb * 64, nb * 32, lane, part16 + kb * 22016 + 10752 + swiglu_row(nb * 32, sel), 5632, F.in[21]); continue; } r -= 2816;
        { const int kb = r / 32, nb = r % 32; p0_tr_item(F.in[24], DM, WSP(bf16, WS_WF2D), DFF, 0, nb * 32, nullptr, scr, kb * 64, nb * 32, lane); }
    }
    for (int i = gt; i < 12 * 192; i += NGT) { const int hj = i / 192, x = i % 192, rel = x - 32, g = hj >> 2;
        sm[SM_BT + i] = (rel >= 0 && rel <= 128) ? F.in[5][(int)T5BUCKET[g][rel] * 12 + hj] * LOG2E : NEGBIG; }
    for (int i = gt; i < 4 * 128 * 128; i += NGT) { const int p = (i >> 7) & 127, q = i & 127; WSP(bf16, WS_WSB)[i] = (bf16)(q <= p ? f2bf(F.in[15][i]) : 0u); }
    for (int i0 = gt; i0 < M * 128; i0 += 4 * NGT) {
        f32x4 a[4], b[4];
#pragma unroll
        for (int k = 0; k < 4; ++k) { const int i = i0 + k * NGT; if (i < M * 128) { const int row = i >> 7, c8 = i & 127;
            const float* src = (row < MP ? F.in[0] + (size_t)row * DM : F.in[1] + (size_t)(row - MP) * DM) + c8 * 8;
            a[k] = __builtin_nontemporal_load((const f32x4*)src); b[k] = __builtin_nontemporal_load((const f32x4*)(src + 4)); } }
#pragma unroll
        for (int k = 0; k < 4; ++k) { const int i = i0 + k * NGT; if (i < M * 128) { const int row = i >> 7, c8 = i & 127;
            *(u32x4*)(WSP(bf16, WS_XB) + (size_t)row * DM + c8 * 8) = pack8(a[k], b[k]); } }
    }
}

constexpr int CW_CQ_HEAD = 8192, CW_DONE = 9216, CW_PCNT = 10240, CQ_PER_X = 669;
template <int G_> __device__ __forceinline__ void copy_chunk_g(const f32x4* src, f32x4* dst, unsigned f0, int tid) {
    constexpr unsigned W = 128u << (2 * G_), per = (W - 4u) * 128u;
#pragma unroll
    for (int bt = 0; bt < 2; ++bt) { f32x4 v[8]; size_t o[8];
#pragma unroll
        for (int j = 0; j < 8; ++j) { const unsigned f = f0 + (unsigned)((bt * 8 + j) * 512 + tid), bd = f / per, off = f - bd * per; o[j] = (size_t)bd * (W * 128u) + off; v[j] = __builtin_nontemporal_load(src + o[j] + 512); }
#pragma unroll
        for (int j = 0; j < 8; ++j) __builtin_nontemporal_store(v[j], dst + o[j]);
    }
}
__device__ __forceinline__ void copy_chunk(Frame& F, int c) {
    if (c < 248) copy_chunk_g<0>((const f32x4*)F.in[2], (f32x4*)(F.out + O_W0S), (unsigned)c * 8192u, F.tid);
    else if (c < 1264) copy_chunk_g<1>((const f32x4*)F.in[3], (f32x4*)(F.out + O_W1S), (unsigned)(c - 248) * 8192u, F.tid);
    else copy_chunk_g<2>((const f32x4*)F.in[4], (f32x4*)(F.out + O_W2S), (unsigned)(c - 1264) * 8192u, F.tid);
}
__device__ __forceinline__ void copy_fill(Frame& F, unsigned* ctl, int phase, bool drain) {
    volatile LAS int* slot = (volatile LAS int*)(F.lds + MISC_OFF + 64);
    const unsigned x = xb_xcc_id() & 7u;
    __syncthreads();
    if (F.tid == 0 && !drain) (void)__hip_atomic_fetch_add(ctl + CW_DONE + 64 * phase, 1u, __ATOMIC_RELAXED, __HIP_MEMORY_SCOPE_AGENT);
    for (unsigned q = 0; q < (drain ? 8u : 1u); ++q) {
        const unsigned xq = (x + q) & 7u;
        for (;;) {
            if (F.tid == 0) { int c = -1;
                if (drain || __hip_atomic_load(ctl + CW_DONE + 64 * phase, __ATOMIC_RELAXED, __HIP_MEMORY_SCOPE_AGENT) < (unsigned)F.G) {
                    const unsigned h = __hip_atomic_fetch_add(ctl + CW_CQ_HEAD + 64 * xq, 1u, __ATOMIC_RELAXED, __HIP_MEMORY_SCOPE_AGENT); if (h < (unsigned)CQ_PER_X) c = (int)(xq * CQ_PER_X + h); }
                *slot = c; }
            __syncthreads();
            const int c = *slot;
            __syncthreads();
            if (c < 0) break;
            copy_chunk(F, c);
        }
    }
}

__device__ __forceinline__ f32x16 mfma32(bf16x8 a, bf16x8 b, f32x16 c) { return __builtin_amdgcn_mfma_f32_32x32x16_bf16(a, b, c, 0, 0, 0); }
__device__ __forceinline__ s16x4 trld(const LAS unsigned char* p) { return __builtin_bit_cast(s16x4, __builtin_amdgcn_ds_read_tr16_b64_v4i16((LAS s16x4*)p)); }

__device__ __forceinline__ void attn_unit(Frame& F, int au, LAS unsigned char* wl, int& cur_gj) {
    int lane = F.lane; asm volatile("" : "+v"(lane));
    const int r32 = lane & 31, hi = lane >> 5;
    const int blk = au & 63, bg = au >> 6, gj = bg % 12, b = bg / 12, g = gj >> 2, j = gj & 3;
    const int dsh = 2 * g, d = 1 << dsh, bpr = 64 >> dsh, r = blk >> (6 - dsh), m0 = (blk & (bpr - 1)) * 32;
    const size_t rowbase = (size_t)b * SEQ; const int hc = g * 256 + j * 64;
    const bf16* Qb = WSP(bf16, WS_Q); const bf16* Kb = WSP(bf16, WS_K); const bf16* Vb = WSP(bf16, WS_V);
    LAS float* tab = (LAS float*)(wl + 8192);
    if (gj != cur_gj) { const float* bt = WSP(float, WS_SMALL) + SM_BT + gj * 192;
#pragma unroll
        for (int i = 0; i < 3; ++i) tab[lane + 64 * i] = bt[lane + 64 * i];
        cur_gj = gj; }
    const int tq = (m0 + r32) * d + r;
    const unsigned voff = (unsigned)((lane >> 3) * d * 64 + (lane & 7) * 8);
    const long ub = (long)gj * (long)PLQ + (long)(rowbase + r) * 64;
#define AT_LD4(dst_, base_, sp_) do { _Pragma("unroll") for (int ii_ = 0; ii_ < 4; ++ii_) { const int sp__ = (sp_) + 8 * ii_; (dst_)[ii_] = *(const u32x4*)((base_) + ub + (long)((sp__ < 0 ? 0 : sp__) * d) * 64 + voff); } } while (0)
    const int i0 = m0 >= 128 ? 0 : (128 - m0) >> 5;
    LAS unsigned char* kb = wl + 12288;
    const int wro = (lane >> 3) * 128 + (((lane & 7) ^ ((lane >> 3) & 7)) << 4);
    u32x4 kr[5][4];
    bf16x8 qf[4];
    {
        u32x4 qr[4];
        AT_LD4(qr, Qb, m0);
        asm volatile("" ::: "memory");
#pragma unroll
        for (int i = 0; i < 5; ++i) AT_LD4(kr[i], Kb, m0 - 128 + 32 * i);
#pragma unroll
        for (int ii = 0; ii < 4; ++ii) *(LAS u32x4*)(kb + wro + 1024 * ii) = qr[ii];
#pragma unroll
        for (int s = 0; s < 4; ++s) qf[s] = *(const LAS bf16x8*)(kb + r32 * 128 + (((2 * s + hi) ^ (r32 & 7)) << 4));
    }
    f32x16 sc[5];
#pragma unroll
    for (int i = 0; i < 5; ++i) {
#pragma unroll
        for (int ii = 0; ii < 4; ++ii) *(LAS u32x4*)(kb + wro + 1024 * ii) = kr[i][ii];
        AT_LD4(kr[i], Vb, m0 - 128 + 32 * i);
        bf16x8 kf[4];
#pragma unroll
        for (int s = 0; s < 4; ++s) kf[s] = *(const LAS bf16x8*)(kb + r32 * 128 + (((2 * s + hi) ^ (r32 & 7)) << 4));
        f32x16 a = {};
#pragma unroll
        for (int s = 0; s < 4; ++s) a = mfma32(kf[s], qf[s], a);
        const LAS float* tb = tab + (r32 - 4 * hi + 4) + (i >= i0 ? 156 - 32 * i : 192 + 27);
#pragma unroll
        for (int R = 0; R < 16; ++R) a[R] += tb[-((R & 3) + 8 * (R >> 2))];
        sc[i] = a;
    }
    float mx = NEGBIG;
#pragma unroll
    for (int i = 0; i < 5; ++i)
#pragma unroll
        for (int R = 0; R < 16; ++R) mx = fmaxf(mx, sc[i][R]);
    mx = fmaxf(mx, __shfl_xor(mx, 32));
    float l = 0.f;
#pragma unroll
    for (int i = 0; i < 5; ++i)
#pragma unroll
        for (int R = 0; R < 16; ++R) { const float p = fast_exp2(sc[i][R] - mx); sc[i][R] = p; l += p; }
    l += __shfl_xor(l, 32);
    f32x16 o0 = {}, o1 = {};
    const int vaoff = (4 * hi + ((lane & 15) >> 2)) * 64 + ((lane >> 4) & 1) * 32 + (lane & 3) * 8;
    const int vwo = ((lane & 7) >> 2) * 2048 + (lane >> 3) * 64 + (lane & 3) * 16;
#pragma unroll
    for (int i = 0; i < 5; ++i) {
        LAS unsigned char* vb = wl + (i & 1) * 4096;
        {
#pragma unroll
            for (int ii = 0; ii < 4; ++ii) *(LAS u32x4*)(vb + vwo + 512 * ii) = kr[i][ii];
            const LAS unsigned char* va = vb + vaoff;
#pragma unroll
            for (int s = 0; s < 2; ++s) {
                u32x4 pw; pw.x = cvt_pk_bf16(sc[i][8 * s + 0], sc[i][8 * s + 1]); pw.y = cvt_pk_bf16(sc[i][8 * s + 2], sc[i][8 * s + 3]); pw.z = cvt_pk_bf16(sc[i][8 * s + 4], sc[i][8 * s + 5]); pw.w = cvt_pk_bf16(sc[i][8 * s + 6], sc[i][8 * s + 7]);
                const bf16x8 pb = __builtin_bit_cast(bf16x8, pw);
                { const s16x4 lo = trld(va + s * 1024), h2 = trld(va + s * 1024 + 512); const bf16x8 A = {lo[0], lo[1], lo[2], lo[3], h2[0], h2[1], h2[2], h2[3]}; o0 = mfma32(A, pb, o0); }
                { const s16x4 lo = trld(va + 2048 + s * 1024), h2 = trld(va + 2048 + s * 1024 + 512); const bf16x8 A = {lo[0], lo[1], lo[2], lo[3], h2[0], h2[1], h2[2], h2[3]}; o1 = mfma32(A, pb, o1); }
            }
        }
    }
#undef AT_LD4
    const float inv = 1.0f / l;
    {
        LAS unsigned char* ob = wl;
#pragma unroll
        for (int G4 = 0; G4 < 4; ++G4) {
            u32x2 w0; w0.x = cvt_pk_bf16(o0[4 * G4] * inv, o0[4 * G4 + 1] * inv); w0.y = cvt_pk_bf16(o0[4 * G4 + 2] * inv, o0[4 * G4 + 3] * inv); *(LAS u32x2*)(ob + r32 * 144 + (8 * G4 + 4 * hi) * 2) = w0;
            u32x2 w1; w1.x = cvt_pk_bf16(o1[4 * G4] * inv, o1[4 * G4 + 1] * inv); w1.y = cvt_pk_bf16(o1[4 * G4 + 2] * inv, o1[4 * G4 + 3] * inv); *(LAS u32x2*)(ob + r32 * 144 + (32 + 8 * G4 + 4 * hi) * 2) = w1;
        }
        bf16* OGb = WSP(bf16, WS_OG);
#pragma unroll
        for (int ii = 0; ii < 4; ++ii) { const int qi = 8 * ii + (lane >> 3), ch = lane & 7;
            const u32x4 w = *(const LAS u32x4*)(ob + qi * 144 + ch * 16);
            *(u32x4*)(OGb + (size_t)gj * PLQ + (rowbase + (size_t)((m0 + qi) * d + r)) * 64 + ch * 8) = w; }
    }
    if (hi == 0) WSP(float, WS_LSE)[(rowbase + tq) * 12 + gj] = (mx + __builtin_amdgcn_logf(l)) * LN2F;
}

__device__ __forceinline__ void attn_sample_task(Frame& F, int task, LAS unsigned char* wl) {
    int lane = F.lane; asm volatile("" : "+v"(lane));
    const int sub = lane >> 4, l16 = lane & 15, t = task & 3, gj = (task >> 2) % 12, bd = task / 48, g = gj >> 2, j = gj & 3;
    const int W = 128 << (2 * g), d = 1 << (2 * g), hc = g * 256 + j * 64;
    const size_t row = (size_t)MP + bd * 4 + t;
    const float* stu = (g == 0 ? F.in[2] : g == 1 ? F.in[3] : F.in[4]) + (size_t)bd * W * 512 + j * 64;
    const float* st = stu + 4 * l16;
    const float* nw = F.out + (g == 0 ? O_W0S : g == 1 ? O_W1S : O_W2S) + (size_t)bd * W * 512 + j * 64 + 4 * l16;
    const float* bt = WSP(float, WS_SMALL) + SM_BT + gj * 192 + 32;
    LAS float* scb = (LAS float*)(wl + 10240);
    const u32x2 qw = *(const u32x2*)(WSP(bf16, WS_Q) + (size_t)gj * PLQ + row * 64 + 4 * l16);
    const f32x4 qv = {bflo(qw.x), bfhi(qw.x), bflo(qw.y), bfhi(qw.y)};
    const float* r0p; { const int idx = W + t - sub * d; r0p = idx < W ? st + (size_t)idx * 512 : nw + (size_t)(idx - 4) * 512; }
#define SOFF(u_) ((unsigned)((W + t - (4 * (u_) + sub < 128 ? 4 * (u_) + sub : 128) * d) * 512 + 4 * l16))
    {
        f32x4 kv[17];
        kv[0] = *(const f32x4*)r0p;
#pragma unroll
        for (int u = 1; u < 17; ++u) kv[u] = *(const f32x4*)(stu + SOFF(u));
#pragma unroll
        for (int u = 0; u < 17; ++u) { const int i = u * 4 + sub;
            float s = (qv[0] * kv[u][0] + qv[1] * kv[u][1]) + (qv[2] * kv[u][2] + qv[3] * kv[u][3]);
            s += __shfl_xor(s, 1); s += __shfl_xor(s, 2); s += __shfl_xor(s, 4); s += __shfl_xor(s, 8);
            if (l16 == 0) scb[i] = s + bt[i]; }
        asm volatile("" ::: "memory");
    }
    f32x4 vA[11], vB[11], vC[11];
    {
        f32x4 kv[16];
#pragma unroll
        for (int u = 0; u < 16; ++u) kv[u] = *(const f32x4*)(stu + SOFF(17 + u));
        vA[0] = *(const f32x4*)(r0p + 256);
#pragma unroll
        for (int u = 1; u < 11; ++u) vA[u] = *(const f32x4*)(stu + 256 + SOFF(u));
#pragma unroll
        for (int u = 0; u < 16; ++u) { const int i = (17 + u) * 4 + sub, ii = i < 128 ? i : 128;
            float s = (qv[0] * kv[u][0] + qv[1] * kv[u][1]) + (qv[2] * kv[u][2] + qv[3] * kv[u][3]);
            s += __shfl_xor(s, 1); s += __shfl_xor(s, 2); s += __shfl_xor(s, 4); s += __shfl_xor(s, 8);
            if (l16 == 0 && i <= 128) scb[i] = s + bt[ii]; }
    }
    asm volatile("s_waitcnt lgkmcnt(0)" ::: "memory");
#pragma unroll
    for (int u = 0; u < 11; ++u) vB[u] = *(const f32x4*)(stu + 256 + SOFF(11 + u));
    const float v0 = scb[lane], v1 = scb[lane + 64], v2 = lane == 0 ? scb[128] : NEGBIG;
    const float mx = wave_max(fmaxf(fmaxf(v0, v1), v2));
    const float p0 = fast_exp2(v0 - mx), p1 = fast_exp2(v1 - mx), p2 = lane == 0 ? fast_exp2(v2 - mx) : 0.f;
    const float l = wave_sum(p0 + p1 + p2);
    scb[lane] = p0; scb[lane + 64] = p1; if (lane < 4) scb[128 + lane] = p2;
    asm volatile("s_waitcnt lgkmcnt(0)" ::: "memory");
    f32x4 o4 = {0.f, 0.f, 0.f, 0.f};
#pragma unroll
    for (int u = 0; u < 11; ++u) o4 += scb[u * 4 + sub] * vA[u];
    asm volatile("" ::: "memory");
#pragma unroll
    for (int u = 0; u < 11; ++u) vC[u] = *(const f32x4*)(stu + 256 + SOFF(22 + u));
#pragma unroll
    for (int u = 0; u < 11; ++u) o4 += scb[(11 + u) * 4 + sub] * vB[u];
#pragma unroll
    for (int u = 0; u < 11; ++u) o4 += scb[(22 + u) * 4 + sub] * vC[u];
#undef SOFF
#pragma unroll
    for (int c = 0; c < 4; ++c) { o4[c] += __shfl_xor(o4[c], 16); o4[c] += __shfl_xor(o4[c], 32); }
    const float inv = 1.0f / l;
    if (lane < 16) { u32x2 w; w.x = cvt_pk_bf16(o4[0] * inv, o4[1] * inv); w.y = cvt_pk_bf16(o4[2] * inv, o4[3] * inv); *(u32x2*)(WSP(bf16, WS_OG) + (size_t)gj * PLQ + row * 64 + 4 * l16) = w; }
    if (lane == 0) WSP(float, WS_LSE)[row * 12 + gj] = (mx + __builtin_amdgcn_logf(l)) * LN2F;
    asm volatile("s_waitcnt lgkmcnt(0)" ::: "memory");
}

__device__ __forceinline__ void sgu_unit(Frame& F, int su, LAS unsigned char* wl) {
    const int lane = F.lane, r32 = lane & 31, hi = lane >> 5;
    const int cb = su & 3, gg = (su >> 2) & 3, chunk = su >> 4, c0 = gg * 128 + cb * 32; const size_t row0 = (size_t)chunk * 128;
    LAS f32x2* st = (LAS f32x2*)(wl + 9216);
    const u64* sgv = WSP(u64, WS_SGV);
#pragma unroll
    for (int h = 0; h < 2; ++h) { const int rr = lane + 64 * h; const u32x4* p = (const u32x4*)(sgv + (row0 + rr) * 8);
        const u32x4 a = p[0], b = p[1], c = p[2], dd = p[3];
        const float mn[8] = {__uint_as_float(a.x), __uint_as_float(a.z), __uint_as_float(b.x), __uint_as_float(b.z), __uint_as_float(c.x), __uint_as_float(c.z), __uint_as_float(dd.x), __uint_as_float(dd.z)};
        const float m2[8] = {__uint_as_float(a.y), __uint_as_float(a.w), __uint_as_float(b.y), __uint_as_float(b.w), __uint_as_float(c.y), __uint_as_float(c.w), __uint_as_float(dd.y), __uint_as_float(dd.w)};
        float smn = 0.f;
#pragma unroll
        for (int i = 0; i < 8; ++i) smn += mn[i];
        const float mt = smn * 0.125f; float q = 0.f;
#pragma unroll
        for (int i = 0; i < 8; ++i) { const float e = mn[i] - mt; q += m2[i] + 64.0f * e * e; }
        st[rr] = (f32x2){mt, 1.0f / sqrtf(q * (1.0f / 512.0f) + LN_EPS)}; }
    const int ch = lane & 3;
    const float* lg = F.in[13] + c0 + ch * 8; const float* lb = F.in[14] + c0 + ch * 8;
    const f32x4 g0 = *(const f32x4*)lg, g1 = *(const f32x4*)(lg + 4), b0 = *(const f32x4*)lb, b1 = *(const f32x4*)(lb + 4);
    const bf16* GVb = WSP(bf16, WS_GV);
#pragma unroll
    for (int it = 0; it < 8; ++it) { const int rw = 16 * it + (lane >> 2);
        const u32x4 w = *(const u32x4*)(GVb + (size_t)(gg * 4 + cb) * PLU + (row0 + rw) * 32 + ch * 8); f32x4 x0, x1; unpack8(w, x0, x1); const f32x2 s = st[rw];
        x0 = (x0 - s.x) * s.y * g0 + b0; x1 = (x1 - s.x) * s.y * g1 + b1;
        *(LAS u32x4*)(wl + rw * 64 + ch * 16) = pack8(x0, x1); }
    const LAS unsigned char* va = wl + (8 * hi + ((lane & 15) >> 2)) * 64 + ((lane >> 4) & 1) * 32 + (lane & 3) * 8;
    bf16x8 Af[8];
#pragma unroll
    for (int ks = 0; ks < 8; ++ks) { const s16x4 lo = trld(va + ks * 1024), h2 = trld(va + ks * 1024 + 256); Af[ks] = (bf16x8){lo[0], lo[1], lo[2], lo[3], h2[0], h2[1], h2[2], h2[3]}; }
    const bf16* Wsb = WSP(bf16, WS_WSB) + (size_t)gg * 128 * 128;
    const bf16* Ub = WSP(bf16, WS_U); bf16* AY = WSP(bf16, WS_AY);
#pragma unroll
    for (int pt = 0; pt < 4; ++pt) {
        f32x16 acc = {};
#pragma unroll
        for (int ks = 0; ks < 2 * pt + 2; ++ks) { const bf16x8 B = *(const bf16x8*)(Wsb + (size_t)(32 * pt + r32) * 128 + 16 * ks + 8 * hi); acc = mfma32(Af[ks], B, acc); }
        const float sbv = F.in[16][gg * 128 + 32 * pt + r32];
        const size_t prow = row0 + 32 * pt + r32;
#pragma unroll
        for (int G4 = 0; G4 < 4; ++G4) { const int c4 = 8 * G4 + 4 * hi;
            const u32x2 uw = *(const u32x2*)(Ub + (size_t)(gg * 4 + cb) * PLU + prow * 32 + c4);
            u32x2 y; y.x = cvt_pk_bf16(bflo(uw.x) * (acc[4 * G4] + sbv), bfhi(uw.x) * (acc[4 * G4 + 1] + sbv)); y.y = cvt_pk_bf16(bflo(uw.y) * (acc[4 * G4 + 2] + sbv), bfhi(uw.y) * (acc[4 * G4 + 3] + sbv));
            *(u32x2*)(AY + prow * 768 + 256 + c0 + c4) = y; }
    }
    asm volatile("s_waitcnt lgkmcnt(0)" ::: "memory");
}
__device__ __forceinline__ void sgu_sample_task(Frame& F, int bd) {
    const int lane = F.lane, c = lane * 8, gg = lane >> 4;
    const size_t row0 = (size_t)MP + bd * 4;
    const u64* sgv = WSP(u64, WS_SGV); const bf16* GVb = WSP(bf16, WS_GV); const bf16* Ub = WSP(bf16, WS_U); bf16* AY = WSP(bf16, WS_AY);
    const f32x4 g0 = *(const f32x4*)(F.in[13] + c), g1 = *(const f32x4*)(F.in[13] + c + 4), b0 = *(const f32x4*)(F.in[14] + c), b1 = *(const f32x4*)(F.in[14] + c + 4);
    f32x4 vn[4][2];
#pragma unroll
    for (int t = 0; t < 4; ++t) {
        const u32x4* p = (const u32x4*)(sgv + (row0 + t) * 8);
        const u32x4 a = p[0], b = p[1], cc = p[2], dd = p[3];
        const float mn[8] = {__uint_as_float(a.x), __uint_as_float(a.z), __uint_as_float(b.x), __uint_as_float(b.z), __uint_as_float(cc.x), __uint_as_float(cc.z), __uint_as_float(dd.x), __uint_as_float(dd.z)};
        const float m2[8] = {__uint_as_float(a.y), __uint_as_float(a.w), __uint_as_float(b.y), __uint_as_float(b.w), __uint_as_float(cc.y), __uint_as_float(cc.w), __uint_as_float(dd.y), __uint_as_float(dd.w)};
        float smn = 0.f;
#pragma unroll
        for (int i = 0; i < 8; ++i) smn += mn[i];
        const float mt = smn * 0.125f; float q = 0.f;
#pragma unroll
        for (int i = 0; i < 8; ++i) { const float e = mn[i] - mt; q += m2[i] + 64.0f * e * e; }
        const float rs = 1.0f / sqrtf(q * (1.0f / 512.0f) + LN_EPS);
        f32x4 x0, x1; unpack8(*(const u32x4*)(GVb + (size_t)(lane >> 2) * PLU + (row0 + t) * 32 + (lane & 3) * 8), x0, x1);
        vn[t][0] = (x0 - mt) * rs * g0 + b0; vn[t][1] = (x1 - mt) * rs * g1 + b1;
        float* sv = F.out + O_SV + (size_t)(bd * 4 + t) * SGUW + c; *(f32x4*)sv = vn[t][0]; *(f32x4*)(sv + 4) = vn[t][1];
    }
#pragma unroll
    for (int p = 0; p < 4; ++p) {
        const float sbv = F.in[16][gg * 128 + p];
        f32x4 m0 = {sbv, sbv, sbv, sbv}, m1 = m0;
#pragma unroll
        for (int q = 0; q <= p; ++q) { const float w = F.in[15][(size_t)(gg * 128 + p) * 128 + q]; m0 += w * vn[q][0]; m1 += w * vn[q][1]; }
        f32x4 u0, u1; unpack8(*(const u32x4*)(Ub + (size_t)(lane >> 2) * PLU + (row0 + p) * 32 + (lane & 3) * 8), u0, u1);
        *(u32x4*)(AY + (row0 + p) * 768 + 256 + c) = pack8(u0 * m0, u1 * m1);
    }
}


#ifdef MK_PROBE
__device__ __constant__ int PRB_B[8] = {0, 0, 3, 5, 7, 12, 20, 31};
__device__ __constant__ int PRB_T[8] = {0, 37, 130, 1000, 2047, 255, 1290, 64};
__device__ __forceinline__ size_t probe_row(int w) { return (size_t)PRB_B[w] * SEQ + PRB_T[w]; }
__device__ __forceinline__ void probe_put(unsigned* ctl, int stage, float ref, float got) {
    float d = fabsf(ref - got) / (fabsf(ref) + 0.3f); if (!(d == d)) d = 1e30f; d = wave_max(d);
    if ((threadIdx.x & 63) == 0) atomicMax(ctl + 64 + stage, __float_as_uint(d));
}
__device__ __forceinline__ float probe_dot(const LAS float* vec, const float* W, int K, int ldw, int col) {
    float a = 0.f;
#pragma unroll 8
    for (int k = 0; k < K; ++k) a += vec[k] * W[(size_t)k * ldw + col];
    return a;
}
__device__ __forceinline__ void probe_ln_row(LAS float* vec, const bf16* rowp, const float* g, const float* b, int lane) {
    float x[16], s = 0.f;
    for (int i = 0; i < 16; ++i) { x[i] = bflo((unsigned)rowp[i * 64 + lane]); s += x[i]; }
    const float mean = wave_sum(s) * (1.0f / 1024.0f); float q = 0.f;
    for (int i = 0; i < 16; ++i) q += (x[i] - mean) * (x[i] - mean);
    const float rs = 1.0f / sqrtf(wave_sum(q) * (1.0f / 1024.0f) + LN_EPS);
    for (int i = 0; i < 16; ++i) { const int c = i * 64 + lane; vec[c] = (x[i] - mean) * rs * g[c] + b[c]; }
    asm volatile("s_waitcnt lgkmcnt(0)" ::: "memory");
}
__device__ __forceinline__ void probe_stage(Frame& F, unsigned* ctl, int stage) {
    const int lane = F.lane, w = F.wave; const size_t row = probe_row(w);
    LAS float* vec = (LAS float*)(F.lds + w * 16384);
    if (stage == 0) {
        const float* x = F.in[0] + row * DM;
        for (int i = 0; i < 16; ++i) vec[i * 64 + lane] = x[i * 64 + lane];
        asm volatile("s_waitcnt lgkmcnt(0)" ::: "memory");
        const int hc = lane * 44 + (lane * 5 + w) % 44; const float a = probe_dot(vec, F.in[8], DM, DFF, hc), b = probe_dot(vec, F.in[9], DM, DFF, hc);
        probe_put(ctl, 0, a * b / (1.0f + expf(-a)), bflo((unsigned)WSP(bf16, WS_ACT)[row * DFF + hc]));
        for (int i = 0; i < 44; ++i) vec[i * 64 + lane] = bflo((unsigned)WSP(bf16, WS_ACT)[row * DFF + i * 64 + lane]);
        asm volatile("s_waitcnt lgkmcnt(0)" ::: "memory");
        const int c = lane * 16 + (lane * 7 + w * 3) % 16; probe_put(ctl, 1, ALPHA * x[c] + 0.5f * probe_dot(vec, F.in[10], DFF, DM, c), bflo((unsigned)WSP(bf16, WS_V1)[row * DM + c]));
    } else if (stage == 1) {
        probe_ln_row(vec, WSP(bf16, WS_V1) + row * DM, F.in[6], F.in[7], lane);
        const int c = lane * 84 + (lane * 11 + w * 7) % 84; const float z = probe_dot(vec, F.in[11], DM, INW, c) + F.in[12][c];
        float ref, got;
        if (c < 768) { ref = z * QSCALE; got = bflo((unsigned)WSP(bf16, WS_Q)[row * QKVW + c]); }
        else if (c < 1536) { ref = z; got = bflo((unsigned)WSP(bf16, WS_K)[row * QKVW + c - 768]); }
        else if (c < 2304) { ref = z; got = bflo((unsigned)WSP(bf16, WS_V)[row * QKVW + c - 1536]); }
        else if (c < 2816) { ref = 0.5f * z * (1.0f + erff(z * 0.70710678f)); got = bflo((unsigned)WSP(bf16, WS_U)[row * SGUW + c - 2304]); }
        else if (c < 3328) { ref = 0.5f * z * (1.0f + erff(z * 0.70710678f)); got = bflo((unsigned)WSP(bf16, WS_GV)[row * SGUW + c - 2816]); }
        else if (c < 4352) { ref = 1.0f / (1.0f + expf(-z)); got = bflo((unsigned)WSP(bf16, WS_SA)[row * DM + c - 3328]); }
        else { ref = 1.0f / (1.0f + expf(-z)); got = bflo((unsigned)WSP(bf16, WS_SB)[row * DM + c - 4352]); }
        if (c >= 4352) {
            float csr = 0.f, bir = 0.f; unsigned wbad = 0u;
            for (int k = 0; k < DM; ++k) { const float wv = F.in[11][(size_t)k * INW + c]; csr += bfround(F.in[6][k] * wv); bir += F.in[7][k] * wv;
                if (f2bf(F.in[6][k] * wv) != (unsigned)WSP(bf16, WS_WIN)[(size_t)c * DM + k]) wbad = 1u; }
            bir += F.in[12][c];
            const float* smm = WSP(float, WS_SMALL);
            if (fabsf(csr - smm[SM_CS1 + c]) > 1e-3f) atomicOr(ctl + 98, 1u);
            if (fabsf(bir - smm[SM_B1 + c]) > 1e-3f) atomicOr(ctl + 98, 2u);
            if (wbad) atomicOr(ctl + 98, 4u);
        }
        if (c >= 4352) { float d = fabsf(ref - got) / (fabsf(ref) + 0.3f); if (d > 0.1f) { atomicOr(ctl + 96, 1u << (c & 7)); atomicOr(ctl + 97, 1u << ((c - 4352) >> 7)); } }
        { const int cls = c < 768 ? 0 : c < 1536 ? 1 : c < 2304 ? 2 : c < 2816 ? 3 : c < 3328 ? 4 : c < 4352 ? 5 : 6;
          for (int k = 0; k < 7; ++k) probe_put(ctl, 8 + k, cls == k ? ref : 0.f, cls == k ? got : 0.f); }
        probe_put(ctl, 2, ref, got);
    } else if (stage == 2) {
        const bf16* OG = WSP(bf16, WS_OG) + row * QKVW; const float* LSE = WSP(float, WS_LSE) + row * 12;
        for (int q = 0; q < 4; ++q) { const int c = lane * 4 + q, j = c >> 6;
            const float l0 = LSE[j], l1 = LSE[4 + j], l2 = LSE[8 + j], mx = fmaxf(fmaxf(l0, l1), l2), e0 = expf(l0 - mx), e1 = expf(l1 - mx), e2 = expf(l2 - mx);
            const float ref = (bflo((unsigned)OG[c]) * e0 + bflo((unsigned)OG[256 + c]) * e1 + bflo((unsigned)OG[512 + c]) * e2) / (e0 + e1 + e2);
            probe_put(ctl, 3, ref, bflo((unsigned)WSP(bf16, WS_AY)[row * 768 + c])); }
    } else if (stage == 3) {
        for (int i = 0; i < 12; ++i) vec[i * 64 + lane] = bflo((unsigned)WSP(bf16, WS_AY)[row * 768 + i * 64 + lane]);
        asm volatile("s_waitcnt lgkmcnt(0)" ::: "memory");
        const int c = lane * 16 + (lane * 7 + w * 3) % 16; const float a = probe_dot(vec, F.in[17], 256, DM, c), b = probe_dot(vec + 256, F.in[18], 512, DM, c);
        probe_put(ctl, 4, bflo((unsigned)WSP(bf16, WS_SA)[row * DM + c]) * a + bflo((unsigned)WSP(bf16, WS_SB)[row * DM + c]) * b, bflo((unsigned)WSP(bf16, WS_XB)[row * DM + c]));
    } else if (stage == 4) {
        probe_ln_row(vec, WSP(bf16, WS_V1) + row * DM, F.in[6], F.in[7], lane);
        const int c = lane * 16 + (lane * 7 + w * 3) % 16; const float h1 = vec[c];
        for (int i = 0; i < 16; ++i) vec[i * 64 + lane] = bflo((unsigned)WSP(bf16, WS_XB)[row * DM + i * 64 + lane]);
        asm volatile("s_waitcnt lgkmcnt(0)" ::: "memory");
        probe_put(ctl, 5, ALPHA * h1 + probe_dot(vec, F.in[19], DM, DM, c), bflo((unsigned)WSP(bf16, WS_V2)[row * DM + c]));
    } else if (stage == 5) {
        probe_ln_row(vec, WSP(bf16, WS_V2) + row * DM, F.in[20], F.in[21], lane);
        const int hc = lane * 44 + (lane * 5 + w) % 44; const float a = probe_dot(vec, F.in[22], DM, DFF, hc), b = probe_dot(vec, F.in[23], DM, DFF, hc);
        probe_put(ctl, 6, a * b / (1.0f + expf(-a)), bflo((unsigned)WSP(bf16, WS_ACT)[row * DFF + hc]));
    } else {
        probe_ln_row(vec, WSP(bf16, WS_V2) + row * DM, F.in[20], F.in[21], lane);
        const int c = lane * 16 + (lane * 7 + w * 3) % 16; const float h2 = vec[c];
        for (int i = 0; i < 44; ++i) vec[i * 64 + lane] = bflo((unsigned)WSP(bf16, WS_ACT)[row * DFF + i * 64 + lane]);
        asm volatile("s_waitcnt lgkmcnt(0)" ::: "memory");
        probe_put(ctl, 7, ALPHA * h2 + 0.5f * probe_dot(vec, F.in[24], DFF, DM, c), F.out[O_Y + row * DM + c]);
    }
    asm volatile("s_waitcnt lgkmcnt(0)" ::: "memory");
}
#define PROBE(stage) do { if (F.vcu == 0) probe_stage(F, ctl, stage); __syncthreads(); } while (0)
#else
#define PROBE(stage) do {} while (0)
#endif
__device__ __forceinline__ int rot_c(int rot, int G) { int c = (int)blockIdx.x + rot; while (c >= G) c -= G; return c; }
constexpr int N_PHASES = 11;
__global__ void __launch_bounds__(512, 2) mk_fwd(Args args) {
    extern __shared__ __attribute__((aligned(16))) unsigned char lds_raw[];
    Frame F;
    F.lds = (LAS unsigned char*)lds_raw;
    F.wave = __builtin_amdgcn_readfirstlane(threadIdx.x >> 6); F.lane = lane_now(); F.tid = F.wave * 64 + F.lane;
    F.G = gridDim.x; { const int bx = blockIdx.x; F.vcu = (F.G % 8 == 0) ? (bx % 8) * (F.G / 8) + bx / 8 : bx; }
    F.in = args.in; F.out = args.out; F.ws = args.ws;
    volatile LAS unsigned* MISC = (volatile LAS unsigned*)(F.lds + MISC_OFF);
    for (int u = F.tid; u < (LDS_BYTES - MISC_OFF) / 4; u += 512) ((LAS unsigned*)(F.lds + MISC_OFF))[u] = 0u;
    __syncthreads();
    unsigned* ctl = (unsigned*)(F.ws + WS_CTL);
    XcdBarrier bar; bar.bar = ctl + CW_BAR; bar.x = 0; bar.st = nullptr;
    if (MK_N_LAUNCHES == 1) bar = xcd_barrier_post(ctl + CW_BAR, MISC + 8, F.tid == 0);
    const int lo = args.ph_lo, hi = args.ph_hi;
#ifdef MK_PROBE
    if (lo >= 100) { if (F.vcu == 0) probe_stage(F, (unsigned*)(F.ws + WS_CTL), lo - 100); return; }
#endif
#ifdef MK_ONLY
#define IN(k) ((k) == MK_ONLY)
#else
#define IN(k) (lo <= (k) && (k) < hi)
#endif
#ifdef MK_STAMP_A
    u64* tsw = (u64*)(F.ws + WS_CTL) + 1024;
#define STAMP(k) do { if (blockIdx.x == 0 && F.tid == 0) tsw[(k)] = __builtin_amdgcn_s_memrealtime(); } while (0)
#else
#define STAMP(k) do {} while (0)
#endif
    STAMP(0);
#define SEAM(k) do { if (IN(k) && IN((k) + 1)) xcd_barrier(bar, F.wave == 0 && lane_now() == 0); STAMP((k) + 1); F.lane = lane_now(); F.tid = F.wave * 64 + F.lane; } while (0)
    LAS f32x2* stab = (LAS f32x2*)(F.lds + STAB_OFF);
#ifdef MK_PROBE
    const bool alt = (args.li == 99);
    if (args.li >= 200) {
        const int k = args.li - 200; const unsigned* A = (const unsigned*)(F.ws + (k == 0 ? WS_ACT : k == 1 ? WS_V1 : WS_V2)); const unsigned* B = (const unsigned*)(F.ws + (k == 0 ? 1412 * MiB : k == 1 ? 1767 * MiB : 1896 * MiB));
        const size_t n = (size_t)M * (k == 0 ? DFF : DM) / 2; unsigned cnt = 0;
        for (size_t i = (size_t)F.vcu * 512 + F.tid; i < n; i += (size_t)F.G * 512) cnt += (A[i] != B[i]) ? 1u : 0u;
        if (cnt) atomicAdd((unsigned*)(F.ws + WS_CTL) + 80 + k, cnt);
        return;
    }
#else
    const bool alt = false;
#endif
    const int gw = F.vcu * 8 + F.wave, NGW = F.G * 8;
    const int gt = F.vcu * 512 + F.tid, NGT = F.G * 512;
    float* sm = WSP(float, WS_SMALL);

    if (IN(0)) { p0_prologue(F); if (MK_DUP == 0) { __syncthreads(); p0_prologue(F); } }
    SEAM(0);
    if (IN(1)) {
        for (int i = gt; i < 22016; i += NGT) { float a = 0.f;
#pragma unroll
            for (int ks = 0; ks < 16; ++ks) a += WSP(float, WS_LSE)[ks * 22016 + i];
            if (i < 5376) sm[SM_CS1 + i] = a; else if (i < 10752) { const int rw = i - 5376; int col = rw; if (rw >= 3328) { const int q = rw - 3328, blk = q >> 8, wi = q & 255; col = (wi < 128 ? 3328 : 4352) + 128 * blk + (wi & 127); } sm[SM_B1 + rw] = a + F.in[12][col]; } else if (i < 16384) sm[SM_CS2 + i - 10752] = a; else sm[SM_B2 + i - 16384] = a; }
        pg8::Gemm g{WSP(bf16, WS_XB), WSP(bf16, WS_WF1), M, NFF2, DM}; pg8::StaticOrder S; S.init(M, NFF2, F.G, rot_c(0, F.G));
        pg8::EpiSwiglu<false> E{alt ? WSP(bf16, 1412 * MiB) : WSP(bf16, WS_ACT), nullptr, nullptr, nullptr, stab};
        pg8::gemm_phase(F.lds, g, S, E, F.wave);
        if (MK_DUP == 1) pg8::gemm_phase(F.lds, g, S, E, F.wave);
    }
    SEAM(1);
    if (IN(2)) {
        pg8::Gemm g{WSP(bf16, WS_ACT), WSP(bf16, WS_WF1D), M, DM, DFF}; pg8::StaticOrder S; S.init(M, DM, F.G, rot_c(112, F.G));
        pg8::EpiDown<0> E{F.in[0], F.in[1], WSP(bf16, WS_XB), nullptr, nullptr, nullptr, stab, alt ? WSP(bf16, 1767 * MiB) : WSP(bf16, WS_V1), nullptr, alt ? WSP(u64, WS_S3) : WSP(u64, WS_S1), 0.5f};
        pg8::gemm_phase(F.lds, g, S, E, F.wave);
        if (MK_DUP == 2) pg8::gemm_phase(F.lds, g, S, E, F.wave);
        copy_fill(F, ctl, 2, false);
    }
    SEAM(2);
    if (IN(3)) {
        pg8::Gemm g{WSP(bf16, WS_V1), WSP(bf16, WS_WIN), M, INW, DM}; pg8::StaticOrder S; S.init(M, INW, F.G, rot_c(208, F.G));
        pg8::EpiWin E{sm + SM_CS1, sm + SM_B1, WSP(u64, WS_S1), stab, WSP(bf16, WS_Q), WSP(bf16, WS_K), WSP(bf16, WS_V), WSP(bf16, WS_U), WSP(bf16, WS_GV), WSP(bf16, WS_SA), WSP(bf16, WS_SB), WSP(u64, WS_SGV), F.out};
        pg8::gemm_phase(F.lds, g, S, E, F.wave);
        if (MK_DUP == 3) pg8::gemm_phase(F.lds, g, S, E, F.wave);
    }
    SEAM(3);
    if (IN(4)) {
        LAS unsigned char* wl = F.lds + F.wave * 16384;
        const bf16* OG = WSP(bf16, WS_OG); const float* LSE = WSP(float, WS_LSE); bf16* AY = WSP(bf16, WS_AY);
        int cur_gj = -1;
        ((LAS float*)(wl + 8192))[192 + F.lane] = NEGBIG;
#pragma unroll 1
        for (int rep = 0; rep < (MK_DUP == 4 ? 2 : 1); ++rep) {
        if (MK_DUP == 4) { asm volatile("" : "+v"(F.lane), "+v"(F.tid)); cur_gj = -1; }
        int T = F.vcu, vw = F.vcu; const int sslot = F.vcu % 3;
        for (int step = 0; T < NB * 16 || vw < DEC_B * 2; ++step) {
          const bool do_s = vw < DEC_B * 2 && (step % 3 == sslot || T >= NB * 16);
          if (!do_s) {
            const int b = T >> 4, j = (T >> 2) & 3, ck = T & 3;
#pragma unroll 1
            for (int u = F.wave; u < 48; u += 8) { const int g = u >> 4, k = u & 15;
                const int blk = (g == 0) ? ck * 16 + k : (g == 1) ? (k >> 2) * 16 + 4 * ck + (k & 3) : k * 4 + ck;
                attn_unit(F, ((b * 12 + g * 4 + j) << 6) | blk, wl, cur_gj); }
            asm volatile("s_waitcnt vmcnt(0)" ::: "memory"); __syncthreads();
            int ctid = F.tid; asm volatile("" : "+v"(ctid));
#pragma unroll 1
            for (int h = 0; h < 1; ++h) {
                float l0[8], l1[8], l2[8]; u32x4 wa[8], wb[8], wc[8];
#pragma unroll
                for (int q = 0; q < 8; ++q) { const int idx = ctid + 512 * (8 * h + q); const size_t row = (size_t)b * SEQ + ck * 512 + (idx >> 3); const int c = idx & 7;
                    l0[q] = LSE[row * 12 + j]; l1[q] = LSE[row * 12 + 4 + j]; l2[q] = LSE[row * 12 + 8 + j];
                    const bf16* og = OG + (size_t)j * PLQ + row * 64 + c * 8; wa[q] = *(const u32x4*)og; wb[q] = *(const u32x4*)(og + 4 * PLQ); wc[q] = *(const u32x4*)(og + 8 * PLQ); }
#pragma unroll
                for (int q = 0; q < 8; ++q) { const int idx = ctid + 512 * (8 * h + q); const size_t row = (size_t)b * SEQ + ck * 512 + (idx >> 3); const int c = idx & 7;
                    const float mx = fmaxf(fmaxf(l0[q], l1[q]), l2[q]);
                    const float e0 = __expf(l0[q] - mx), e1 = __expf(l1[q] - mx), e2 = __expf(l2[q] - mx), inv = 1.0f / (e0 + e1 + e2);
                    f32x4 a0, a1, b0, b1, c0, c1; unpack8(wa[q], a0, a1); unpack8(wb[q], b0, b1); unpack8(wc[q], c0, c1);
                    *(u32x4*)(AY + row * 768 + j * 64 + c * 8) = pack8((a0 * e0 + b0 * e1 + c0 * e2) * inv, (a1 * e0 + b1 * e1 + c1 * e2) * inv); }
            }
            __syncthreads();
            T += F.G;
          } else {
            const int bd = vw >> 1, jh = vw & 1;
#pragma unroll 1
            for (int v = F.wave; v < (MK_DUP == 43 ? 48 : 24); v += 8) { const int v24 = v >= 24 ? v - 24 : v, g = v24 >> 3, j = 2 * jh + ((v24 >> 2) & 1), t = v24 & 3; attn_sample_task(F, ((bd * 12 + g * 4 + j) << 2) | t, wl); }
            asm volatile("s_waitcnt vmcnt(0)" ::: "memory"); __syncthreads();
            if (F.tid < 64) { const size_t row = (size_t)MP + bd * 4 + (F.tid >> 4); const int j = 2 * jh + ((F.tid >> 3) & 1), c = F.tid & 7;
                const float l0 = LSE[row * 12 + j], l1 = LSE[row * 12 + 4 + j], l2 = LSE[row * 12 + 8 + j], mx = fmaxf(fmaxf(l0, l1), l2);
                const float e0 = __expf(l0 - mx), e1 = __expf(l1 - mx), e2 = __expf(l2 - mx), inv = 1.0f / (e0 + e1 + e2);
                const bf16* og = OG + (size_t)j * PLQ + row * 64 + c * 8;
                f32x4 a0, a1, b0, b1, c0, c1; unpack8(*(const u32x4*)og, a0, a1); unpack8(*(const u32x4*)(og + 4 * PLQ), b0, b1); unpack8(*(const u32x4*)(og + 8 * PLQ), c0, c1);
                *(u32x4*)(AY + row * 768 + j * 64 + c * 8) = pack8((a0 * e0 + b0 * e1 + c0 * e2) * inv, (a1 * e0 + b1 * e1 + c1 * e2) * inv); }
            __syncthreads();
            vw += F.G;
          }
        }
        for (int su = gw; su < (MP / 128) * 16 * (MK_DUP == 42 ? 2 : 1); su += NGW) sgu_unit(F, su >= (MP / 128) * 16 ? su - (MP / 128) * 16 : su, wl);
        for (int bd = gw; bd < DEC_B; bd += NGW) sgu_sample_task(F, bd);
        if (MK_DUP == 4) { asm volatile("s_waitcnt vmcnt(0)" ::: "memory"); __syncthreads(); }
        }
    }
    SEAM(4);
    if (IN(6)) {
        pg8::Gemm g{WSP(bf16, WS_AY), WSP(bf16, WS_WOAB), M, DM, 768}; pg8::StaticOrder S; S.init(M, DM, F.G, rot_c(96, F.G));
        pg8::EpiGate E{WSP(bf16, WS_SA), WSP(bf16, WS_SB), WSP(bf16, WS_XB)};
        pg8::gemm_phase(F.lds, g, S, E, F.wave);
        if (MK_DUP == 6) pg8::gemm_phase(F.lds, g, S, E, F.wave);
        copy_fill(F, ctl, 6, false);
    }
    SEAM(6);
    if (IN(7)) {
        pg8::Gemm g{WSP(bf16, WS_XB), WSP(bf16, WS_WOUT), M, DM, DM}; pg8::StaticOrder S; S.init(M, DM, F.G, rot_c(88, F.G));
        pg8::EpiDown<1> E{nullptr, nullptr, WSP(bf16, WS_V1), F.in[6], F.in[7], WSP(u64, WS_S1), stab, alt ? WSP(bf16, 1896 * MiB) : WSP(bf16, WS_V2), nullptr, alt ? WSP(u64, WS_S3) : WSP(u64, WS_S2), 1.0f};
        pg8::gemm_phase(F.lds, g, S, E, F.wave);
        if (MK_DUP == 7) pg8::gemm_phase(F.lds, g, S, E, F.wave);
        copy_fill(F, ctl, 7, false);
    }
    SEAM(7);
    if (IN(8)) {
        pg8::Gemm g{WSP(bf16, WS_V2), WSP(bf16, WS_WF2), M, NFF2, DM}; pg8::StaticOrder S; S.init(M, NFF2, F.G, rot_c(160, F.G));
        pg8::EpiSwiglu<true> E{WSP(bf16, WS_ACT), sm + SM_CS2, sm + SM_B2, WSP(u64, WS_S2), stab};
        pg8::gemm_phase(F.lds, g, S, E, F.wave);
        if (MK_DUP == 8) pg8::gemm_phase(F.lds, g, S, E, F.wave);
    }
    SEAM(8);
    if (IN(9)) {
        pg8::Gemm g{WSP(bf16, WS_ACT), WSP(bf16, WS_WF2D), M, DM, DFF}; pg8::PanelOrder S; S.init(M, F.G, rot_c(104, F.G));
        pg8::EpiDown<3> E{nullptr, nullptr, WSP(bf16, WS_V2), F.in[20], F.in[21], WSP(u64, WS_S2), stab, nullptr, F.out + O_Y, WSP(u64, WS_S3), 0.5f,
                          F.in[25], F.in[26], ctl + CW_PCNT, (LAS f32x2*)(F.lds + MISC_OFF + 4096)};
        pg8::gemm_phase(F.lds, g, S, E, F.wave);
        F.lane = lane_now(); F.tid = F.wave * 64 + F.lane;
        copy_fill(F, ctl, 9, false);
        copy_fill(F, ctl, 10, true);
    }
#ifdef MK_STAMP_A
    STAMP(11);
    __syncthreads();
    if (blockIdx.x == 0) {
        asm volatile("s_waitcnt vmcnt(0)" ::: "memory");
        const float da = (float)(tsw[MK_STAMP_A + 1] - tsw[MK_STAMP_A]) * 0.01f, db = (float)(tsw[MK_STAMP_B + 1] - tsw[MK_STAMP_B]) * 0.01f;
        if (F.tid == 0) F.out[O_W0P] += da;
        for (int i = F.tid; i < DEC_B * DEC_T * SGUW; i += 512) F.out[O_SV + i] += db * 0.01f;
    }
#endif
#ifdef MK_PROBE
    if (IN(10) && MK_PROBE == 1 && F.vcu == 0) {
        __builtin_amdgcn_fence(__ATOMIC_ACQUIRE, "agent");
        float dmax = 0.f; for (int st = 0; st < 8; ++st) dmax = fmaxf(dmax, __uint_as_float(__hip_atomic_load(ctl + 64 + st, __ATOMIC_RELAXED, __HIP_MEMORY_SCOPE_AGENT)));
        for (int i = F.tid; i < DEC_B * DEC_T * SGUW; i += 512) F.out[O_SV + i] += 100.0f * dmax;
    }
    if (IN(10) && gt == 0) {
        __builtin_amdgcn_fence(__ATOMIC_ACQUIRE, "agent");
        float val = 0.f; float scale = 100.f;
        for (int st = 8; st < 15; ++st) { const float d = __uint_as_float(__hip_atomic_load(ctl + 64 + st, __ATOMIC_RELAXED, __HIP_MEMORY_SCOPE_AGENT));
            if (val == 0.f && d > MK_PROBE_TOL) { int ex; (void)frexpf(d, &ex); val = scale * (float)(ex + 40); } scale *= 10.f; }
        if (MK_PROBE == 2) { val = 0.f; scale = 100.f;
            for (int k = 0; k < 3; ++k) { const unsigned c = __hip_atomic_load(ctl + 80 + k, __ATOMIC_RELAXED, __HIP_MEMORY_SCOPE_AGENT);
                if (val == 0.f && c > 0u) { int ex; (void)frexpf((float)c, &ex); val = scale * (float)(ex + 40); } scale *= 10.f; } }
        if (MK_PROBE == 1) { val = 1.0e4f * (float)(100u + __hip_atomic_load(ctl + 96, __ATOMIC_RELAXED, __HIP_MEMORY_SCOPE_AGENT)); }
        if (MK_PROBE == 11) { val = 1000.0f * (float)__hip_atomic_load(ctl + 96, __ATOMIC_RELAXED, __HIP_MEMORY_SCOPE_AGENT) + 1.0e6f * (float)__hip_atomic_load(ctl + 97, __ATOMIC_RELAXED, __HIP_MEMORY_SCOPE_AGENT); }
        if (MK_PROBE == 3) { F.out[O_SV] += 1.0e6f; val = 0.f; }
        if (MK_PROBE == 4) { F.out[O_Y] += 1.0e6f; val = 0.f; }
        if (MK_PROBE == 5) { F.out[O_Y + (size_t)MP * DM] += 1.0e6f; val = 0.f; }
        F.out[O_W0P] += val;
    }
#endif
#undef IN
#undef SEAM
}

extern "C" void kernel_launch(void* const* d_in, const int* in_sizes, int n_in, void* d_out, int out_size, void* d_ws, size_t ws_size, hipStream_t stream) {
    static int grid = 0;
    if (grid == 0) {
        if (n_in != 27 || (size_t)out_size != O_END || ws_size < WS_END) { fprintf(stderr, "kernel_launch: unexpected shapes: n_in %d out %d ws %zu (need %zu)\n", n_in, out_size, ws_size, (size_t)WS_END); grid = -1; return; }
        int dev = 0, cus = 0, per_cu = 0;
        if (hipGetDevice(&dev) != hipSuccess || hipDeviceGetAttribute(&cus, hipDeviceAttributeMultiprocessorCount, dev) != hipSuccess) { grid = -1; return; }
        if (hipFuncSetAttribute((const void*)mk_fwd, hipFuncAttributeMaxDynamicSharedMemorySize, LDS_BYTES) != hipSuccess) { fprintf(stderr, "kernel_launch: hipFuncSetAttribute failed\n"); grid = -1; return; }
        if (hipOccupancyMaxActiveBlocksPerMultiprocessor(&per_cu, (const void*)mk_fwd, 512, LDS_BYTES) != hipSuccess || per_cu < 1) { fprintf(stderr, "kernel_launch: occupancy query says %d\n", per_cu); }
        (void)hipGetLastError();
        grid = cus;
    }
    if (grid < 0) return;
    (void)hipMemsetAsync((char*)d_ws + WS_CTL, 0, 65536, stream);
    Args a{};
    for (int i = 0; i < 27; ++i) a.in[i] = (const float*)d_in[i];
    a.out = (float*)d_out; a.ws = (unsigned char*)d_ws;
    const int nph = MK_PH_MAX < N_PHASES ? MK_PH_MAX : N_PHASES;
    if (MK_N_LAUNCHES == 1) {
        a.ph_lo = 0; a.ph_hi = nph; a.li = 0;
        hipLaunchKernelGGL(mk_fwd, dim3(grid), dim3(512), LDS_BYTES, stream, a);
    } else {
        for (int p = 0; p < nph; ++p) { a.ph_lo = p; a.ph_hi = p + 1; a.li = p; hipLaunchKernelGGL(mk_fwd, dim3(grid), dim3(512), LDS_BYTES, stream, a);
#ifdef MK_PROBE
            const int stage_after[11] = {-1, -1, 0, 1, -1, 2, 3, 4, 5, 6, -1};
            if (MK_PROBE == 1 && stage_after[p] >= 0) { a.ph_lo = 100 + stage_after[p]; a.ph_hi = a.ph_lo + 1; hipLaunchKernelGGL(mk_fwd, dim3(grid), dim3(512), LDS_BYTES, stream, a); }
            if (MK_PROBE == 2 && (p == 1 || p == 2 || p == 7)) { const int k = p == 1 ? 0 : p == 2 ? 1 : 2;
                a.ph_lo = p; a.ph_hi = p + 1; a.li = 99; hipLaunchKernelGGL(mk_fwd, dim3(grid), dim3(512), LDS_BYTES, stream, a);
                a.li = 200 + k; hipLaunchKernelGGL(mk_fwd, dim3(grid), dim3(512), LDS_BYTES, stream, a); }
#endif
        }
    }
}
```

```cpp
#include <hip/hip_runtime.h>
#include <cstdio>
#include <cstdint>
#define MK_PROBE_TOL 0.02f
#define MK_PROBE_WS (2025ull << 20)

#ifndef MK_N_LAUNCHES
#define MK_N_LAUNCHES 1
#endif
#ifndef MK_DUP
#define MK_DUP -1
#endif
#ifndef MK_PH_MAX
#define MK_PH_MAX 11
#endif

#define GAS __attribute__((address_space(1)))
#define LAS __attribute__((address_space(3)))
typedef unsigned short bf16;
typedef unsigned long long u64;
typedef float f32x2 __attribute__((ext_vector_type(2)));
typedef float f32x4 __attribute__((ext_vector_type(4)));
typedef float f32x16 __attribute__((ext_vector_type(16)));
typedef short bf16x8 __attribute__((ext_vector_type(8)));
typedef short s16x4 __attribute__((ext_vector_type(4)));
typedef unsigned u32x2 __attribute__((ext_vector_type(2)));
typedef unsigned u32x4 __attribute__((ext_vector_type(4)));

constexpr int DM = 1024, SEQ = 2048, NB = 32, MP = NB * SEQ, DEC_B = 128, DEC_T = 4, MS = DEC_B * DEC_T, M = MP + MS;
constexpr size_t PLQ = (size_t)(MP + MS) * 64, PLU = (size_t)(MP + MS) * 32 + 2176;
constexpr int DFF = 2816, NFF2 = 2 * DFF, INW = 5376, QKVW = 768, SGUW = 512;
constexpr float LN_EPS = 1e-5f;
constexpr float ALPHA = 1.189207115002721f;
constexpr float LOG2E = 1.4426950408889634f, LN2F = 0.6931471805599453f;
constexpr float QSCALE = 0.125f * LOG2E;
constexpr float NEGBIG = -1e30f;

constexpr size_t O_Y = 0, O_W0P = 67633152ull, O_W1P = 69730304ull, O_W2P = 78118912ull, O_W0S = 111673344ull, O_W1S = 120061952ull, O_W2S = 153616384ull, O_SV = 287834112ull, O_END = 288096256ull;

constexpr size_t MiB = 1u << 20;
constexpr size_t WS_CTL = 0, CTL_ZERO_BYTES = 1 * MiB;
constexpr size_t WS_SMALL = 1 * MiB;
constexpr size_t WS_WF1 = 2 * MiB, WS_WF1D = 13 * MiB, WS_WIN = 19 * MiB, WS_WOAB = 30 * MiB, WS_WOUT = 32 * MiB, WS_WF2 = 34 * MiB, WS_WF2D = 45 * MiB, WS_WSB = 51 * MiB;
constexpr size_t WS_S1 = 52 * MiB, WS_S2 = 61 * MiB, WS_S3 = 70 * MiB, WS_SGV = 79 * MiB, WS_LSE = 84 * MiB;
constexpr size_t WS_XB = 88 * MiB;
constexpr size_t WS_V1 = 217 * MiB, WS_V2 = 346 * MiB, WS_U = 475 * MiB, WS_GV = 540 * MiB, WS_SA = 605 * MiB, WS_SB = 734 * MiB, WS_OG = 863 * MiB, WS_AY = 960 * MiB;
constexpr size_t WS_ACT = 1057 * MiB;
constexpr size_t WS_Q = WS_ACT, WS_K = WS_ACT + 97 * MiB, WS_V = WS_ACT + 194 * MiB;
constexpr size_t WS_END = 1412 * MiB;
static_assert(12 * PLQ * 2 <= 97 * MiB && 16 * PLU * 2 <= 65 * MiB, "plane map");
static_assert((size_t)M * DFF * 2 <= 355 * MiB && (size_t)M * QKVW * 2 <= 97 * MiB && (size_t)M * DM * 2 <= 129 * MiB, "ws map");
constexpr int SM_CS1 = 0, SM_B1 = 8192, SM_CS2 = 16384, SM_B2 = 24576, SM_BT = 32768, SM_PART = 65536;

constexpr int CW_BAR = 4096;

constexpr int RING_BYTES = 131072, STAB_OFF = RING_BYTES  , MISC_OFF = STAB_OFF + 4096, LDS_BYTES = 147456;

__device__ const unsigned char T5BUCKET[3][129] = {
{0,1,2,3,4,5,6,7,8,9,10,11,12,13,14,15,16,16,16,16,16,16,17,17,17,17,17,17,17,17,18,18,18,18,18,18,18,18,18,18,19,19,19,19,19,19,19,19,19,19,19,19,19,19,20,20,20,20,20,20,20,20,20,20,20,20,20,20,20,20,20,20,20,21,21,21,21,21,21,21,21,21,21,21,21,21,21,21,21,21,21,21,21,21,21,21,21,21,21,22,22,22,22,22,22,22,22,22,22,22,22,22,22,22,22,22,22,22,22,22,22,22,22,22,22,22,22,22,22},
{0,4,8,12,16,16,17,17,18,18,19,19,19,19,20,20,20,20,20,21,21,21,21,21,21,22,22,22,22,22,22,22,22,22,23,23,23,23,23,23,23,23,23,23,23,23,24,24,24,24,24,24,24,24,24,24,24,24,24,24,24,24,25,25,25,25,25,25,25,25,25,25,25,25,25,25,25,25,25,25,25,25,25,26,26,26,26,26,26,26,26,26,26,26,26,26,26,26,26,26,26,26,26,26,26,26,26,26,26,26,26,26,26,27,27,27,27,27,27,27,27,27,27,27,27,27,27,27,27},
{0,16,18,19,20,21,21,22,22,23,23,23,24,24,24,24,25,25,25,25,25,26,26,26,26,26,26,26,26,27,27,27,27,27,27,27,27,27,27,28,28,28,28,28,28,28,28,28,28,28,28,28,29,29,29,29,29,29,29,29,29,29,29,29,29,29,29,29,29,29,30,30,30,30,30,30,30,30,30,30,30,30,30,30,30,30,30,30,30,30,30,30,30,30,30,31,31,31,31,31,31,31,31,31,31,31,31,31,31,31,31,31,31,31,31,31,31,31,31,31,31,31,31,31,31,31,31,31,31}};

__device__ __forceinline__ unsigned f2bf(float f) { unsigned u = __builtin_bit_cast(unsigned, f); return (u + 0x7fffu + ((u >> 16) & 1u)) >> 16; }
__device__ __forceinline__ unsigned pk2(float lo, float hi) { return f2bf(lo) | (f2bf(hi) << 16); }
__device__ __forceinline__ float bfround(float f) { return __uint_as_float(f2bf(f) << 16); }
typedef __bf16 bf16x2_t __attribute__((ext_vector_type(2)));
__device__ __forceinline__ unsigned cvt_pk_bf16(float lo, float hi) { const f32x2 v = {lo, hi}; const bf16x2_t b = __builtin_convertvector(v, bf16x2_t); return __builtin_bit_cast(unsigned, b); }
__device__ __forceinline__ float bflo(unsigned u) { return __uint_as_float(u << 16); }
__device__ __forceinline__ float bfhi(unsigned u) { return __uint_as_float(u & 0xffff0000u); }
__device__ __forceinline__ u32x4 pack8(f32x4 a, f32x4 b) { u32x4 w; w.x = cvt_pk_bf16(a[0], a[1]); w.y = cvt_pk_bf16(a[2], a[3]); w.z = cvt_pk_bf16(b[0], b[1]); w.w = cvt_pk_bf16(b[2], b[3]); return w; }
__device__ __forceinline__ int lane_now() { int l; asm volatile("v_mbcnt_lo_u32_b32 %0, -1, 0\n\tv_mbcnt_hi_u32_b32 %0, -1, %0" : "=v"(l)); return l & 63; }
__device__ __forceinline__ void unpack8(u32x4 w, f32x4& a, f32x4& b) { a = (f32x4){bflo(w.x), bfhi(w.x), bflo(w.y), bfhi(w.y)}; b = (f32x4){bflo(w.z), bfhi(w.z), bflo(w.w), bfhi(w.w)}; }
__device__ __forceinline__ float fast_exp2(float x) { return __builtin_amdgcn_exp2f(x); }
__device__ __forceinline__ float fast_rcp(float x) { return __builtin_amdgcn_rcpf(x); }
__device__ __forceinline__ float sigmoidf_(float x) { return fast_rcp(1.0f + fast_exp2(-x * LOG2E)); }
__device__ __forceinline__ f32x4 sigmoid4(f32x4 v) { return (f32x4){sigmoidf_(v[0]), sigmoidf_(v[1]), sigmoidf_(v[2]), sigmoidf_(v[3])}; }
__device__ __forceinline__ float gelu1(float v) {
    const float av = __builtin_fabsf(v), t = fast_rcp(av * 0.2316418882f + 1.0f);
    float q = t * 0.5307027145f + (-0.7265760135f); q = q * t + 0.7107068705f; q = q * t + (-0.142248368f); q = q * t + 0.127414796f; q = q * t;
    const float e = fast_exp2((v * v) * (-0.72134752044f));
    const float m = v * (q * e);
    return v < 0.f ? m : v - m;
}
__device__ __forceinline__ f32x4 gelu4(f32x4 v) {
    const f32x4 av = __builtin_elementwise_abs(v), dd = av * 0.2316418882f + 1.0f;
    const f32x4 t = {fast_rcp(dd[0]), fast_rcp(dd[1]), fast_rcp(dd[2]), fast_rcp(dd[3])};
    f32x4 q = t * 0.5307027145f + (-0.7265760135f); q = q * t + 0.7107068705f; q = q * t + (-0.142248368f); q = q * t + 0.127414796f; q = q * t;
    const f32x4 s2 = (v * v) * (-0.72134752044f);
    const f32x4 e = {fast_exp2(s2[0]), fast_exp2(s2[1]), fast_exp2(s2[2]), fast_exp2(s2[3])};
    const f32x4 m = v * (q * e), r = v - m;
    return (f32x4){v[0] < 0.f ? m[0] : r[0], v[1] < 0.f ? m[1] : r[1], v[2] < 0.f ? m[2] : r[2], v[3] < 0.f ? m[3] : r[3]};
}
__device__ __forceinline__ float wave_sum(float v) {
#pragma unroll
    for (int o = 1; o < 64; o <<= 1) v += __shfl_xor(v, o);
    return v;
}
__device__ __forceinline__ float wave_max(float v) {
#pragma unroll
    for (int o = 1; o < 64; o <<= 1) v = fmaxf(v, __shfl_xor(v, o));
    return v;
}

namespace pg8 {
constexpr int BM = 256, BK = 64, HALF = 128, HTB = HALF * BK * 2, STAGE_BYTES = 8 * HTB, NXCD = 8, WGM = 8;
__host__ __device__ __forceinline__ int lds_byte(int r, int c) { const int st = (r >> 4) * 2 + (c >> 5), rr = r & 15, cc = c & 31, ob = rr * 64 + cc * 2; return st * 1024 + (ob ^ (((ob >> 9) & 1) << 5)); }
__host__ __device__ __forceinline__ void stage_rc(int b, int& R, int& C) { const int st = b / 1024, sb = b % 1024, swz = sb ^ (((sb >> 9) & 1) << 5); R = (st >> 1) * 16 + swz / 64; C = (st & 1) * 32 + (swz % 64) / 2; }
__host__ __device__ __forceinline__ int perm32(int rho) { const int n = rho >> 4, i = rho & 15; return 8 * (i >> 2) + 4 * n + (i & 3); }

struct Unit { int pm, pn; };
struct Gemm { const bf16* A; const bf16* Bt; int M, N, K; };

struct StaticOrder {
    int nM, nN, nwg, G, c;
    __device__ void init(int M_, int N_, int G_, int c_) { nM = M_ / BM; nN = N_ / BM; nwg = nM * nN; G = G_; c = c_; }
    __device__ bool next(int i, Unit& u) const {
        const long L = (long)i * G + c; if (L >= nwg) return false;
        int wgid = (int)L; { const int q = nwg / NXCD, r = nwg % NXCD, xcd = wgid % NXCD, off = wgid / NXCD; wgid = (xcd < r ? xcd * (q + 1) : r * (q + 1) + (xcd - r) * q) + off; }
        const int nig = WGM * nN, gid = wgid / nig, fm = gid * WGM, gsz = (nM - fm) < WGM ? (nM - fm) : WGM;
        u.pm = fm + ((wgid % nig) % gsz); u.pn = (wgid % nig) / gsz; return true;
    }
};

struct PanelOrder {
    int nM, G, slot, tile;
    __device__ void init(int M_, int G_, int c_) { nM = M_ / BM; G = G_;
        if (G % 32 == 0) { const int R = G / 8, x = c_ & 7, k = c_ >> 3; slot = x * (R / 4) + (k >> 2); tile = k & 3; } else { slot = c_ >> 2; tile = c_ & 3; if (c_ >= (G / 4) * 4) slot = 1 << 20; } }
    __device__ bool next(int i, Unit& u) const { const int pm = i * (G / 4) + slot; if (pm >= nM) return false; u.pm = pm; u.pn = tile; return true; }
};

template <class Order, class Epi>
__device__ __forceinline__ void gemm_phase(LAS unsigned char* lds, const Gemm g, const Order& S, const Epi& E, const int wid) {
    const int lane = lane_now(), tid = wid * 64 + lane, wr = wid >> 2, wc = wid & 3, fr = lane & 15, fq = lane >> 4;
    const int K = g.K, nt = K / BK;
    unsigned voffA[2], voffB[2];
#pragma unroll
    for (int i = 0; i < 2; ++i) { int R, C; stage_rc(tid * 16 + i * 8192, R, C); const int Rb = (R & ~31) + perm32(R & 31);
        voffA[i] = (unsigned)(R * K + C) * 2u; voffB[i] = (unsigned)(Rb * K + C) * 2u; }
    const size_t kstep = (size_t)(BK * 2);
    const size_t hstep = (size_t)HALF * K * 2;
    const size_t tstep = 2 * hstep;
    const unsigned ldsw = (unsigned)wid * 1024u;
    const int aoff = lds_byte(wr * 64 + fr, fq * 8), boff = lds_byte(wc * 32 + fr, fq * 8);
#define PG8_SA(b, h) (((b) * 2 + (h)) * HTB)
#define PG8_SB(b, h) ((4 + (b) * 2 + (h)) * HTB)
#define PG8_STAGE(bufoff, gbase, voff) do { _Pragma("unroll") for (int _i = 0; _i < 2; ++_i) \
        __builtin_amdgcn_global_load_lds((const unsigned*)((const char*)(gbase) + (voff)[_i]), (LAS unsigned*)(lds + (bufoff) + ldsw + _i * 8192), 16, 0, 0); } while (0)
#define PG8_LDA(dst, b, h) do { _Pragma("unroll") for (int m = 0; m < 4; ++m) _Pragma("unroll") for (int k = 0; k < 2; ++k) dst[m][k] = *(const LAS bf16x8*)(lds + PG8_SA(b, h) + aoff + m * 2048 + k * 1024); } while (0)
#define PG8_LDB(dst, b, h) do { _Pragma("unroll") for (int n = 0; n < 2; ++n) _Pragma("unroll") for (int k = 0; k < 2; ++k) dst[n][k] = *(const LAS bf16x8*)(lds + PG8_SB(b, h) + boff + n * 2048 + k * 1024); } while (0)
#define PG8_MMA(ai, bj, At, Bt) do { __builtin_amdgcn_s_setprio(1); _Pragma("unroll") for (int m = 0; m < 4; ++m) _Pragma("unroll") for (int n = 0; n < 2; ++n) _Pragma("unroll") for (int k = 0; k < 2; ++k) \
        acc[ai][bj][m][n] = __builtin_amdgcn_mfma_f32_16x16x32_bf16(Bt[n][k], At[m][k], acc[ai][bj][m][n], 0, 0, 0); __builtin_amdgcn_s_setprio(0); } while (0)
#define PG8_WAIT_V(n) asm volatile("s_waitcnt vmcnt(" #n ")" ::: "memory")
#define PG8_WAIT_L(n) asm volatile("s_waitcnt lgkmcnt(" #n ")" ::: "memory")
#define PG8_BAR __builtin_amdgcn_s_barrier()
#define PG8_SCHED __builtin_amdgcn_sched_barrier(0)
    Unit cur, nxt; int ui = 0;
    if (!S.next(0, cur)) return;
    f32x4 acc[2][2][4][2];
#pragma unroll
    for (int a = 0; a < 2; ++a)
#pragma unroll
        for (int b = 0; b < 2; ++b)
#pragma unroll
            for (int m = 0; m < 4; ++m)
#pragma unroll
                for (int n = 0; n < 2; ++n) acc[a][b][m][n] = (f32x4){0.f, 0.f, 0.f, 0.f};
    bf16x8 At[4][2], B0[2][2], B1[2][2];
    const char* cA = (const char*)g.A + (size_t)cur.pm * tstep; const char* cB = (const char*)g.Bt + (size_t)cur.pn * tstep;
    int tpar = 0, tpm = cur.pm;
    if constexpr (Epi::HAS_PREP) E.prep(cur, 0, tid);
    PG8_STAGE(PG8_SB(0, 0), cB, voffB); PG8_STAGE(PG8_SB(0, 1), cB + hstep, voffB); PG8_STAGE(PG8_SA(0, 0), cA, voffA); PG8_STAGE(PG8_SA(0, 1), cA + hstep, voffA);
    if (wr == 1) PG8_BAR;
    PG8_WAIT_V(2); PG8_BAR;
    PG8_STAGE(PG8_SB(1, 0), cB + kstep, voffB); PG8_STAGE(PG8_SA(1, 0), cA + kstep, voffA); PG8_STAGE(PG8_SB(1, 1), cB + hstep + kstep, voffB);
    PG8_WAIT_V(6); PG8_BAR;
    for (;;) {
        const bool has_next = S.next(ui + 1, nxt);
        const char* nA = has_next ? (const char*)g.A + (size_t)nxt.pm * tstep : cA; const char* nB = has_next ? (const char*)g.Bt + (size_t)nxt.pn * tstep : cB;
        for (int t = 0; t < nt; t += 2) {
            const bool last = (t == nt - 2);
            const char* a1 = cA + (size_t)(t + 1) * kstep;
            const char* a2 = last ? nA : cA + (size_t)(t + 2) * kstep; const char* b2 = last ? nB : cB + (size_t)(t + 2) * kstep;
            const char* a3 = a2 + kstep; const char* b3 = b2 + kstep;
            if constexpr (Epi::MID_T >= 0) { if (t == Epi::MID_T) E.mid(acc, cur, wr, wc, fr, fq); }
            PG8_LDB(B0, 0, 0); PG8_LDB(B1, 0, 1); PG8_SCHED; PG8_LDA(At, 0, 0); PG8_STAGE(PG8_SA(1, 1), a1 + hstep, voffA);
            PG8_WAIT_V(8); PG8_WAIT_L(0); PG8_BAR; PG8_MMA(0, 0, At, B0); PG8_MMA(0, 1, At, B1); PG8_BAR; PG8_SCHED;
            PG8_LDA(At, 0, 1); PG8_STAGE(PG8_SB(0, 0), b2, voffB); PG8_STAGE(PG8_SB(0, 1), b2 + hstep, voffB); PG8_STAGE(PG8_SA(0, 0), a2, voffA);
            PG8_WAIT_V(8); PG8_WAIT_L(0); PG8_BAR; PG8_MMA(1, 0, At, B0); PG8_MMA(1, 1, At, B1); PG8_BAR; PG8_SCHED;
            PG8_LDB(B0, 1, 0); PG8_LDB(B1, 1, 1); PG8_SCHED; PG8_LDA(At, 1, 0); PG8_STAGE(PG8_SA(0, 1), a2 + hstep, voffA);
            PG8_WAIT_V(8); PG8_WAIT_L(0); PG8_BAR; PG8_MMA(0, 0, At, B0); PG8_MMA(0, 1, At, B1); PG8_BAR; PG8_SCHED;
            PG8_LDA(At, 1, 1); PG8_STAGE(PG8_SB(1, 0), b3, voffB); PG8_STAGE(PG8_SB(1, 1), b3 + hstep, voffB); PG8_STAGE(PG8_SA(1, 0), a3, voffA);
            PG8_WAIT_V(8); PG8_WAIT_L(0); PG8_BAR; PG8_MMA(1, 0, At, B0); PG8_MMA(1, 1, At, B1); PG8_BAR; PG8_SCHED;
        }
        if (wr == 0) PG8_BAR;
        E(acc, cur, wr, wc, fr, fq, tpar);
        if (!has_next) break;
#pragma unroll
        for (int a = 0; a < 2; ++a)
#pragma unroll
            for (int b = 0; b < 2; ++b)
#pragma unroll
                for (int m = 0; m < 4; ++m)
#pragma unroll
                    for (int n = 0; n < 2; ++n) acc[a][b][m][n] = (f32x4){0.f, 0.f, 0.f, 0.f};
        if constexpr (Epi::HAS_PREP) { if (nxt.pm != tpm) { tpar ^= 1; tpm = nxt.pm; E.prep(nxt, tpar, tid); } }
        cur = nxt; cA = nA; cB = nB; ++ui;
        if (wr == 1) PG8_BAR;
    }
    PG8_WAIT_V(0);
    PG8_BAR;
#undef PG8_SA
#undef PG8_SB
#undef PG8_STAGE
#undef PG8_LDA
#undef PG8_LDB
#undef PG8_MMA
#undef PG8_WAIT_V
#undef PG8_WAIT_L
#undef PG8_BAR
#undef PG8_SCHED
}

template <bool WT = false>
__device__ __forceinline__ void wave_row_stats(const f32x4 (&v)[2][2][4][2], u64* slots, int ns, int sidx, int row0, int fq) {
#pragma unroll
    for (int ai = 0; ai < 2; ++ai)
#pragma unroll
        for (int m = 0; m < 4; ++m) {
            float s = 0.f;
#pragma unroll
            for (int bj = 0; bj < 2; ++bj)
#pragma unroll
                for (int n = 0; n < 2; ++n) { const f32x4 x = v[ai][bj][m][n]; s += (x[0] + x[1]) + (x[2] + x[3]); }
            s += __shfl_xor(s, 16); s += __shfl_xor(s, 32);
            const float mw = s * (1.0f / 64.0f); float q = 0.f;
#pragma unroll
            for (int bj = 0; bj < 2; ++bj)
#pragma unroll
                for (int n = 0; n < 2; ++n) { const f32x4 d = v[ai][bj][m][n] - mw; q += (d[0] * d[0] + d[1] * d[1]) + (d[2] * d[2] + d[3] * d[3]); }
            q += __shfl_xor(q, 16); q += __shfl_xor(q, 32);
            if (fq == 0) { u64* sp = slots + (size_t)(row0 + ai * HALF + m * 16) * ns + sidx; const u64 val = ((u64)__float_as_uint(q) << 32) | (u64)__float_as_uint(mw);
                if constexpr (WT) __hip_atomic_store(sp, val, __ATOMIC_RELAXED, __HIP_MEMORY_SCOPE_AGENT); else *sp = val; }
        }
}
__device__ __forceinline__ void stats_table16(const u64* slots, int pm, LAS f32x2* tab, int tid) {
    asm volatile("" : "+v"(tid));
    const int row = tid >> 1, half = tid & 1;
    const u32x4* p = (const u32x4*)(slots + (size_t)(pm * 256 + row) * 16 + half * 8);
    const u32x4 a = p[0], b = p[1], c = p[2], d = p[3];
    const float mn[8] = {__uint_as_float(a.x), __uint_as_float(a.z), __uint_as_float(b.x), __uint_as_float(b.z), __uint_as_float(c.x), __uint_as_float(c.z), __uint_as_float(d.x), __uint_as_float(d.z)};
    const float m2[8] = {__uint_as_float(a.y), __uint_as_float(a.w), __uint_as_float(b.y), __uint_as_float(b.w), __uint_as_float(c.y), __uint_as_float(c.w), __uint_as_float(d.y), __uint_as_float(d.w)};
    float sm = 0.f;
#pragma unroll
    for (int i = 0; i < 8; ++i) sm += mn[i];
    sm += __shfl_xor(sm, 1);
    const float mt = sm * (1.0f / 16.0f);
    float q = 0.f;
#pragma unroll
    for (int i = 0; i < 8; ++i) { const float dd = mn[i] - mt; q += m2[i] + 64.0f * dd * dd; }
    q += __shfl_xor(q, 1);
    if (half == 0) tab[row] = (f32x2){mt, 1.0f / sqrtf(q * (1.0f / 1024.0f) + LN_EPS)};
}

__device__ __forceinline__ void stats_table16_coh(u64* slots, int pm, LAS f32x2* tab, int tid) {
    asm volatile("" : "+v"(tid));
    const int row = tid >> 1, half = tid & 1;
    u64* p = slots + (size_t)(pm * 256 + row) * 16 + half * 8;
    u64 w[8];
#pragma unroll
    for (int i = 0; i < 8; ++i) w[i] = __hip_atomic_load(p + i, __ATOMIC_RELAXED, __HIP_MEMORY_SCOPE_AGENT);
    float sm = 0.f;
#pragma unroll
    for (int i = 0; i < 8; ++i) sm += __uint_as_float((unsigned)w[i]);
    sm += __shfl_xor(sm, 1);
    const float mt = sm * (1.0f / 16.0f);
    float q = 0.f;
#pragma unroll
    for (int i = 0; i < 8; ++i) { const float dd = __uint_as_float((unsigned)w[i]) - mt; q += __uint_as_float((unsigned)(w[i] >> 32)) + 64.0f * dd * dd; }
    q += __shfl_xor(q, 1);
    if (half == 0) tab[row] = (f32x2){mt, 1.0f / sqrtf(q * (1.0f / 1024.0f) + LN_EPS)};
}

template <bool LN> struct EpiSwiglu {
    static constexpr bool HAS_PREP = LN; static constexpr int MID_T = -1;
    bf16* O; const float* cs; const float* bias; const u64* slots; LAS f32x2* stab;
    __device__ __forceinline__ void prep(const Unit& u, int par, int tid) const { stats_table16(slots, u.pm, stab + par * 256, tid); }
    __device__ __forceinline__ void mid(f32x4 (&)[2][2][4][2], const Unit&, int, int, int, int) const {}
    __device__ __forceinline__ void operator()(f32x4 (&acc)[2][2][4][2], const Unit& u, int wr, int wc, int fr, int fq, int par) const {
        asm volatile("" : "+v"(fr), "+v"(fq));
        const int ocol = u.pn * 128 + wc * 32 + 8 * fq, brow = u.pn * 256 + wc * 32 + 8 * fq;
        f32x4 csA[2], csB[2], biA[2], biB[2];
        if constexpr (LN) {
#pragma unroll
            for (int n = 0; n < 2; ++n) { csA[n] = *(const f32x4*)(cs + brow + 4 * n); csB[n] = *(const f32x4*)(cs + brow + 128 + 4 * n); biA[n] = *(const f32x4*)(bias + brow + 4 * n); biB[n] = *(const f32x4*)(bias + brow + 128 + 4 * n); }
        }
#pragma unroll
        for (int ai = 0; ai < 2; ++ai)
#pragma unroll
            for (int m = 0; m < 4; ++m) {
                const int r = ai * HALF + wr * 64 + m * 16 + fr;
                f32x4 o[2];
                f32x2 st; if constexpr (LN) st = stab[par * 256 + r];
#pragma unroll
                for (int n = 0; n < 2; ++n) {
                    f32x4 a = acc[ai][0][m][n], b = acc[ai][1][m][n];
                    if constexpr (LN) { a = (a - st.x * csA[n]) * st.y + biA[n]; b = (b - st.x * csB[n]) * st.y + biB[n]; }
                    o[n] = a * b * sigmoid4(a);
                }
                *(u32x4*)(O + (size_t)(u.pm * BM + r) * DFF + ocol) = pack8(o[0], o[1]);
            }
    }
};

template <int MODE> struct EpiDown {
    static constexpr bool HAS_PREP = (MODE != 0); static constexpr int MID_T = -1;
    const float* xp; const float* xs; const bf16* Vp; const float* g; const float* b; const u64* slots_in; LAS f32x2* stab;
    bf16* Ob; float* Of; u64* slots_out; float cacc;
    const float* g3; const float* b3; unsigned* pcnt; LAS f32x2* tab3;
    __device__ __forceinline__ void prep(const Unit& u, int par, int tid) const { stats_table16(slots_in, u.pm, stab + par * 256, tid); }
    __device__ __forceinline__ void mid(f32x4 (&)[2][2][4][2], const Unit&, int, int, int, int) const {}
    __device__ __forceinline__ void operator()(f32x4 (&acc)[2][2][4][2], const Unit& u, int wr, int wc, int fr, int fq, int par) const {
        asm volatile("" : "+v"(fr), "+v"(fq));
        u32x4 w[2][2][4];
        if constexpr (MODE == 99) {
#pragma unroll
            for (int bj = 0; bj < 2; ++bj)
#pragma unroll
                for (int ai = 0; ai < 2; ++ai)
#pragma unroll
                    for (int m = 0; m < 4; ++m) w[bj][ai][m] = *(const u32x4*)(Vp + (size_t)(u.pm * BM + ai * HALF + wr * 64 + m * 16 + fr) * DM + u.pn * BM + bj * HALF + wc * 32 + 8 * fq);
        }
#pragma unroll
        for (int bj = 0; bj < 2; ++bj) {
            const int col = u.pn * BM + bj * HALF + wc * 32 + 8 * fq;
            f32x4 g0, g1, b0, b1;
            if constexpr (MODE != 0) { g0 = *(const f32x4*)(g + col); g1 = *(const f32x4*)(g + col + 4); b0 = *(const f32x4*)(b + col); b1 = *(const f32x4*)(b + col + 4); }
#pragma unroll
            for (int ai = 0; ai < 2; ++ai)
#pragma unroll
                for (int m = 0; m < 4; ++m) w[bj][ai][m] = *(const u32x4*)(Vp + (size_t)(u.pm * BM + ai * HALF + wr * 64 + m * 16 + fr) * DM + col);
#pragma unroll
            for (int ai = 0; ai < 2; ++ai)
#pragma unroll
                for (int m = 0; m < 4; ++m) {
                    const int r = ai * HALF + wr * 64 + m * 16 + fr;
                    f32x4 r0, r1; unpack8(w[bj][ai][m], r0, r1);
                    if constexpr (MODE != 0) { const f32x2 st = stab[par * 256 + r]; r0 = (r0 - st.x) * st.y * g0 + b0; r1 = (r1 - st.x) * st.y * g1 + b1; }
                    acc[ai][bj][m][0] = ALPHA * r0 + cacc * acc[ai][bj][m][0]; acc[ai][bj][m][1] = ALPHA * r1 + cacc * acc[ai][bj][m][1];
                    asm volatile("" : "+v"(acc[ai][bj][m][0]), "+v"(acc[ai][bj][m][1]));
                }
            asm volatile("" ::: "memory");
        }
        if constexpr (MODE == 3) {
            wave_row_stats<true>(acc, slots_out, 16, u.pn * 4 + wc, u.pm * BM + wr * 64 + fr, fq);
            asm volatile("s_waitcnt vmcnt(0)" ::: "memory");
            __builtin_amdgcn_s_barrier();
            const int tid = (wr * 4 + wc) * 64 + fq * 16 + fr;
            if (tid == 0) {
                (void)__hip_atomic_fetch_add(pcnt + u.pm, 1u, __ATOMIC_RELAXED, __HIP_MEMORY_SCOPE_AGENT);
                unsigned sp = 0;
                while (__hip_atomic_load(pcnt + u.pm, __ATOMIC_RELAXED, __HIP_MEMORY_SCOPE_AGENT) < 4u) { __builtin_amdgcn_s_sleep(1); if (++sp > (1u << 20)) break; }
                __builtin_amdgcn_fence(__ATOMIC_ACQUIRE, "agent");
            }
            __builtin_amdgcn_s_barrier();
            stats_table16_coh(slots_out, u.pm, tab3, tid);
            asm volatile("s_waitcnt lgkmcnt(0)" ::: "memory");
            __builtin_amdgcn_s_barrier();
#pragma unroll
            for (int bj = 0; bj < 2; ++bj) {
                const int col = u.pn * BM + bj * HALF + wc * 32 + 8 * fq;
                const f32x4 h0 = *(const f32x4*)(g3 + col), h1 = *(const f32x4*)(g3 + col + 4), c0 = *(const f32x4*)(b3 + col), c1 = *(const f32x4*)(b3 + col + 4);
#pragma unroll
                for (int ai = 0; ai < 2; ++ai)
#pragma unroll
                    for (int m = 0; m < 4; ++m) {
                        const int r = ai * HALF + wr * 64 + m * 16 + fr; const f32x2 st = tab3[r];
                        float* y = Of + (size_t)(u.pm * BM + r) * DM + col;
                        __builtin_nontemporal_store((acc[ai][bj][m][0] - st.x) * st.y * h0 + c0, (f32x4*)y); __builtin_nontemporal_store((acc[ai][bj][m][1] - st.x) * st.y * h1 + c1, (f32x4*)(y + 4));
                    }
                asm volatile("" ::: "memory");
            }
            return;
        }
        wave_row_stats(acc, slots_out, 16, u.pn * 4 + wc, u.pm * BM + wr * 64 + fr, fq);
#pragma unroll
        for (int ai = 0; ai < 2; ++ai)
#pragma unroll
            for (int m = 0; m < 4; ++m) {
                const size_t row = (size_t)(u.pm * BM + ai * HALF + wr * 64 + m * 16 + fr);
#pragma unroll
                for (int bj = 0; bj < 2; ++bj) {
                    const int col = u.pn * BM + bj * HALF + wc * 32 + 8 * fq;
                    if constexpr (MODE == 2) { *(f32x4*)(Of + row * DM + col) = acc[ai][bj][m][0]; *(f32x4*)(Of + row * DM + col + 4) = acc[ai][bj][m][1]; }
                    else *(u32x4*)(Ob + row * DM + col) = pack8(acc[ai][bj][m][0], acc[ai][bj][m][1]);
                }
                asm volatile("" ::: "memory");
            }
    }
};

struct EpiWin {
    static constexpr bool HAS_PREP = true; static constexpr int MID_T = -1;
    const float* cs; const float* bias; const u64* slots; LAS f32x2* stab;
    bf16 *Q, *K, *V, *U, *GV, *SA, *SB; u64* sgv; float* out;
    __device__ __forceinline__ void prep(const Unit& u, int par, int tid) const { stats_table16(slots, u.pm, stab + par * 256, tid); }
    __device__ __forceinline__ void mid(f32x4 (&)[2][2][4][2], const Unit&, int, int, int, int) const {}
    template <int ACT>
    __device__ __forceinline__ void store_tile(f32x4 (&acc)[2][2][4][2], bf16* dst, int ld, int c0, const Unit& u, int wr, int wc, int fr, int fq) const {
#pragma unroll
        for (int ai = 0; ai < 2; ++ai)
#pragma unroll
            for (int m = 0; m < 4; ++m) {
                bf16* rowp = dst + (size_t)(u.pm * BM + ai * HALF + wr * 64 + m * 16 + fr) * ld + c0 + wc * 32 + 8 * fq;
#pragma unroll
                for (int bj = 0; bj < 2; ++bj) {
                    f32x4 v0 = acc[ai][bj][m][0], v1 = acc[ai][bj][m][1];
                    if (ACT == 1) { v0 = v0 * QSCALE; v1 = v1 * QSCALE; }
                    if (ACT == 2) { v0 = gelu4(v0); v1 = gelu4(v1); }
                    if (ACT == 3) { v0 = sigmoid4(v0); v1 = sigmoid4(v1); }
                    __builtin_nontemporal_store(pack8(v0, v1), (u32x4*)(rowp + bj * HALF));
                }
                asm volatile("" ::: "memory");
            }
    }
    template <int ACT>
    __device__ __forceinline__ void store_planes(f32x4 (&acc)[2][2][4][2], bf16* dst, int g, const Unit& u, int wr, int wc, int fr, int fq) const {
#pragma unroll
        for (int ai = 0; ai < 2; ++ai)
#pragma unroll
            for (int m = 0; m < 4; ++m) {
                bf16* rowp = dst + (size_t)(g * 4 + (wc >> 1)) * PLQ + (size_t)(u.pm * BM + ai * HALF + wr * 64 + m * 16 + fr) * 64 + (wc & 1) * 32 + 8 * fq;
#pragma unroll
                for (int bj = 0; bj < 2; ++bj) {
                    f32x4 v0 = acc[ai][bj][m][0], v1 = acc[ai][bj][m][1];
                    if (ACT == 1) { v0 = v0 * QSCALE; v1 = v1 * QSCALE; }
                    __builtin_nontemporal_store(pack8(v0, v1), (u32x4*)(rowp + (size_t)bj * 2 * PLQ));
                }
                asm volatile("" ::: "memory");
            }
    }
    __device__ __forceinline__ void operator()(f32x4 (&acc)[2][2][4][2], const Unit& u, int wr, int wc, int fr, int fq, int par) const {
        asm volatile("" : "+v"(fr), "+v"(fq));
#pragma unroll
        for (int bj = 0; bj < 2; ++bj) {
            const int col = u.pn * BM + bj * HALF + wc * 32 + 8 * fq;
            const f32x4 c0 = *(const f32x4*)(cs + col), c1 = *(const f32x4*)(cs + col + 4), b0 = *(const f32x4*)(bias + col), b1 = *(const f32x4*)(bias + col + 4);
#pragma unroll
            for (int ai = 0; ai < 2; ++ai)
#pragma unroll
                for (int m = 0; m < 4; ++m) {
                    const f32x2 st = stab[par * 256 + ai * HALF + wr * 64 + m * 16 + fr];
                    const float k2 = -st.x * st.y;
                    acc[ai][bj][m][0] = acc[ai][bj][m][0] * st.y + (c0 * k2 + b0); acc[ai][bj][m][1] = acc[ai][bj][m][1] * st.y + (c1 * k2 + b1);
                    asm volatile("" : "+v"(acc[ai][bj][m][0]), "+v"(acc[ai][bj][m][1]));
                }
            asm volatile("" ::: "memory");
        }
        const int pn = u.pn;
        if (pn < 3) { store_planes<1>(acc, Q, pn, u, wr, wc, fr, fq); }
        else if (pn < 9) {
            const int kv = pn >= 6 ? 1 : 0, g = pn - 3 - 3 * kv, W = 128 << (2 * g);
            store_planes<0>(acc, kv ? V : K, g, u, wr, wc, fr, fq);
            const size_t obase_p = (g == 0) ? O_W0P : (g == 1) ? O_W1P : O_W2P, obase_s = (g == 0) ? O_W0S : (g == 1) ? O_W1S : O_W2S;
#pragma unroll
            for (int ai = 0; ai < 2; ++ai)
#pragma unroll
                for (int m = 0; m < 4; ++m) {
                    const int r = ai * HALF + wr * 64 + m * 16 + fr;
                    float* dst = nullptr;
                    if (u.pm < MP / BM) { const int b = u.pm >> 3, t = (u.pm & 7) * 256 + r, p = t - (SEQ - W); if (p >= 0) dst = out + obase_p + ((size_t)(b * W + p) * 2 + kv) * 256; }
                    else { const int ms = (u.pm - MP / BM) * 256 + r, bd = ms >> 2, tt = ms & 3; dst = out + obase_s + ((size_t)(bd * W + W - 4 + tt) * 2 + kv) * 256; }
                    if (dst) {
#pragma unroll
                        for (int bj = 0; bj < 2; ++bj) { float* d2 = dst + bj * HALF + wc * 32 + 8 * fq; __builtin_nontemporal_store(acc[ai][bj][m][0], (f32x4*)d2); __builtin_nontemporal_store(acc[ai][bj][m][1], (f32x4*)(d2 + 4)); }
                    }
                    asm volatile("" ::: "memory");
                }
        }
        else if (pn < 11) {
#pragma unroll
            for (int ai = 0; ai < 2; ++ai)
#pragma unroll
                for (int m = 0; m < 4; ++m) {
                    bf16* rowp = U + (size_t)((pn - 9) * 8 + wc) * PLU + (size_t)(u.pm * BM + ai * HALF + wr * 64 + m * 16 + fr) * 32 + 8 * fq;
#pragma unroll
                    for (int bj = 0; bj < 2; ++bj) __builtin_nontemporal_store(pack8(gelu4(acc[ai][bj][m][0]), gelu4(acc[ai][bj][m][1])), (u32x4*)(rowp + (size_t)bj * 4 * PLU));
                    asm volatile("" ::: "memory");
                }
        }
        else if (pn < 13) {
            bf16* dstb = GV + (size_t)((pn - 11) * 8 + wc) * PLU + 8 * fq; const int sidx = (pn - 11) * 4 + wc;
#pragma unroll
            for (int ai = 0; ai < 2; ++ai)
#pragma unroll
                for (int m = 0; m < 4; ++m) {
                    const size_t row = (size_t)(u.pm * BM + ai * HALF + wr * 64 + m * 16 + fr);
                    f32x4 t[2][2]; float s = 0.f;
#pragma unroll
                    for (int bj = 0; bj < 2; ++bj)
#pragma unroll
                        for (int n = 0; n < 2; ++n) { t[bj][n] = gelu4(acc[ai][bj][m][n]); s += (t[bj][n][0] + t[bj][n][1]) + (t[bj][n][2] + t[bj][n][3]); }
                    s += __shfl_xor(s, 16); s += __shfl_xor(s, 32);
                    const float mw = s * (1.0f / 64.0f); float q = 0.f;
#pragma unroll
                    for (int bj = 0; bj < 2; ++bj)
#pragma unroll
                        for (int n = 0; n < 2; ++n) { const f32x4 d = t[bj][n] - mw; q += (d[0] * d[0] + d[1] * d[1]) + (d[2] * d[2] + d[3] * d[3]); }
                    q += __shfl_xor(q, 16); q += __shfl_xor(q, 32);
                    if (fq == 0) sgv[row * 8 + sidx] = ((u64)__float_as_uint(q) << 32) | (u64)__float_as_uint(mw);
#pragma unroll
                    for (int bj = 0; bj < 2; ++bj) __builtin_nontemporal_store(pack8(t[bj][0], t[bj][1]), (u32x4*)(dstb + row * 32 + (size_t)bj * 4 * PLU));
                    asm volatile("" ::: "memory");
                }
        }
        else {
            const int p = pn - 13, wave = wr * 4 + wc, ln = fq * 16 + fr;
#pragma unroll
            for (int ai = 0; ai < 2; ++ai)
#pragma unroll
                for (int m = 0; m < 4; ++m) {
                    const size_t idx = ((((size_t)(u.pm * 8 + p) * 8 + wave) * 8 + (ai * 4 + m)) * 64 + ln) * 8;
                    f32x4 r[2], sb[2];
#pragma unroll
                    for (int n = 0; n < 2; ++n) {
                        const f32x4 xa = acc[ai][0][m][n] * (-LOG2E), xb = acc[ai][1][m][n] * (-LOG2E);
                        f32x4 ea = {fast_exp2(xa[0]), fast_exp2(xa[1]), fast_exp2(xa[2]), fast_exp2(xa[3])}, eb = {fast_exp2(xb[0]), fast_exp2(xb[1]), fast_exp2(xb[2]), fast_exp2(xb[3])};
                        ea = __builtin_elementwise_min(ea, (f32x4){1e30f, 1e30f, 1e30f, 1e30f}) + 1.0f; eb = __builtin_elementwise_min(eb, (f32x4){1e30f, 1e30f, 1e30f, 1e30f}) + 1.0f;
                        const f32x4 ia = {fast_rcp(ea[0]), fast_rcp(ea[1]), fast_rcp(ea[2]), fast_rcp(ea[3])};
                        sb[n] = (f32x4){fast_rcp(eb[0]), fast_rcp(eb[1]), fast_rcp(eb[2]), fast_rcp(eb[3])}; r[n] = eb * ia; }
                    __builtin_nontemporal_store(pack8(r[0], r[1]), (u32x4*)(SA + idx)); __builtin_nontemporal_store(pack8(sb[0], sb[1]), (u32x4*)(SB + idx));
                    asm volatile("" ::: "memory");
                }
        }
    }
};

struct EpiGate {
    static constexpr bool HAS_PREP = false; static constexpr int MID_T = 4;
    const bf16* SA; const bf16* SB; bf16* T;
    __device__ __forceinline__ void prep(const Unit&, int, int) const {}
    __device__ __forceinline__ void mid(f32x4 (&acc)[2][2][4][2], const Unit& u, int wr, int wc, int fr, int fq) const {
        asm volatile("" : "+v"(fr), "+v"(fq));
        const int wave = wr * 4 + wc, ln = fq * 16 + fr;
        u32x4 w[2][8];
#pragma unroll
        for (int bj = 0; bj < 2; ++bj)
#pragma unroll
            for (int j = 0; j < 8; ++j) w[bj][j] = *(const u32x4*)(SA + ((((size_t)(u.pm * 8 + 2 * u.pn + bj) * 8 + wave) * 8 + j) * 64 + ln) * 8);
#pragma unroll
        for (int bj = 0; bj < 2; ++bj)
#pragma unroll
            for (int j = 0; j < 8; ++j) { const int ai = j >> 2, m = j & 3; f32x4 r0, r1; unpack8(w[bj][j], r0, r1); acc[ai][bj][m][0] *= r0; acc[ai][bj][m][1] *= r1; asm volatile("" : "+v"(acc[ai][bj][m][0]), "+v"(acc[ai][bj][m][1])); }
        asm volatile("" ::: "memory");
    }
    __device__ __forceinline__ void operator()(f32x4 (&acc)[2][2][4][2], const Unit& u, int wr, int wc, int fr, int fq, int) const {
        asm volatile("" : "+v"(fr), "+v"(fq));
        const int wave = wr * 4 + wc, ln = fq * 16 + fr;
        u32x4 w[2][8];
#pragma unroll
        for (int bj = 0; bj < 2; ++bj)
#pragma unroll
            for (int j = 0; j < 8; ++j) w[bj][j] = *(const u32x4*)(SB + ((((size_t)(u.pm * 8 + 2 * u.pn + bj) * 8 + wave) * 8 + j) * 64 + ln) * 8);
#pragma unroll
        for (int bj = 0; bj < 2; ++bj)
#pragma unroll
            for (int j = 0; j < 8; ++j) { const int ai = j >> 2, m = j & 3; f32x4 b0, b1; unpack8(w[bj][j], b0, b1);
                *(u32x4*)(T + (size_t)(u.pm * BM + ai * HALF + wr * 64 + m * 16 + fr) * DM + u.pn * BM + bj * HALF + wc * 32 + 8 * fq) = pack8(acc[ai][bj][m][0] * b0, acc[ai][bj][m][1] * b1); }
        asm volatile("" ::: "memory");
    }
};
}

#define XB_TMO      128
#define XB_XCNT(j)  (256  + 64 * (j))
#define XB_XSUB(j)  (1280 + 64 * (j))
#define XB_XGEN(j)  (2304 + 64 * (j))
#define XB_TOP      3328
#define XB_TOPGEN   3392
#define XCD_BAR_WORDS 3456
#define XB_SPIN_CAP (1u << 18)
__device__ __forceinline__ unsigned xb_ld(unsigned* p)              { return __hip_atomic_load(p, __ATOMIC_RELAXED, __HIP_MEMORY_SCOPE_AGENT); }
__device__ __forceinline__ unsigned xb_add(unsigned* p, unsigned v) { return __hip_atomic_fetch_add(p, v, __ATOMIC_RELAXED, __HIP_MEMORY_SCOPE_AGENT); }
__device__ __forceinline__ unsigned xb_xcc_id() { return (unsigned)__builtin_amdgcn_s_getreg((3 << 11) | 20) & 0xFu; }
#define XB_SPIN(cond, bar) do { unsigned _sp = 0; while (cond) { __builtin_amdgcn_s_sleep(1); \
    if ((++_sp & 255u) == 0u) { if (xb_ld(&(bar)[XB_TMO])) break; if (_sp > XB_SPIN_CAP) { atomicAdd(&(bar)[XB_TMO], 1u); break; } } } } while (0)
struct XcdBarrier { unsigned* bar; unsigned x; volatile LAS unsigned* st; };
__device__ __forceinline__ XcdBarrier xcd_barrier_post(unsigned* bar, volatile LAS unsigned* st, const bool leader) {
    XcdBarrier b; b.bar = bar; b.x = xb_xcc_id(); b.st = st;
    if (leader) (void)xb_add(&bar[XB_XCNT(b.x)], 1u);
    return b;
}
__device__ __forceinline__ void xcd_barrier_complete(unsigned* bar, unsigned x, unsigned& nloc, unsigned& nx) {
    const unsigned G = gridDim.x * gridDim.y * gridDim.z;
    unsigned sum, cnt, mine, sp = 0u;
    for (;;) {
        sum = 0u; cnt = 0u; mine = 0u;
#pragma unroll
        for (unsigned j = 0; j < 16; ++j) { const unsigned c = xb_ld(&bar[XB_XCNT(j)]); sum += c; cnt += (c > 0u) ? 1u : 0u; mine = (j == x) ? c : mine; }
        if (sum == G) break;
        __builtin_amdgcn_s_sleep(1);
        if ((++sp & 255u) == 0u) { if (xb_ld(&bar[XB_TMO])) break; if (sp > XB_SPIN_CAP) { atomicAdd(&bar[XB_TMO], 1u); break; } }
    }
    nloc = mine > 0u ? mine : 1u; nx = cnt > 0u ? cnt : 1u;
}
__device__ __forceinline__ void xcd_barrier(const XcdBarrier& b, const bool leader) {
    asm volatile("s_waitcnt vmcnt(0)" ::: "memory");
    __syncthreads();
    if (leader) {
        unsigned* bar = b.bar;
        __builtin_amdgcn_s_waitcnt(0);
        unsigned nloc = b.st[0], nx = b.st[1];
        if (nloc == 0u) { xcd_barrier_complete(bar, b.x, nloc, nx); b.st[0] = nloc; b.st[1] = nx; }
        const unsigned old = xb_add(&bar[XB_XSUB(b.x)], 1u);
        const unsigned gen = old / nloc;
        if (old + 1u == (gen + 1u) * nloc) {
            __builtin_amdgcn_fence(__ATOMIC_RELEASE, "agent");
            asm volatile("s_waitcnt vmcnt(0)" ::: "memory");
            const unsigned og = xb_add(&bar[XB_TOP], 1u);
            const unsigned tg = og / nx;
            if (og + 1u == (tg + 1u) * nx) xb_add(&bar[XB_TOPGEN], 1u);
            else XB_SPIN(xb_ld(&bar[XB_TOPGEN]) == tg, bar);
            __builtin_amdgcn_fence(__ATOMIC_ACQUIRE, "agent");
            xb_add(&bar[XB_XGEN(b.x)], 1u);
            asm volatile("s_waitcnt vmcnt(0)" ::: "memory");
        } else {
            XB_SPIN(xb_ld(&bar[XB_XGEN(b.x)]) == gen, bar);
            __builtin_amdgcn_fence(__ATOMIC_ACQUIRE, "agent");
            asm volatile("s_waitcnt vmcnt(0)" ::: "memory");
        }
    }
    __syncthreads();
}

struct Args { const float* in[27]; float* out; unsigned char* ws; int ph_lo, ph_hi, li, pad; };
struct Frame {
    LAS unsigned char* lds; int tid, lane, wave, vcu, G;
    const float* const* in; float* out; unsigned char* ws;
};
#define WSP(T, off) ((T*)(F.ws + (off)))

__device__ __forceinline__ void p0_tr_item(const float* W, int N, bf16* WT, int ldk, int koff, int dst_row0, const float* g, LAS float* scr, int k0, int n0, int lane,
                                           float* part = nullptr, int bias_off = 0, const float* bvec = nullptr) {
    f32x4 w[8]; float gk[8], bk[8];
#pragma unroll
    for (int i = 0; i < 8; ++i) { const int kk = 8 * i + (lane >> 3); w[i] = *(const f32x4*)(W + (size_t)(k0 + kk) * N + n0 + 4 * (lane & 7)); gk[i] = g ? g[k0 + kk] : 1.0f; bk[i] = part ? bvec[k0 + kk] : 0.f; }
    f32x4 cs = {0.f, 0.f, 0.f, 0.f}, bi = cs;
#pragma unroll
    for (int i = 0; i < 8; ++i) { const int kk = 8 * i + (lane >> 3); LAS float* d = scr + kk * 33 + 4 * (lane & 7); f32x4 v = w[i]; if (g) v = v * gk[i]; d[0] = v[0]; d[1] = v[1]; d[2] = v[2]; d[3] = v[3];
        if (part) { cs += (f32x4){bfround(v[0]), bfround(v[1]), bfround(v[2]), bfround(v[3])}; bi += w[i] * bk[i]; } }
    if (part) {
#pragma unroll
        for (int c = 0; c < 4; ++c) { cs[c] += __shfl_xor(cs[c], 8); cs[c] += __shfl_xor(cs[c], 16); cs[c] += __shfl_xor(cs[c], 32); bi[c] += __shfl_xor(bi[c], 8); bi[c] += __shfl_xor(bi[c], 16); bi[c] += __shfl_xor(bi[c], 32); }
        if (lane < 8) { *(f32x4*)(part + 4 * lane) = cs; *(f32x4*)(part + bias_off + 4 * lane) = bi; }
    }
    asm volatile("s_waitcnt lgkmcnt(0)" ::: "memory");
    const int c = lane & 7;
#pragma unroll
    for (int j = 0; j < 4; ++j) { const int n = (lane >> 3) + 8 * j; const LAS float* s = scr + (8 * c) * 33 + n;
        u32x4 o; o.x = pk2(s[0 * 33], s[1 * 33]); o.y = pk2(s[2 * 33], s[3 * 33]); o.z = pk2(s[4 * 33], s[5 * 33]); o.w = pk2(s[6 * 33], s[7 * 33]);
        *(u32x4*)(WT + (size_t)(dst_row0 + n) * ldk + koff + k0 + 8 * c) = o; }
    asm volatile("s_waitcnt lgkmcnt(0)" ::: "memory");
}
__device__ __forceinline__ int swiglu_row(int n, int sel) { return 256 * (n >> 7) + (n & 127) + sel * 128; }
__device__ __forceinline__ int win_row(int n) { if (n < 3328) return n; const int q = n - 3328; return q < 1024 ? 3328 + 256 * (q >> 7) + (q & 127) : 3328 + 256 * ((q - 1024) >> 7) + 128 + (q & 127); }

__device__ __forceinline__ void p0_prologue(Frame& F) {
    const int gw = F.vcu * 8 + F.wave, NGW = F.G * 8, lane = F.lane;
    const int gt = F.vcu * 512 + F.tid, NGT = F.G * 512;
    float* sm = WSP(float, WS_SMALL);
    float* part16 = WSP(float, WS_LSE);
    LAS float* scr = (LAS float*)(F.lds + F.wave * 16384);
    for (int it = gw; it < 12032; it += NGW) {
        int r = it;
        if (r < 2816) { const int sel = r / 1408, q = r % 1408, kb = q / 88, nb = q % 88; p0_tr_item(sel ? F.in[9] : F.in[8], DFF, WSP(bf16, WS_WF1), DM, 0, swiglu_row(nb * 32, sel), nullptr, scr, kb * 64, nb * 32, lane); continue; } r -= 2816;
        if (r < 1408) { const int kb = r / 32, nb = r % 32; p0_tr_item(F.in[10], DM, WSP(bf16, WS_WF1D), DFF, 0, nb * 32, nullptr, scr, kb * 64, nb * 32, lane); continue; } r -= 1408;
        if (r < 2688) { const int kb = r / 168, nb = r % 168; p0_tr_item(F.in[11], INW, WSP(bf16, WS_WIN), DM, 0, win_row(nb * 32), F.in[6], scr, kb * 64, nb * 32, lane, part16 + kb * 22016 + win_row(nb * 32), 5376, F.in[7]); continue; } r -= 2688;
        if (r < 128) { const int kb = r / 32, nb = r % 32; p0_tr_item(F.in[17], DM, WSP(bf16, WS_WOAB), 768, 0, nb * 32, nullptr, scr, kb * 64, nb * 32, lane); continue; } r -= 128;
        if (r < 256) { const int kb = r / 32, nb = r % 32; p0_tr_item(F.in[18], DM, WSP(bf16, WS_WOAB), 768, 256, nb * 32, nullptr, scr, kb * 64, nb * 32, lane); continue; } r -= 256;
        if (r < 512) { const int kb = r / 32, nb = r % 32; p0_tr_item(F.in[19], DM, WSP(bf16, WS_WOUT), DM, 0, nb * 32, nullptr, scr, kb * 64, nb * 32, lane); continue; } r -= 512;
        if (r < 2816) { const int sel = r / 1408, q = r % 1408, kb = q / 88, nb = q % 88; p0_tr_item(sel ? F.in[23] : F.in[22], DFF, WSP(bf16, WS_WF2), DM, 0, swiglu_row(nb * 32, sel), F.in[20], scr, kb * 64, nb * 32, lane, part16 + kb * 22016 + 10752 + swiglu_row(nb * 32, sel), 5632, F.in[21]); continue; } r -= 2816;
        { const int kb = r / 32, nb = r % 32; p0_tr_item(F.in[24], DM, WSP(bf16, WS_WF2D), DFF, 0, nb * 32, nullptr, scr, kb * 64, nb * 32, lane); }
    }
    for (int i = gt; i < 12 * 192; i += NGT) { const int hj = i / 192, x = i % 192, rel = x - 32, g = hj >> 2;
        sm[SM_BT + i] = (rel >= 0 && rel <= 128) ? F.in[5][(int)T5BUCKET[g][rel] * 12 + hj] * LOG2E : NEGBIG; }
    for (int i = gt; i < 4 * 128 * 128; i += NGT) { const int p = (i >> 7) & 127, q = i & 127; WSP(bf16, WS_WSB)[i] = (bf16)(q <= p ? f2bf(F.in[15][i]) : 0u); }
    for (int i0 = gt; i0 < M * 128; i0 += 4 * NGT) {
        f32x4 a[4], b[4];
#pragma unroll
        for (int k = 0; k < 4; ++k) { const int i = i0 + k * NGT; if (i < M * 128) { const int row = i >> 7, c8 = i & 127;
            const float* src = (row < MP ? F.in[0] + (size_t)row * DM : F.in[1] + (size_t)(row - MP) * DM) + c8 * 8;
            a[k] = __builtin_nontemporal_load((const f32x4*)src); b[k] = __builtin_nontemporal_load((const f32x4*)(src + 4)); } }
#pragma unroll
        for (int k = 0; k < 4; ++k) { const int i = i0 + k * NGT; if (i < M * 128) { const int row = i >> 7, c8 = i & 127;
            *(u32x4*)(WSP(bf16, WS_XB) + (size_t)row * DM + c8 * 8) = pack8(a[k], b[k]); } }
    }
}

constexpr int CW_CQ_HEAD = 8192, CW_DONE = 9216, CW_PCNT = 10240, CQ_PER_X = 669;
template <int G_> __device__ __forceinline__ void copy_chunk_g(const f32x4* src, f32x4* dst, unsigned f0, int tid) {
    constexpr unsigned W = 128u << (2 * G_), per = (W - 4u) * 128u;
#pragma unroll
    for (int bt = 0; bt < 2; ++bt) { f32x4 v[8]; size_t o[8];
#pragma unroll
        for (int j = 0; j < 8; ++j) { const unsigned f = f0 + (unsigned)((bt * 8 + j) * 512 + tid), bd = f / per, off = f - bd * per; o[j] = (size_t)bd * (W * 128u) + off; v[j] = __builtin_nontemporal_load(src + o[j] + 512); }
#pragma unroll
        for (int j = 0; j < 8; ++j) __builtin_nontemporal_store(v[j], dst + o[j]);
    }
}
__device__ __forceinline__ void copy_chunk(Frame& F, int c) {
    if (c < 248) copy_chunk_g<0>((const f32x4*)F.in[2], (f32x4*)(F.out + O_W0S), (unsigned)c * 8192u, F.tid);
    else if (c < 1264) copy_chunk_g<1>((const f32x4*)F.in[3], (f32x4*)(F.out + O_W1S), (unsigned)(c - 248) * 8192u, F.tid);
    else copy_chunk_g<2>((const f32x4*)F.in[4], (f32x4*)(F.out + O_W2S), (unsigned)(c - 1264) * 8192u, F.tid);
}
__device__ __forceinline__ void copy_fill(Frame& F, unsigned* ctl, int phase, bool drain) {
    volatile LAS int* slot = (volatile LAS int*)(F.lds + MISC_OFF + 64);
    const unsigned x = xb_xcc_id() & 7u;
    __syncthreads();
    if (F.tid == 0 && !drain) (void)__hip_atomic_fetch_add(ctl + CW_DONE + 64 * phase, 1u, __ATOMIC_RELAXED, __HIP_MEMORY_SCOPE_AGENT);
    for (unsigned q = 0; q < (drain ? 8u : 1u); ++q) {
        const unsigned xq = (x + q) & 7u;
        for (;;) {
            if (F.tid == 0) { int c = -1;
                if (drain || __hip_atomic_load(ctl + CW_DONE + 64 * phase, __ATOMIC_RELAXED, __HIP_MEMORY_SCOPE_AGENT) < (unsigned)F.G) {
                    const unsigned h = __hip_atomic_fetch_add(ctl + CW_CQ_HEAD + 64 * xq, 1u, __ATOMIC_RELAXED, __HIP_MEMORY_SCOPE_AGENT); if (h < (unsigned)CQ_PER_X) c = (int)(xq * CQ_PER_X + h); }
                *slot = c; }
            __syncthreads();
            const int c = *slot;
            __syncthreads();
            if (c < 0) break;
            copy_chunk(F, c);
        }
    }
}

__device__ __forceinline__ f32x16 mfma32(bf16x8 a, bf16x8 b, f32x16 c) { return __builtin_amdgcn_mfma_f32_32x32x16_bf16(a, b, c, 0, 0, 0); }
__device__ __forceinline__ s16x4 trld(const LAS unsigned char* p) { return __builtin_bit_cast(s16x4, __builtin_amdgcn_ds_read_tr16_b64_v4i16((LAS s16x4*)p)); }

__device__ __forceinline__ void attn_unit(Frame& F, int au, LAS unsigned char* wl, int& cur_gj) {
    int lane = F.lane; asm volatile("" : "+v"(lane));
    const int r32 = lane & 31, hi = lane >> 5;
    const int blk = au & 63, bg = au >> 6, gj = bg % 12, b = bg / 12, g = gj >> 2, j = gj & 3;
    const int dsh = 2 * g, d = 1 << dsh, bpr = 64 >> dsh, r = blk >> (6 - dsh), m0 = (blk & (bpr - 1)) * 32;
    const size_t rowbase = (size_t)b * SEQ; const int hc = g * 256 + j * 64;
    const bf16* Qb = WSP(bf16, WS_Q); const bf16* Kb = WSP(bf16, WS_K); const bf16* Vb = WSP(bf16, WS_V);
    LAS float* tab = (LAS float*)(wl + 8192);
    if (gj != cur_gj) { const float* bt = WSP(float, WS_SMALL) + SM_BT + gj * 192;
#pragma unroll
        for (int i = 0; i < 3; ++i) tab[lane + 64 * i] = bt[lane + 64 * i];
        cur_gj = gj; }
    const int tq = (m0 + r32) * d + r;
    const unsigned voff = (unsigned)((lane >> 3) * d * 64 + (lane & 7) * 8);
    const long ub = (long)gj * (long)PLQ + (long)(rowbase + r) * 64;
#define AT_LD4(dst_, base_, sp_) do { _Pragma("unroll") for (int ii_ = 0; ii_ < 4; ++ii_) { const int sp__ = (sp_) + 8 * ii_; (dst_)[ii_] = *(const u32x4*)((base_) + ub + (long)((sp__ < 0 ? 0 : sp__) * d) * 64 + voff); } } while (0)
    const int i0 = m0 >= 128 ? 0 : (128 - m0) >> 5;
    LAS unsigned char* kb = wl + 12288;
    const int wro = (lane >> 3) * 128 + (((lane & 7) ^ ((lane >> 3) & 7)) << 4);
    u32x4 kr[5][4];
    bf16x8 qf[4];
    {
        u32x4 qr[4];
        AT_LD4(qr, Qb, m0);
        asm volatile("" ::: "memory");
#pragma unroll
        for (int i = 0; i < 5; ++i) AT_LD4(kr[i], Kb, m0 - 128 + 32 * i);
#pragma unroll
        for (int ii = 0; ii < 4; ++ii) *(LAS u32x4*)(kb + wro + 1024 * ii) = qr[ii];
#pragma unroll
        for (int s = 0; s < 4; ++s) qf[s] = *(const LAS bf16x8*)(kb + r32 * 128 + (((2 * s + hi) ^ (r32 & 7)) << 4));
    }
    f32x16 sc[5];
#pragma unroll
    for (int i = 0; i < 5; ++i) {
#pragma unroll
        for (int ii = 0; ii < 4; ++ii) *(LAS u32x4*)(kb + wro + 1024 * ii) = kr[i][ii];
        AT_LD4(kr[i], Vb, m0 - 128 + 32 * i);
        bf16x8 kf[4];
#pragma unroll
        for (int s = 0; s < 4; ++s) kf[s] = *(const LAS bf16x8*)(kb + r32 * 128 + (((2 * s + hi) ^ (r32 & 7)) << 4));
        f32x16 a = {};
#pragma unroll
        for (int s = 0; s < 4; ++s) a = mfma32(kf[s], qf[s], a);
        const LAS float* tb = tab + (r32 - 4 * hi + 4) + (i >= i0 ? 156 - 32 * i : 192 + 27);
#pragma unroll
        for (int R = 0; R < 16; ++R) a[R] += tb[-((R & 3) + 8 * (R >> 2))];
        sc[i] = a;
    }
    float mx = NEGBIG;
#pragma unroll
    for (int i = 0; i < 5; ++i)
#pragma unroll
        for (int R = 0; R < 16; ++R) mx = fmaxf(mx, sc[i][R]);
    mx = fmaxf(mx, __shfl_xor(mx, 32));
    float l = 0.f;
#pragma unroll
    for (int i = 0; i < 5; ++i)
#pragma unroll
        for (int R = 0; R < 16; ++R) { const float p = fast_exp2(sc[i][R] - mx); sc[i][R] = p; l += p; }
    l += __shfl_xor(l, 32);
    f32x16 o0 = {}, o1 = {};
    const int vaoff = (4 * hi + ((lane & 15) >> 2)) * 64 + ((lane >> 4) & 1) * 32 + (lane & 3) * 8;
    const int vwo = ((lane & 7) >> 2) * 2048 + (lane >> 3) * 64 + (lane & 3) * 16;
#pragma unroll
    for (int i = 0; i < 5; ++i) {
        LAS unsigned char* vb = wl + (i & 1) * 4096;
        {
#pragma unroll
            for (int ii = 0; ii < 4; ++ii) *(LAS u32x4*)(vb + vwo + 512 * ii) = kr[i][ii];
            const LAS unsigned char* va = vb + vaoff;
#pragma unroll
            for (int s = 0; s < 2; ++s) {
                u32x4 pw; pw.x = cvt_pk_bf16(sc[i][8 * s + 0], sc[i][8 * s + 1]); pw.y = cvt_pk_bf16(sc[i][8 * s + 2], sc[i][8 * s + 3]); pw.z = cvt_pk_bf16(sc[i][8 * s + 4], sc[i][8 * s + 5]); pw.w = cvt_pk_bf16(sc[i][8 * s + 6], sc[i][8 * s + 7]);
                const bf16x8 pb = __builtin_bit_cast(bf16x8, pw);
                { const s16x4 lo = trld(va + s * 1024), h2 = trld(va + s * 1024 + 512); const bf16x8 A = {lo[0], lo[1], lo[2], lo[3], h2[0], h2[1], h2[2], h2[3]}; o0 = mfma32(A, pb, o0); }
                { const s16x4 lo = trld(va + 2048 + s * 1024), h2 = trld(va + 2048 + s * 1024 + 512); const bf16x8 A = {lo[0], lo[1], lo[2], lo[3], h2[0], h2[1], h2[2], h2[3]}; o1 = mfma32(A, pb, o1); }
            }
        }
    }
#undef AT_LD4
    const float inv = 1.0f / l;
    {
        LAS unsigned char* ob = wl;
#pragma unroll
        for (int G4 = 0; G4 < 4; ++G4) {
            u32x2 w0; w0.x = cvt_pk_bf16(o0[4 * G4] * inv, o0[4 * G4 + 1] * inv); w0.y = cvt_pk_bf16(o0[4 * G4 + 2] * inv, o0[4 * G4 + 3] * inv); *(LAS u32x2*)(ob + r32 * 144 + (8 * G4 + 4 * hi) * 2) = w0;
            u32x2 w1; w1.x = cvt_pk_bf16(o1[4 * G4] * inv, o1[4 * G4 + 1] * inv); w1.y = cvt_pk_bf16(o1[4 * G4 + 2] * inv, o1[4 * G4 + 3] * inv); *(LAS u32x2*)(ob + r32 * 144 + (32 + 8 * G4 + 4 * hi) * 2) = w1;
        }
        bf16* OGb = WSP(bf16, WS_OG);
#pragma unroll
        for (int ii = 0; ii < 4; ++ii) { const int qi = 8 * ii + (lane >> 3), ch = lane & 7;
            const u32x4 w = *(const LAS u32x4*)(ob + qi * 144 + ch * 16);
            *(u32x4*)(OGb + (size_t)gj * PLQ + (rowbase + (size_t)((m0 + qi) * d + r)) * 64 + ch * 8) = w; }
    }
    if (hi == 0) WSP(float, WS_LSE)[(rowbase + tq) * 12 + gj] = (mx + __builtin_amdgcn_logf(l)) * LN2F;
}

__device__ __forceinline__ void attn_sample_task(Frame& F, int task, LAS unsigned char* wl) {
    int lane = F.lane; asm volatile("" : "+v"(lane));
    const int sub = lane >> 4, l16 = lane & 15, t = task & 3, gj = (task >> 2) % 12, bd = task / 48, g = gj >> 2, j = gj & 3;
    const int W = 128 << (2 * g), d = 1 << (2 * g), hc = g * 256 + j * 64;
    const size_t row = (size_t)MP + bd * 4 + t;
    const float* stu = (g == 0 ? F.in[2] : g == 1 ? F.in[3] : F.in[4]) + (size_t)bd * W * 512 + j * 64;
    const float* st = stu + 4 * l16;
    const float* nw = F.out + (g == 0 ? O_W0S : g == 1 ? O_W1S : O_W2S) + (size_t)bd * W * 512 + j * 64 + 4 * l16;
    const float* bt = WSP(float, WS_SMALL) + SM_BT + gj * 192 + 32;
    LAS float* scb = (LAS float*)(wl + 10240);
    const u32x2 qw = *(const u32x2*)(WSP(bf16, WS_Q) + (size_t)gj * PLQ + row * 64 + 4 * l16);
    const f32x4 qv = {bflo(qw.x), bfhi(qw.x), bflo(qw.y), bfhi(qw.y)};
    const float* r0p; { const int idx = W + t - sub * d; r0p = idx < W ? st + (size_t)idx * 512 : nw + (size_t)(idx - 4) * 512; }
#define SOFF(u_) ((unsigned)((W + t - (4 * (u_) + sub < 128 ? 4 * (u_) + sub : 128) * d) * 512 + 4 * l16))
    {
        f32x4 kv[17];
        kv[0] = *(const f32x4*)r0p;
#pragma unroll
        for (int u = 1; u < 17; ++u) kv[u] = *(const f32x4*)(stu + SOFF(u));
#pragma unroll
        for (int u = 0; u < 17; ++u) { const int i = u * 4 + sub;
            float s = (qv[0] * kv[u][0] + qv[1] * kv[u][1]) + (qv[2] * kv[u][2] + qv[3] * kv[u][3]);
            s += __shfl_xor(s, 1); s += __shfl_xor(s, 2); s += __shfl_xor(s, 4); s += __shfl_xor(s, 8);
            if (l16 == 0) scb[i] = s + bt[i]; }
        asm volatile("" ::: "memory");
    }
    f32x4 vA[11], vB[11], vC[11];
    {
        f32x4 kv[16];
#pragma unroll
        for (int u = 0; u < 16; ++u) kv[u] = *(const f32x4*)(stu + SOFF(17 + u));
        vA[0] = *(const f32x4*)(r0p + 256);
#pragma unroll
        for (int u = 1; u < 11; ++u) vA[u] = *(const f32x4*)(stu + 256 + SOFF(u));
#pragma unroll
        for (int u = 0; u < 16; ++u) { const int i = (17 + u) * 4 + sub, ii = i < 128 ? i : 128;
            float s = (qv[0] * kv[u][0] + qv[1] * kv[u][1]) + (qv[2] * kv[u][2] + qv[3] * kv[u][3]);
            s += __shfl_xor(s, 1); s += __shfl_xor(s, 2); s += __shfl_xor(s, 4); s += __shfl_xor(s, 8);
            if (l16 == 0 && i <= 128) scb[i] = s + bt[ii]; }
    }
    asm volatile("s_waitcnt lgkmcnt(0)" ::: "memory");
#pragma unroll
    for (int u = 0; u < 11; ++u) vB[u] = *(const f32x4*)(stu + 256 + SOFF(11 + u));
    const float v0 = scb[lane], v1 = scb[lane + 64], v2 = lane == 0 ? scb[128] : NEGBIG;
    const float mx = wave_max(fmaxf(fmaxf(v0, v1), v2));
    const float p0 = fast_exp2(v0 - mx), p1 = fast_exp2(v1 - mx), p2 = lane == 0 ? fast_exp2(v2 - mx) : 0.f;
    const float l = wave_sum(p0 + p1 + p2);
    scb[lane] = p0; scb[lane + 64] = p1; if (lane < 4) scb[128 + lane] = p2;
    asm volatile("s_waitcnt lgkmcnt(0)" ::: "memory");
    f32x4 o4 = {0.f, 0.f, 0.f, 0.f};
#pragma unroll
    for (int u = 0; u < 11; ++u) o4 += scb[u * 4 + sub] * vA[u];
    asm volatile("" ::: "memory");
#pragma unroll
    for (int u = 0; u < 11; ++u) vC[u] = *(const f32x4*)(stu + 256 + SOFF(22 + u));
#pragma unroll
    for (int u = 0; u < 11; ++u) o4 += scb[(11 + u) * 4 + sub] * vB[u];
#pragma unroll
    for (int u = 0; u < 11; ++u) o4 += scb[(22 + u) * 4 + sub] * vC[u];
#undef SOFF
#pragma unroll
    for (int c = 0; c < 4; ++c) { o4[c] += __shfl_xor(o4[c], 16); o4[c] += __shfl_xor(o4[c], 32); }
    const float inv = 1.0f / l;
    if (lane < 16) { u32x2 w; w.x = cvt_pk_bf16(o4[0] * inv, o4[1] * inv); w.y = cvt_pk_bf16(o4[2] * inv, o4[3] * inv); *(u32x2*)(WSP(bf16, WS_OG) + (size_t)gj * PLQ + row * 64 + 4 * l16) = w; }
    if (lane == 0) WSP(float, WS_LSE)[row * 12 + gj] = (mx + __builtin_amdgcn_logf(l)) * LN2F;
    asm volatile("s_waitcnt lgkmcnt(0)" ::: "memory");
}

__device__ __forceinline__ void sgu_unit(Frame& F, int su, LAS unsigned char* wl) {
    const int lane = F.lane, r32 = lane & 31, hi = lane >> 5;
    const int cb = su & 3, gg = (su >> 2) & 3, chunk = su >> 4, c0 = gg * 128 + cb * 32; const size_t row0 = (size_t)chunk * 128;
    LAS f32x2* st = (LAS f32x2*)(wl + 9216);
    const u64* sgv = WSP(u64, WS_SGV);
#pragma unroll
    for (int h = 0; h < 2; ++h) { const int rr = lane + 64 * h; const u32x4* p = (const u32x4*)(sgv + (row0 + rr) * 8);
        const u32x4 a = p[0], b = p[1], c = p[2], dd = p[3];
        const float mn[8] = {__uint_as_float(a.x), __uint_as_float(a.z), __uint_as_float(b.x), __uint_as_float(b.z), __uint_as_float(c.x), __uint_as_float(c.z), __uint_as_float(dd.x), __uint_as_float(dd.z)};
        const float m2[8] = {__uint_as_float(a.y), __uint_as_float(a.w), __uint_as_float(b.y), __uint_as_float(b.w), __uint_as_float(c.y), __uint_as_float(c.w), __uint_as_float(dd.y), __uint_as_float(dd.w)};
        float smn = 0.f;
#pragma unroll
        for (int i = 0; i < 8; ++i) smn += mn[i];
        const float mt = smn * 0.125f; float q = 0.f;
#pragma unroll
        for (int i = 0; i < 8; ++i) { const float e = mn[i] - mt; q += m2[i] + 64.0f * e * e; }
        st[rr] = (f32x2){mt, 1.0f / sqrtf(q * (1.0f / 512.0f) + LN_EPS)}; }
    const int ch = lane & 3;
    const float* lg = F.in[13] + c0 + ch * 8; const float* lb = F.in[14] + c0 + ch * 8;
    const f32x4 g0 = *(const f32x4*)lg, g1 = *(const f32x4*)(lg + 4), b0 = *(const f32x4*)lb, b1 = *(const f32x4*)(lb + 4);
    const bf16* GVb = WSP(bf16, WS_GV);
#pragma unroll
    for (int it = 0; it < 8; ++it) { const int rw = 16 * it + (lane >> 2);
        const u32x4 w = *(const u32x4*)(GVb + (size_t)(gg * 4 + cb) * PLU + (row0 + rw) * 32 + ch * 8); f32x4 x0, x1; unpack8(w, x0, x1); const f32x2 s = st[rw];
        x0 = (x0 - s.x) * s.y * g0 + b0; x1 = (x1 - s.x) * s.y * g1 + b1;
        *(LAS u32x4*)(wl + rw * 64 + ch * 16) = pack8(x0, x1); }
    const LAS unsigned char* va = wl + (8 * hi + ((lane & 15) >> 2)) * 64 + ((lane >> 4) & 1) * 32 + (lane & 3) * 8;
    bf16x8 Af[8];
#pragma unroll
    for (int ks = 0; ks < 8; ++ks) { const s16x4 lo = trld(va + ks * 1024), h2 = trld(va + ks * 1024 + 256); Af[ks] = (bf16x8){lo[0], lo[1], lo[2], lo[3], h2[0], h2[1], h2[2], h2[3]}; }
    const bf16* Wsb = WSP(bf16, WS_WSB) + (size_t)gg * 128 * 128;
    const bf16* Ub = WSP(bf16, WS_U); bf16* AY = WSP(bf16, WS_AY);
#pragma unroll
    for (int pt = 0; pt < 4; ++pt) {
        f32x16 acc = {};
#pragma unroll
        for (int ks = 0; ks < 2 * pt + 2; ++ks) { const bf16x8 B = *(const bf16x8*)(Wsb + (size_t)(32 * pt + r32) * 128 + 16 * ks + 8 * hi); acc = mfma32(Af[ks], B, acc); }
        const float sbv = F.in[16][gg * 128 + 32 * pt + r32];
        const size_t prow = row0 + 32 * pt + r32;
#pragma unroll
        for (int G4 = 0; G4 < 4; ++G4) { const int c4 = 8 * G4 + 4 * hi;
            const u32x2 uw = *(const u32x2*)(Ub + (size_t)(gg * 4 + cb) * PLU + prow * 32 + c4);
            u32x2 y; y.x = cvt_pk_bf16(bflo(uw.x) * (acc[4 * G4] + sbv), bfhi(uw.x) * (acc[4 * G4 + 1] + sbv)); y.y = cvt_pk_bf16(bflo(uw.y) * (acc[4 * G4 + 2] + sbv), bfhi(uw.y) * (acc[4 * G4 + 3] + sbv));
            *(u32x2*)(AY + prow * 768 + 256 + c0 + c4) = y; }
    }
    asm volatile("s_waitcnt lgkmcnt(0)" ::: "memory");
}
__device__ __forceinline__ void sgu_sample_task(Frame& F, int bd) {
    const int lane = F.lane, c = lane * 8, gg = lane >> 4;
    const size_t row0 = (size_t)MP + bd * 4;
    const u64* sgv = WSP(u64, WS_SGV); const bf16* GVb = WSP(bf16, WS_GV); const bf16* Ub = WSP(bf16, WS_U); bf16* AY = WSP(bf16, WS_AY);
    const f32x4 g0 = *(const f32x4*)(F.in[13] + c), g1 = *(const f32x4*)(F.in[13] + c + 4), b0 = *(const f32x4*)(F.in[14] + c), b1 = *(const f32x4*)(F.in[14] + c + 4);
    f32x4 vn[4][2];
#pragma unroll
    for (int t = 0; t < 4; ++t) {
        const u32x4* p = (const u32x4*)(sgv + (row0 + t) * 8);
        const u32x4 a = p[0], b = p[1], cc = p[2], dd = p[3];
        const float mn[8] = {__uint_as_float(a.x), __uint_as_float(a.z), __uint_as_float(b.x), __uint_as_float(b.z), __uint_as_float(cc.x), __uint_as_float(cc.z), __uint_as_float(dd.x), __uint_as_float(dd.z)};
        const float m2[8] = {__uint_as_float(a.y), __uint_as_float(a.w), __uint_as_float(b.y), __uint_as_float(b.w), __uint_as_float(cc.y), __uint_as_float(cc.w), __uint_as_float(dd.y), __uint_as_float(dd.w)};
        float smn = 0.f;
#pragma unroll
        for (int i = 0; i < 8; ++i) smn += mn[i];
        const float mt = smn * 0.125f; float q = 0.f;
#pragma unroll
        for (int i = 0; i < 8; ++i) { const float e = mn[i] - mt; q += m2[i] + 64.0f * e * e; }
        const float rs = 1.0f / sqrtf(q * (1.0f / 512.0f) + LN_EPS);
        f32x4 x0, x1; unpack8(*(const u32x4*)(GVb + (size_t)(lane >> 2) * PLU + (row0 + t) * 32 + (lane & 3) * 8), x0, x1);
        vn[t][0] = (x0 - mt) * rs * g0 + b0; vn[t][1] = (x1 - mt) * rs * g1 + b1;
        float* sv = F.out + O_SV + (size_t)(bd * 4 + t) * SGUW + c; *(f32x4*)sv = vn[t][0]; *(f32x4*)(sv + 4) = vn[t][1];
    }
#pragma unroll
    for (int p = 0; p < 4; ++p) {
        const float sbv = F.in[16][gg * 128 + p];
        f32x4 m0 = {sbv, sbv, sbv, sbv}, m1 = m0;
#pragma unroll
        for (int q = 0; q <= p; ++q) { const float w = F.in[15][(size_t)(gg * 128 + p) * 128 + q]; m0 += w * vn[q][0]; m1 += w * vn[q][1]; }
        f32x4 u0, u1; unpack8(*(const u32x4*)(Ub + (size_t)(lane >> 2) * PLU + (row0 + p) * 32 + (lane & 3) * 8), u0, u1);
        *(u32x4*)(AY + (row0 + p) * 768 + 256 + c) = pack8(u0 * m0, u1 * m1);
    }
}


#ifdef MK_PROBE
__device__ __constant__ int PRB_B[8] = {0, 0, 3, 5, 7, 12, 20, 31};
__device__ __constant__ int PRB_T[8] = {0, 37, 130, 1000, 2047, 255, 1290, 64};
__device__ __forceinline__ size_t probe_row(int w) { return (size_t)PRB_B[w] * SEQ + PRB_T[w]; }
__device__ __forceinline__ void probe_put(unsigned* ctl, int stage, float ref, float got) {
    float d = fabsf(ref - got) / (fabsf(ref) + 0.3f); if (!(d == d)) d = 1e30f; d = wave_max(d);
    if ((threadIdx.x & 63) == 0) atomicMax(ctl + 64 + stage, __float_as_uint(d));
}
__device__ __forceinline__ float probe_dot(const LAS float* vec, const float* W, int K, int ldw, int col) {
    float a = 0.f;
#pragma unroll 8
    for (int k = 0; k < K; ++k) a += vec[k] * W[(size_t)k * ldw + col];
    return a;
}
__device__ __forceinline__ void probe_ln_row(LAS float* vec, const bf16* rowp, const float* g, const float* b, int lane) {
    float x[16], s = 0.f;
    for (int i = 0; i < 16; ++i) { x[i] = bflo((unsigned)rowp[i * 64 + lane]); s += x[i]; }
    const float mean = wave_sum(s) * (1.0f / 1024.0f); float q = 0.f;
    for (int i = 0; i < 16; ++i) q += (x[i] - mean) * (x[i] - mean);
    const float rs = 1.0f / sqrtf(wave_sum(q) * (1.0f / 1024.0f) + LN_EPS);
    for (int i = 0; i < 16; ++i) { const int c = i * 64 + lane; vec[c] = (x[i] - mean) * rs * g[c] + b[c]; }
    asm volatile("s_waitcnt lgkmcnt(0)" ::: "memory");
}
__device__ __forceinline__ void probe_stage(Frame& F, unsigned* ctl, int stage) {
    const int lane = F.lane, w = F.wave; const size_t row = probe_row(w);
    LAS float* vec = (LAS float*)(F.lds + w * 16384);
    if (stage == 0) {
        const float* x = F.in[0] + row * DM;
        for (int i = 0; i < 16; ++i) vec[i * 64 + lane] = x[i * 64 + lane];
        asm volatile("s_waitcnt lgkmcnt(0)" ::: "memory");
        const int hc = lane * 44 + (lane * 5 + w) % 44; const float a = probe_dot(vec, F.in[8], DM, DFF, hc), b = probe_dot(vec, F.in[9], DM, DFF, hc);
        probe_put(ctl, 0, a * b / (1.0f + expf(-a)), bflo((unsigned)WSP(bf16, WS_ACT)[row * DFF + hc]));
        for (int i = 0; i < 44; ++i) vec[i * 64 + lane] = bflo((unsigned)WSP(bf16, WS_ACT)[row * DFF + i * 64 + lane]);
        asm volatile("s_waitcnt lgkmcnt(0)" ::: "memory");
        const int c = lane * 16 + (lane * 7 + w * 3) % 16; probe_put(ctl, 1, ALPHA * x[c] + 0.5f * probe_dot(vec, F.in[10], DFF, DM, c), bflo((unsigned)WSP(bf16, WS_V1)[row * DM + c]));
    } else if (stage == 1) {
        probe_ln_row(vec, WSP(bf16, WS_V1) + row * DM, F.in[6], F.in[7], lane);
        const int c = lane * 84 + (lane * 11 + w * 7) % 84; const float z = probe_dot(vec, F.in[11], DM, INW, c) + F.in[12][c];
        float ref, got;
        if (c < 768) { ref = z * QSCALE; got = bflo((unsigned)WSP(bf16, WS_Q)[row * QKVW + c]); }
        else if (c < 1536) { ref = z; got = bflo((unsigned)WSP(bf16, WS_K)[row * QKVW + c - 768]); }
        else if (c < 2304) { ref = z; got = bflo((unsigned)WSP(bf16, WS_V)[row * QKVW + c - 1536]); }
        else if (c < 2816) { ref = 0.5f * z * (1.0f + erff(z * 0.70710678f)); got = bflo((unsigned)WSP(bf16, WS_U)[row * SGUW + c - 2304]); }
        else if (c < 3328) { ref = 0.5f * z * (1.0f + erff(z * 0.70710678f)); got = bflo((unsigned)WSP(bf16, WS_GV)[row * SGUW + c - 2816]); }
        else if (c < 4352) { ref = 1.0f / (1.0f + expf(-z)); got = bflo((unsigned)WSP(bf16, WS_SA)[row * DM + c - 3328]); }
        else { ref = 1.0f / (1.0f + expf(-z)); got = bflo((unsigned)WSP(bf16, WS_SB)[row * DM + c - 4352]); }
        if (c >= 4352) {
            float csr = 0.f, bir = 0.f; unsigned wbad = 0u;
            for (int k = 0; k < DM; ++k) { const float wv = F.in[11][(size_t)k * INW + c]; csr += bfround(F.in[6][k] * wv); bir += F.in[7][k] * wv;
                if (f2bf(F.in[6][k] * wv) != (unsigned)WSP(bf16, WS_WIN)[(size_t)c * DM + k]) wbad = 1u; }
            bir += F.in[12][c];
            const float* smm = WSP(float, WS_SMALL);
            if (fabsf(csr - smm[SM_CS1 + c]) > 1e-3f) atomicOr(ctl + 98, 1u);
            if (fabsf(bir - smm[SM_B1 + c]) > 1e-3f) atomicOr(ctl + 98, 2u);
            if (wbad) atomicOr(ctl + 98, 4u);
        }
        if (c >= 4352) { float d = fabsf(ref - got) / (fabsf(ref) + 0.3f); if (d > 0.1f) { atomicOr(ctl + 96, 1u << (c & 7)); atomicOr(ctl + 97, 1u << ((c - 4352) >> 7)); } }
        { const int cls = c < 768 ? 0 : c < 1536 ? 1 : c < 2304 ? 2 : c < 2816 ? 3 : c < 3328 ? 4 : c < 4352 ? 5 : 6;
          for (int k = 0; k < 7; ++k) probe_put(ctl, 8 + k, cls == k ? ref : 0.f, cls == k ? got : 0.f); }
        probe_put(ctl, 2, ref, got);
    } else if (stage == 2) {
        const bf16* OG = WSP(bf16, WS_OG) + row * QKVW; const float* LSE = WSP(float, WS_LSE) + row * 12;
        for (int q = 0; q < 4; ++q) { const int c = lane * 4 + q, j = c >> 6;
            const float l0 = LSE[j], l1 = LSE[4 + j], l2 = LSE[8 + j], mx = fmaxf(fmaxf(l0, l1), l2), e0 = expf(l0 - mx), e1 = expf(l1 - mx), e2 = expf(l2 - mx);
            const float ref = (bflo((unsigned)OG[c]) * e0 + bflo((unsigned)OG[256 + c]) * e1 + bflo((unsigned)OG[512 + c]) * e2) / (e0 + e1 + e2);
            probe_put(ctl, 3, ref, bflo((unsigned)WSP(bf16, WS_AY)[row * 768 + c])); }
    } else if (stage == 3) {
        for (int i = 0; i < 12; ++i) vec[i * 64 + lane] = bflo((unsigned)WSP(bf16, WS_AY)[row * 768 + i * 64 + lane]);
        asm volatile("s_waitcnt lgkmcnt(0)" ::: "memory");
        const int c = lane * 16 + (lane * 7 + w * 3) % 16; const float a = probe_dot(vec, F.in[17], 256, DM, c), b = probe_dot(vec + 256, F.in[18], 512, DM, c);
        probe_put(ctl, 4, bflo((unsigned)WSP(bf16, WS_SA)[row * DM + c]) * a + bflo((unsigned)WSP(bf16, WS_SB)[row * DM + c]) * b, bflo((unsigned)WSP(bf16, WS_XB)[row * DM + c]));
    } else if (stage == 4) {
        probe_ln_row(vec, WSP(bf16, WS_V1) + row * DM, F.in[6], F.in[7], lane);
        const int c = lane * 16 + (lane * 7 + w * 3) % 16; const float h1 = vec[c];
        for (int i = 0; i < 16; ++i) vec[i * 64 + lane] = bflo((unsigned)WSP(bf16, WS_XB)[row * DM + i * 64 + lane]);
        asm volatile("s_waitcnt lgkmcnt(0)" ::: "memory");
        probe_put(ctl, 5, ALPHA * h1 + probe_dot(vec, F.in[19], DM, DM, c), bflo((unsigned)WSP(bf16, WS_V2)[row * DM + c]));
    } else if (stage == 5) {
        probe_ln_row(vec, WSP(bf16, WS_V2) + row * DM, F.in[20], F.in[21], lane);
        const int hc = lane * 44 + (lane * 5 + w) % 44; const float a = probe_dot(vec, F.in[22], DM, DFF, hc), b = probe_dot(vec, F.in[23], DM, DFF, hc);
        probe_put(ctl, 6, a * b / (1.0f + expf(-a)), bflo((unsigned)WSP(bf16, WS_ACT)[row * DFF + hc]));
    } else {
        probe_ln_row(vec, WSP(bf16, WS_V2) + row * DM, F.in[20], F.in[21], lane);
        const int c = lane * 16 + (lane * 7 + w * 3) % 16; const float h2 = vec[c];
        for (int i = 0; i < 44; ++i) vec[i * 64 + lane] = bflo((unsigned)WSP(bf16, WS_ACT)[row * DFF + i * 64 + lane]);
        asm volatile("s_waitcnt lgkmcnt(0)" ::: "memory");
        probe_put(ctl, 7, ALPHA * h2 + 0.5f * probe_dot(vec, F.in[24], DFF, DM, c), F.out[O_Y + row * DM + c]);
    }
    asm volatile("s_waitcnt lgkmcnt(0)" ::: "memory");
}
#define PROBE(stage) do { if (F.vcu == 0) probe_stage(F, ctl, stage); __syncthreads(); } while (0)
#else
#define PROBE(stage) do {} while (0)
#endif
__device__ __forceinline__ int rot_c(int rot, int G) { int c = (int)blockIdx.x + rot; while (c >= G) c -= G; return c; }
constexpr int N_PHASES = 11;
__global__ void __launch_bounds__(512, 2) mk_fwd(Args args) {
    extern __shared__ __attribute__((aligned(16))) unsigned char lds_raw[];
    Frame F;
    F.lds = (LAS unsigned char*)lds_raw;
    F.wave = __builtin_amdgcn_readfirstlane(threadIdx.x >> 6); F.lane = lane_now(); F.tid = F.wave * 64 + F.lane;
    F.G = gridDim.x; { const int bx = blockIdx.x; F.vcu = (F.G % 8 == 0) ? (bx % 8) * (F.G / 8) + bx / 8 : bx; }
    F.in = args.in; F.out = args.out; F.ws = args.ws;
    volatile LAS unsigned* MISC = (volatile LAS unsigned*)(F.lds + MISC_OFF);
    for (int u = F.tid; u < (LDS_BYTES - MISC_OFF) / 4; u += 512) ((LAS unsigned*)(F.lds + MISC_OFF))[u] = 0u;
    __syncthreads();
    unsigned* ctl = (unsigned*)(F.ws + WS_CTL);
    XcdBarrier bar; bar.bar = ctl + CW_BAR; bar.x = 0; bar.st = nullptr;
    if (MK_N_LAUNCHES == 1) bar = xcd_barrier_post(ctl + CW_BAR, MISC + 8, F.tid == 0);
    const int lo = args.ph_lo, hi = args.ph_hi;
#ifdef MK_PROBE
    if (lo >= 100) { if (F.vcu == 0) probe_stage(F, (unsigned*)(F.ws + WS_CTL), lo - 100); return; }
#endif
#ifdef MK_ONLY
#define IN(k) ((k) == MK_ONLY)
#else
#define IN(k) (lo <= (k) && (k) < hi)
#endif
#ifdef MK_STAMP_A
    u64* tsw = (u64*)(F.ws + WS_CTL) + 1024;
#define STAMP(k) do { if (blockIdx.x == 0 && F.tid == 0) tsw[(k)] = __builtin_amdgcn_s_memrealtime(); } while (0)
#else
#define STAMP(k) do {} while (0)
#endif
    STAMP(0);
#define SEAM(k) do { if (IN(k) && IN((k) + 1)) xcd_barrier(bar, F.wave == 0 && lane_now() == 0); STAMP((k) + 1); F.lane = lane_now(); F.tid = F.wave * 64 + F.lane; } while (0)
    LAS f32x2* stab = (LAS f32x2*)(F.lds + STAB_OFF);
#ifdef MK_PROBE
    const bool alt = (args.li == 99);
    if (args.li >= 200) {
        const int k = args.li - 200; const unsigned* A = (const unsigned*)(F.ws + (k == 0 ? WS_ACT : k == 1 ? WS_V1 : WS_V2)); const unsigned* B = (const unsigned*)(F.ws + (k == 0 ? 1412 * MiB : k == 1 ? 1767 * MiB : 1896 * MiB));
        const size_t n = (size_t)M * (k == 0 ? DFF : DM) / 2; unsigned cnt = 0;
        for (size_t i = (size_t)F.vcu * 512 + F.tid; i < n; i += (size_t)F.G * 512) cnt += (A[i] != B[i]) ? 1u : 0u;
        if (cnt) atomicAdd((unsigned*)(F.ws + WS_CTL) + 80 + k, cnt);
        return;
    }
#else
    const bool alt = false;
#endif
    const int gw = F.vcu * 8 + F.wave, NGW = F.G * 8;
    const int gt = F.vcu * 512 + F.tid, NGT = F.G * 512;
    float* sm = WSP(float, WS_SMALL);

    if (IN(0)) { p0_prologue(F); if (MK_DUP == 0) { __syncthreads(); p0_prologue(F); } }
    SEAM(0);
    if (IN(1)) {
        for (int i = gt; i < 22016; i += NGT) { float a = 0.f;
#pragma unroll
            for (int ks = 0; ks < 16; ++ks) a += WSP(float, WS_LSE)[ks * 22016 + i];
            if (i < 5376) sm[SM_CS1 + i] = a; else if (i < 10752) { const int rw = i - 5376; int col = rw; if (rw >= 3328) { const int q = rw - 3328, blk = q >> 8, wi = q & 255; col = (wi < 128 ? 3328 : 4352) + 128 * blk + (wi & 127); } sm[SM_B1 + rw] = a + F.in[12][col]; } else if (i < 16384) sm[SM_CS2 + i - 10752] = a; else sm[SM_B2 + i - 16384] = a; }
        pg8::Gemm g{WSP(bf16, WS_XB), WSP(bf16, WS_WF1), M, NFF2, DM}; pg8::StaticOrder S; S.init(M, NFF2, F.G, rot_c(0, F.G));
        pg8::EpiSwiglu<false> E{alt ? WSP(bf16, 1412 * MiB) : WSP(bf16, WS_ACT), nullptr, nullptr, nullptr, stab};
        pg8::gemm_phase(F.lds, g, S, E, F.wave);
        if (MK_DUP == 1) pg8::gemm_phase(F.lds, g, S, E, F.wave);
    }
    SEAM(1);
    if (IN(2)) {
        pg8::Gemm g{WSP(bf16, WS_ACT), WSP(bf16, WS_WF1D), M, DM, DFF}; pg8::PanelOrder S; S.init(M, F.G, rot_c(112, F.G));
        pg8::EpiDown<0> E{F.in[0], F.in[1], WSP(bf16, WS_XB), nullptr, nullptr, nullptr, stab, alt ? WSP(bf16, 1767 * MiB) : WSP(bf16, WS_V1), nullptr, alt ? WSP(u64, WS_S3) : WSP(u64, WS_S1), 0.5f};
        pg8::gemm_phase(F.lds, g, S, E, F.wave);
        if (MK_DUP == 2) pg8::gemm_phase(F.lds, g, S, E, F.wave);
        copy_fill(F, ctl, 2, false);
    }
    SEAM(2);
    if (IN(3)) {
        pg8::Gemm g{WSP(bf16, WS_V1), WSP(bf16, WS_WIN), M, INW, DM}; pg8::StaticOrder S; S.init(M, INW, F.G, rot_c(208, F.G));
        pg8::EpiWin E{sm + SM_CS1, sm + SM_B1, WSP(u64, WS_S1), stab, WSP(bf16, WS_Q), WSP(bf16, WS_K), WSP(bf16, WS_V), WSP(bf16, WS_U), WSP(bf16, WS_GV), WSP(bf16, WS_SA), WSP(bf16, WS_SB), WSP(u64, WS_SGV), F.out};
        pg8::gemm_phase(F.lds, g, S, E, F.wave);
        if (MK_DUP == 3) pg8::gemm_phase(F.lds, g, S, E, F.wave);
    }
    SEAM(3);
    if (IN(4)) {
        LAS unsigned char* wl = F.lds + F.wave * 16384;
        const bf16* OG = WSP(bf16, WS_OG); const float* LSE = WSP(float, WS_LSE); bf16* AY = WSP(bf16, WS_AY);
        int cur_gj = -1;
        ((LAS float*)(wl + 8192))[192 + F.lane] = NEGBIG;
#pragma unroll 1
        for (int rep = 0; rep < (MK_DUP == 4 ? 2 : 1); ++rep) {
        if (MK_DUP == 4) { asm volatile("" : "+v"(F.lane), "+v"(F.tid)); cur_gj = -1; }
        int T = F.vcu, vw = F.vcu; const int sslot = F.vcu % 3;
        for (int step = 0; T < NB * 16 || vw < DEC_B * 2; ++step) {
          const bool do_s = vw < DEC_B * 2 && (step % 3 == sslot || T >= NB * 16);
          if (!do_s) {
            const int b = T >> 4, j = (T >> 2) & 3, ck = T & 3;
#pragma unroll 1
            for (int u = F.wave; u < 48; u += 8) { const int g = u >> 4, k = u & 15;
                const int blk = (g == 0) ? ck * 16 + k : (g == 1) ? (k >> 2) * 16 + 4 * ck + (k & 3) : k * 4 + ck;
                attn_unit(F, ((b * 12 + g * 4 + j) << 6) | blk, wl, cur_gj); }
            asm volatile("s_waitcnt vmcnt(0)" ::: "memory"); __syncthreads();
            int ctid = F.tid; asm volatile("" : "+v"(ctid));
#pragma unroll 1
            for (int h = 0; h < 1; ++h) {
                float l0[8], l1[8], l2[8]; u32x4 wa[8], wb[8], wc[8];
#pragma unroll
                for (int q = 0; q < 8; ++q) { const int idx = ctid + 512 * (8 * h + q); const size_t row = (size_t)b * SEQ + ck * 512 + (idx >> 3); const int c = idx & 7;
                    l0[q] = LSE[row * 12 + j]; l1[q] = LSE[row * 12 + 4 + j]; l2[q] = LSE[row * 12 + 8 + j];
                    const bf16* og = OG + (size_t)j * PLQ + row * 64 + c * 8; wa[q] = *(const u32x4*)og; wb[q] = *(const u32x4*)(og + 4 * PLQ); wc[q] = *(const u32x4*)(og + 8 * PLQ); }
#pragma unroll
                for (int q = 0; q < 8; ++q) { const int idx = ctid + 512 * (8 * h + q); const size_t row = (size_t)b * SEQ + ck * 512 + (idx >> 3); const int c = idx & 7;
                    const float mx = fmaxf(fmaxf(l0[q], l1[q]), l2[q]);
                    const float e0 = __expf(l0[q] - mx), e1 = __expf(l1[q] - mx), e2 = __expf(l2[q] - mx), inv = 1.0f / (e0 + e1 + e2);
                    f32x4 a0, a1, b0, b1, c0, c1; unpack8(wa[q], a0, a1); unpack8(wb[q], b0, b1); unpack8(wc[q], c0, c1);
                    *(u32x4*)(AY + row * 768 + j * 64 + c * 8) = pack8((a0 * e0 + b0 * e1 + c0 * e2) * inv, (a1 * e0 + b1 * e1 + c1 * e2) * inv); }
            }
            __syncthreads();
            T += F.G;
          } else {
            const int bd = vw >> 1, jh = vw & 1;
#pragma unroll 1
            for (int v = F.wave; v < (MK_DUP == 43 ? 48 : 24); v += 8) { const int v24 = v >= 24 ? v - 24 : v, g = v24 >> 3, j = 2 * jh + ((v24 >> 2) & 1), t = v24 & 3; attn_sample_task(F, ((bd * 12 + g * 4 + j) << 2) | t, wl); }
            asm volatile("s_waitcnt vmcnt(0)" ::: "memory"); __syncthreads();
            if (F.tid < 64) { const size_t row = (size_t)MP + bd * 4 + (F.tid >> 4); const int j = 2 * jh + ((F.tid >> 3) & 1), c = F.tid & 7;
                const float l0 = LSE[row * 12 + j], l1 = LSE[row * 12 + 4 + j], l2 = LSE[row * 12 + 8 + j], mx = fmaxf(fmaxf(l0, l1), l2);
                const float e0 = __expf(l0 - mx), e1 = __expf(l1 - mx), e2 = __expf(l2 - mx), inv = 1.0f / (e0 + e1 + e2);
                const bf16* og = OG + (size_t)j * PLQ + row * 64 + c * 8;
                f32x4 a0, a1, b0, b1, c0, c1; unpack8(*(const u32x4*)og, a0, a1); unpack8(*(const u32x4*)(og + 4 * PLQ), b0, b1); unpack8(*(const u32x4*)(og + 8 * PLQ), c0, c1);
                *(u32x4*)(AY + row * 768 + j * 64 + c * 8) = pack8((a0 * e0 + b0 * e1 + c0 * e2) * inv, (a1 * e0 + b1 * e1 + c1 * e2) * inv); }
            __syncthreads();
            vw += F.G;
          }
        }
        for (int su = gw; su < (MP / 128) * 16 * (MK_DUP == 42 ? 2 : 1); su += NGW) sgu_unit(F, su >= (MP / 128) * 16 ? su - (MP / 128) * 16 : su, wl);
        for (int bd = gw; bd < DEC_B; bd += NGW) sgu_sample_task(F, bd);
        if (MK_DUP == 4) { asm volatile("s_waitcnt vmcnt(0)" ::: "memory"); __syncthreads(); }
        }
    }
    SEAM(4);
    if (IN(6)) {
        pg8::Gemm g{WSP(bf16, WS_AY), WSP(bf16, WS_WOAB), M, DM, 768}; pg8::PanelOrder S; S.init(M, F.G, rot_c(96, F.G));
        pg8::EpiGate E{WSP(bf16, WS_SA), WSP(bf16, WS_SB), WSP(bf16, WS_XB)};
        pg8::gemm_phase(F.lds, g, S, E, F.wave);
        if (MK_DUP == 6) pg8::gemm_phase(F.lds, g, S, E, F.wave);
        copy_fill(F, ctl, 6, false);
    }
    SEAM(6);
    if (IN(7)) {
        pg8::Gemm g{WSP(bf16, WS_XB), WSP(bf16, WS_WOUT), M, DM, DM}; pg8::PanelOrder S; S.init(M, F.G, rot_c(88, F.G));
        pg8::EpiDown<1> E{nullptr, nullptr, WSP(bf16, WS_V1), F.in[6], F.in[7], WSP(u64, WS_S1), stab, alt ? WSP(bf16, 1896 * MiB) : WSP(bf16, WS_V2), nullptr, alt ? WSP(u64, WS_S3) : WSP(u64, WS_S2), 1.0f};
        pg8::gemm_phase(F.lds, g, S, E, F.wave);
        if (MK_DUP == 7) pg8::gemm_phase(F.lds, g, S, E, F.wave);
        copy_fill(F, ctl, 7, false);
    }
    SEAM(7);
    if (IN(8)) {
        pg8::Gemm g{WSP(bf16, WS_V2), WSP(bf16, WS_WF2), M, NFF2, DM}; pg8::StaticOrder S; S.init(M, NFF2, F.G, rot_c(160, F.G));
        pg8::EpiSwiglu<true> E{WSP(bf16, WS_ACT), sm + SM_CS2, sm + SM_B2, WSP(u64, WS_S2), stab};
        pg8::gemm_phase(F.lds, g, S, E, F.wave);
        if (MK_DUP == 8) pg8::gemm_phase(F.lds, g, S, E, F.wave);
    }
    SEAM(8);
    if (IN(9)) {
        pg8::Gemm g{WSP(bf16, WS_ACT), WSP(bf16, WS_WF2D), M, DM, DFF}; pg8::PanelOrder S; S.init(M, F.G, rot_c(104, F.G));
        pg8::EpiDown<3> E{nullptr, nullptr, WSP(bf16, WS_V2), F.in[20], F.in[21], WSP(u64, WS_S2), stab, nullptr, F.out + O_Y, WSP(u64, WS_S3), 0.5f,
                          F.in[25], F.in[26], ctl + CW_PCNT, (LAS f32x2*)(F.lds + MISC_OFF + 4096)};
        pg8::gemm_phase(F.lds, g, S, E, F.wave);
        F.lane = lane_now(); F.tid = F.wave * 64 + F.lane;
        copy_fill(F, ctl, 9, false);
        copy_fill(F, ctl, 10, true);
    }
#ifdef MK_STAMP_A
    STAMP(11);
    __syncthreads();
    if (blockIdx.x == 0) {
        asm volatile("s_waitcnt vmcnt(0)" ::: "memory");
        const float da = (float)(tsw[MK_STAMP_A + 1] - tsw[MK_STAMP_A]) * 0.01f, db = (float)(tsw[MK_STAMP_B + 1] - tsw[MK_STAMP_B]) * 0.01f;
        if (F.tid == 0) F.out[O_W0P] += da;
        for (int i = F.tid; i < DEC_B * DEC_T * SGUW; i += 512) F.out[O_SV + i] += db * 0.01f;
    }
#endif
#ifdef MK_PROBE
    if (IN(10) && MK_PROBE == 1 && F.vcu == 0) {
        __builtin_amdgcn_fence(__ATOMIC_ACQUIRE, "agent");
        float dmax = 0.f; for (int st = 0; st < 8; ++st) dmax = fmaxf(dmax, __uint_as_float(__hip_atomic_load(ctl + 64 + st, __ATOMIC_RELAXED, __HIP_MEMORY_SCOPE_AGENT)));
        for (int i = F.tid; i < DEC_B * DEC_T * SGUW; i += 512) F.out[O_SV + i] += 100.0f * dmax;
    }
    if (IN(10) && gt == 0) {
        __builtin_amdgcn_fence(__ATOMIC_ACQUIRE, "agent");
        float val = 0.f; float scale = 100.f;
        for (int st = 8; st < 15; ++st) { const float d = __uint_as_float(__hip_atomic_load(ctl + 64 + st, __ATOMIC_RELAXED, __HIP_MEMORY_SCOPE_AGENT));
            if (val == 0.f && d > MK_PROBE_TOL) { int ex; (void)frexpf(d, &ex); val = scale * (float)(ex + 40); } scale *= 10.f; }
        if (MK_PROBE == 2) { val = 0.f; scale = 100.f;
            for (int k = 0; k < 3; ++k) { const unsigned c = __hip_atomic_load(ctl + 80 + k, __ATOMIC_RELAXED, __HIP_MEMORY_SCOPE_AGENT);
                if (val == 0.f && c > 0u) { int ex; (void)frexpf((float)c, &ex); val = scale * (float)(ex + 40); } scale *= 10.f; } }
        if (MK_PROBE == 1) { val = 1.0e4f * (float)(100u + __hip_atomic_load(ctl + 96, __ATOMIC_RELAXED, __HIP_MEMORY_SCOPE_AGENT)); }
        if (MK_PROBE == 11) { val = 1000.0f * (float)__hip_atomic_load(ctl + 96, __ATOMIC_RELAXED, __HIP_MEMORY_SCOPE_AGENT) + 1.0e6f * (float)__hip_atomic_load(ctl + 97, __ATOMIC_RELAXED, __HIP_MEMORY_SCOPE_AGENT); }
        if (MK_PROBE == 3) { F.out[O_SV] += 1.0e6f; val = 0.f; }
        if (MK_PROBE == 4) { F.out[O_Y] += 1.0e6f; val = 0.f; }
        if (MK_PROBE == 5) { F.out[O_Y + (size_t)MP * DM] += 1.0e6f; val = 0.f; }
        F.out[O_W0P] += val;
    }
#endif
#undef IN
#undef SEAM
}

extern "C" void kernel_launch(void* const* d_in, const int* in_sizes, int n_in, void* d_out, int out_size, void* d_ws, size_t ws_size, hipStream_t stream) {
    static int grid = 0;
    if (grid == 0) {
        if (n_in != 27 || (size_t)out_size != O_END || ws_size < WS_END) { fprintf(stderr, "kernel_launch: unexpected shapes: n_in %d out %d ws %zu (need %zu)\n", n_in, out_size, ws_size, (size_t)WS_END); grid = -1; return; }
        int dev = 0, cus = 0, per_cu = 0;
        if (hipGetDevice(&dev) != hipSuccess || hipDeviceGetAttribute(&cus, hipDeviceAttributeMultiprocessorCount, dev) != hipSuccess) { grid = -1; return; }
        if (hipFuncSetAttribute((const void*)mk_fwd, hipFuncAttributeMaxDynamicSharedMemorySize, LDS_BYTES) != hipSuccess) { fprintf(stderr, "kernel_launch: hipFuncSetAttribute failed\n"); grid = -1; return; }
        if (hipOccupancyMaxActiveBlocksPerMultiprocessor(&per_cu, (const void*)mk_fwd, 512, LDS_BYTES) != hipSuccess || per_cu < 1) { fprintf(stderr, "kernel_launch: occupancy query says %d\n", per_cu); }
        (void)hipGetLastError();
        grid = cus;
    }
    if (grid < 0) return;
    (void)hipMemsetAsync((char*)d_ws + WS_CTL, 0, 65536, stream);
    Args a{};
    for (int i = 0; i < 27; ++i) a.in[i] = (const float*)d_in[i];
    a.out = (float*)d_out; a.ws = (unsigned char*)d_ws;
    const int nph = MK_PH_MAX < N_PHASES ? MK_PH_MAX : N_PHASES;
    if (MK_N_LAUNCHES == 1) {
        a.ph_lo = 0; a.ph_hi = nph; a.li = 0;
        hipLaunchKernelGGL(mk_fwd, dim3(grid), dim3(512), LDS_BYTES, stream, a);
    } else {
        for (int p = 0; p < nph; ++p) { a.ph_lo = p; a.ph_hi = p + 1; a.li = p; hipLaunchKernelGGL(mk_fwd, dim3(grid), dim3(512), LDS_BYTES, stream, a);
#ifdef MK_PROBE
            const int stage_after[11] = {-1, -1, 0, 1, -1, 2, 3, 4, 5, 6, -1};
            if (MK_PROBE == 1 && stage_after[p] >= 0) { a.ph_lo = 100 + stage_after[p]; a.ph_hi = a.ph_lo + 1; hipLaunchKernelGGL(mk_fwd, dim3(grid), dim3(512), LDS_BYTES, stream, a); }
            if (MK_PROBE == 2 && (p == 1 || p == 2 || p == 7)) { const int k = p == 1 ? 0 : p == 2 ? 1 : 2;
                a.ph_lo = p; a.ph_hi = p + 1; a.li = 99; hipLaunchKernelGGL(mk_fwd, dim3(grid), dim3(512), LDS_BYTES, stream, a);
                a.li = 200 + k; hipLaunchKernelGGL(mk_fwd, dim3(grid), dim3(512), LDS_BYTES, stream, a); }
#endif
        }
    }
}
```
